# Optimizing an MI355X kernel written in HIP

```python
import math
import jax, jax.numpy as jnp
from jax import lax
import numpy as np

D_MODEL = 1024
BATCH = 8
SEQ = 4096
DEPTH = 1

M_HEADS = 4
M_HEAD_DIM = 128
M_WIDTH = M_HEADS * M_HEAD_DIM
CONV_WIDTH = 4
CHUNK = 64
D_HEADS = 4
D_HEAD_DIM = 64
D_V_DIM = 2 * D_HEAD_DIM
D_WIDTH = D_HEADS * D_V_DIM
ROPE_THETA = 500000.0
ROPE_DIM = D_HEAD_DIM // 4
Q_BLOCK = 128
N_GROUPS = 4
EXPERTS_PER_GROUP = 8
N_EXPERTS = N_GROUPS * EXPERTS_PER_GROUP
TOP_K = 2
D_EXPERT = D_MODEL // 4
EPS = 1e-6
IN_SIZES = (M_WIDTH, M_WIDTH, M_WIDTH, M_WIDTH, M_HEADS, M_HEADS,
            D_WIDTH, D_WIDTH, D_WIDTH, D_MODEL, D_MODEL)
IN_COLS = 4 * M_WIDTH + 2 * M_HEADS + 3 * D_WIDTH + 2 * D_MODEL

kernel_name = "hybrid_mlstm_diffattn_hmoe_block"


def rmsnorm(x, w):
    x32 = x.astype(jnp.float32)
    r = x32 * lax.rsqrt(jnp.mean(x32 * x32, axis=-1, keepdims=True) + EPS)
    return (r * w.astype(jnp.float32)).astype(x.dtype)


def to_heads(t, h):
    b, s, _ = t.shape
    return t.reshape(b, s, h, -1).transpose(0, 2, 1, 3)


def causal_conv(x, w, b):
    s = x.shape[1]
    xp = jnp.pad(x, ((0, 0), (CONV_WIDTH - 1, 0), (0, 0)))
    out = b
    for j in range(CONV_WIDTH):
        out = out + w[j] * xp[:, j:j + s]
    return out


def partial_rope(t, positions):
    inv_freq = ROPE_THETA ** (-jnp.arange(0, ROPE_DIM, 2, dtype=jnp.float32) / ROPE_DIM)
    ang = positions.astype(jnp.float32)[..., None] * inv_freq
    cos = jnp.cos(ang)[:, None, None].astype(t.dtype)
    sin = jnp.sin(ang)[:, None, None].astype(t.dtype)
    rot, rest = t[..., :ROPE_DIM], t[..., ROPE_DIM:]
    r1, r2 = jnp.split(rot, 2, axis=-1)
    rot = jnp.concatenate([r1 * cos - r2 * sin, r2 * cos + r1 * sin], axis=-1)
    return jnp.concatenate([rot, rest], axis=-1)


def mlstm_chunkwise(q, k, v, log_i, log_f):
    b_, h_, s_, d_ = q.shape
    nc = s_ // CHUNK
    chunks = lambda t: t.reshape(b_, h_, nc, CHUNK, *t.shape[3:]).transpose(2, 0, 1, 3, *range(4, t.ndim + 1))
    qc, kc, vc = chunks(q), chunks(k), chunks(v)
    ic, fc = chunks(log_i), chunks(log_f)
    causal = jnp.tril(jnp.ones((CHUNK, CHUNK), dtype=bool))

    def step(carry, inp):
        C, n, m = carry
        qt, kt, vt, it, ft = inp
        bcum = jnp.cumsum(ft, axis=-1)
        dmat = jnp.where(causal, bcum[..., :, None] - bcum[..., None, :] + it[..., None, :], -jnp.inf)
        m_inter = bcum + m[..., None]
        m_t = jnp.maximum(m_inter, jnp.max(dmat, axis=-1))
        s = jnp.einsum('bhtd,bhsd->bhts', qt, kt) * jnp.exp(dmat - m_t[..., None])
        inter = jnp.exp(m_inter - m_t)
        num = jnp.einsum('bhts,bhsd->bhtd', s, vt) + inter[..., None] * jnp.einsum('bhtk,bhkv->bhtv', qt, C)
        den = jnp.sum(s, axis=-1) + inter * jnp.einsum('bhtk,bhk->bht', qt, n)
        den = jnp.maximum(jnp.abs(den), jnp.exp(-m_t))
        h = num / den[..., None]
        b_last = bcum[..., -1]
        w = b_last[..., None] - bcum + it
        m_new = jnp.maximum(b_last + m, jnp.max(w, axis=-1))
        wexp = jnp.exp(w - m_new[..., None])
        decay = jnp.exp(b_last + m - m_new)
        C_new = decay[..., None, None] * C + jnp.einsum('bhs,bhsk,bhsv->bhkv', wexp, kt, vt)
        n_new = decay[..., None] * n + jnp.einsum('bhs,bhsk->bhk', wexp, kt)
        return (C_new, n_new, m_new), h

    init = (jnp.zeros((b_, h_, d_, d_), jnp.float32), jnp.zeros((b_, h_, d_), jnp.float32),
            jnp.zeros((b_, h_), jnp.float32))
    _, hs = lax.scan(step, init, (qc, kc, vc, ic, fc))
    return hs.transpose(1, 2, 0, 3, 4).reshape(b_, h_, s_, d_)


def diff_attention(q, k, v, lam):
    b_, h_, _, s_, d_ = q.shape
    nb = s_ // Q_BLOCK
    qb = q.reshape(b_, h_, 2, nb, Q_BLOCK, d_).transpose(3, 0, 1, 2, 4, 5)
    scale = d_ ** -0.5
    kpos = jnp.arange(s_)

    def block(args):
        qi, i = args
        sc = jnp.einsum('bhmqd,bhmkd->bhmqk', qi, k).astype(jnp.float32) * scale
        qpos = i * Q_BLOCK + jnp.arange(Q_BLOCK)
        sc = jnp.where(kpos[None, :] <= qpos[:, None], sc, -jnp.inf)
        p = jax.nn.softmax(sc, axis=-1)
        a = p[:, :, 0] - lam * p[:, :, 1]
        return jnp.einsum('bhqk,bhkd->bhqd', a.astype(v.dtype), v)

    out = lax.map(block, (qb, jnp.arange(nb)))
    return out.transpose(1, 2, 0, 3, 4).reshape(b_, h_, s_, v.shape[-1])


def hierarchical_moe(h, w_rg, b_rg, w_re, b_re, w_gate, w_up, w_down):
    b_, s_, d_ = h.shape
    hf = h.reshape(-1, d_)
    g_logits = (hf @ w_rg + b_rg).astype(jnp.float32)
    pg = jax.nn.softmax(g_logits, axis=-1)
    pg_top, g_idx = lax.top_k(pg, 1)
    e_logits = (hf @ w_re + b_re).astype(jnp.float32).reshape(-1, N_GROUPS, EXPERTS_PER_GROUP)
    e_sel = jnp.take_along_axis(e_logits, g_idx[:, :, None], axis=1)[:, 0]
    pe = jax.nn.softmax(e_sel, axis=-1)
    pe_top, j_idx = lax.top_k(pe, TOP_K)
    weights = pg_top * pe_top / jnp.sum(pe_top, axis=-1, keepdims=True)
    e_idx = g_idx * EXPERTS_PER_GROUP + j_idx
    combine = jnp.sum(jax.nn.one_hot(e_idx, N_EXPERTS, dtype=jnp.float32) * weights[..., None], axis=1)
    combine = combine.astype(h.dtype)
    y = jnp.zeros_like(hf)
    for e in range(N_EXPERTS):
        act = jax.nn.silu(hf @ w_gate[e]) * (hf @ w_up[e])
        y = y + combine[:, e:e + 1] * (act @ w_down[e])
    return y.reshape(b_, s_, d_)


def setup_inputs(seed: int = 0) -> dict:
    key = jax.random.key(seed)
    ks = iter(jax.random.split(key, 40))
    nrm = lambda shape, s: jax.random.normal(next(ks), shape, jnp.float32) * s
    L = DEPTH
    x = nrm((BATCH, SEQ, D_MODEL), 1.0)
    c = nrm((BATCH, D_MODEL), 1.0)
    positions = (jnp.arange(SEQ, dtype=jnp.int32)[None, :]
                 + jax.random.randint(next(ks), (BATCH, 1), 0, 1024, dtype=jnp.int32))
    f_bias = jnp.broadcast_to(jnp.linspace(3.0, 6.0, M_HEADS, dtype=jnp.float32), (L, M_HEADS))
    return {
        "x": x, "c": c, "positions": positions,
        "w_ada": nrm((L, D_MODEL, 6 * D_MODEL), 0.5 * D_MODEL ** -0.5),
        "b_ada": nrm((L, 6 * D_MODEL), 0.02),
        "norm1_w": 1.0 + nrm((L, D_MODEL), 0.02),
        "w_in": nrm((L, D_MODEL, IN_COLS), D_MODEL ** -0.5),
        "b_igate": nrm((L, M_HEADS), 0.1),
        "b_fgate": f_bias + nrm((L, M_HEADS), 0.1),
        "conv_w": nrm((L, CONV_WIDTH, 2 * M_WIDTH), CONV_WIDTH ** -0.5),
        "conv_b": nrm((L, 2 * M_WIDTH), 0.02),
        "mlstm_norm_w": 1.0 + nrm((L, M_HEADS, M_HEAD_DIM), 0.02),
        "q_norm_w": 1.0 + nrm((L, D_HEAD_DIM), 0.02),
        "k_norm_w": 1.0 + nrm((L, D_HEAD_DIM), 0.02),
        "lam_q1": nrm((L, D_HEAD_DIM), 0.1),
        "lam_k1": nrm((L, D_HEAD_DIM), 0.1),
        "lam_q2": nrm((L, D_HEAD_DIM), 0.1),
        "lam_k2": nrm((L, D_HEAD_DIM), 0.1),
        "subln_w": 1.0 + nrm((L, D_V_DIM), 0.02),
        "w_br_m": nrm((L, M_WIDTH, D_MODEL), M_WIDTH ** -0.5),
        "w_br_d": nrm((L, D_WIDTH, D_MODEL), D_WIDTH ** -0.5),
        "w_out": nrm((L, D_MODEL, D_MODEL), D_MODEL ** -0.5),
        "norm2_w": 1.0 + nrm((L, D_MODEL), 0.02),
        "w_rg": nrm((L, D_MODEL, N_GROUPS), D_MODEL ** -0.5),
        "b_rg": nrm((L, N_GROUPS), 0.01),
        "w_re": nrm((L, D_MODEL, N_EXPERTS), D_MODEL ** -0.5),
        "b_re": nrm((L, N_EXPERTS), 0.01),
        "w_gate": nrm((L, N_EXPERTS, D_MODEL, D_EXPERT), D_MODEL ** -0.5),
        "w_up": nrm((L, N_EXPERTS, D_MODEL, D_EXPERT), D_MODEL ** -0.5),
        "w_down": nrm((L, N_EXPERTS, D_EXPERT, D_MODEL), D_EXPERT ** -0.5),
    }


def reference(x, c, positions, w_ada, b_ada, norm1_w, w_in, b_igate, b_fgate, conv_w, conv_b,
              mlstm_norm_w, q_norm_w, k_norm_w, lam_q1, lam_k1, lam_q2, lam_k2, subln_w,
              w_br_m, w_br_d, w_out, norm2_w, w_rg, b_rg, w_re, b_re, w_gate, w_up, w_down):
    split_idx = [int(v) for v in np.cumsum(IN_SIZES)[:-1]]
    for l in range(DEPTH):
        mod = (c @ w_ada[l] + b_ada[l])[:, None, :]
        shift1, scale1, gate1, shift2, scale2, gate2 = jnp.split(mod, 6, axis=-1)

        h = rmsnorm(x, norm1_w[l]) * (1.0 + scale1) + shift1
        proj = h @ w_in[l]
        (q_m, k_m, v_m, o_m, i_pre, f_pre, q_d, k_d, v_d, g_m, g_d) = jnp.split(proj, split_idx, axis=-1)

        qk = jax.nn.silu(causal_conv(jnp.concatenate([q_m, k_m], axis=-1), conv_w[l], conv_b[l]))
        q_m, k_m = jnp.split(qk, 2, axis=-1)
        qh = to_heads(q_m, M_HEADS).astype(jnp.float32)
        kh = to_heads(k_m, M_HEADS).astype(jnp.float32) * (M_HEAD_DIM ** -0.5)
        vh = to_heads(v_m, M_HEADS).astype(jnp.float32)
        log_i = (i_pre + b_igate[l]).astype(jnp.float32).transpose(0, 2, 1)
        log_f = jax.nn.log_sigmoid((f_pre + b_fgate[l]).astype(jnp.float32)).transpose(0, 2, 1)
        hm = mlstm_chunkwise(qh, kh, vh, log_i, log_f).astype(x.dtype)
        hm = rmsnorm(hm.transpose(0, 2, 1, 3), mlstm_norm_w[l])
        hm = hm.reshape(x.shape[0], x.shape[1], M_WIDTH) * jax.nn.sigmoid(o_m)

        b_, s_ = x.shape[0], x.shape[1]
        qd = q_d.reshape(b_, s_, D_HEADS, 2, D_HEAD_DIM).transpose(0, 2, 3, 1, 4)
        kd = k_d.reshape(b_, s_, D_HEADS, 2, D_HEAD_DIM).transpose(0, 2, 3, 1, 4)
        qd = partial_rope(rmsnorm(qd, q_norm_w[l]), positions)
        kd = partial_rope(rmsnorm(kd, k_norm_w[l]), positions)
        vd = to_heads(v_d, D_HEADS)
        lam_init = 0.8 - 0.6 * math.exp(-0.3 * l)
        lam = (jnp.exp(jnp.sum(lam_q1[l] * lam_k1[l])) - jnp.exp(jnp.sum(lam_q2[l] * lam_k2[l]))
               + lam_init).astype(x.dtype)
        hd = diff_attention(qd, kd, vd, lam)
        hd = rmsnorm(hd.transpose(0, 2, 1, 3), subln_w[l]) * (1.0 - lam_init)
        hd = hd.reshape(b_, s_, D_WIDTH)

        merged = jax.nn.sigmoid(g_m) * (hm @ w_br_m[l]) + jax.nn.sigmoid(g_d) * (hd @ w_br_d[l])
        x = x + gate1 * (merged @ w_out[l])

        h2 = rmsnorm(x, norm2_w[l]) * (1.0 + scale2) + shift2
        x = x + gate2 * hierarchical_moe(h2, w_rg[l], b_rg[l], w_re[l], b_re[l],
                                         w_gate[l], w_up[l], w_down[l])
    return x
```

```cpp
#include <hip/hip_runtime.h>
#include <cmath>
namespace nv {
constexpr int T = 4096, DM = 1024, NB = 8, INC = 5640;
constexpr float EPS = 1e-6f;

__global__ void k_mod(const float* c, const float* w_ada, const float* b_ada, float* mod) {
    int col = blockIdx.x * 256 + threadIdx.x, b = blockIdx.y;
    float s = b_ada[col];
    for (int k = 0; k < 1024; ++k) s += c[b * 1024 + k] * w_ada[(size_t)k * 6144 + col];
    mod[b * 6144 + col] = s;
}
__global__ void k_modnorm(const float* x, const float* w, const float* scale, const float* shift, float* h) {
    __shared__ float red[256];
    int r = blockIdx.x, tid = threadIdx.x;
    const float* xr = x + (size_t)r * 1024;
    float v[4], s = 0.f;
    for (int i = 0; i < 4; ++i) { v[i] = xr[tid + 256 * i]; s += v[i] * v[i]; }
    red[tid] = s; __syncthreads();
    for (int o = 128; o > 0; o >>= 1) { if (tid < o) red[tid] += red[tid + o]; __syncthreads(); }
    float rstd = 1.0f / sqrtf(red[0] / 1024.f + EPS);
    for (int i = 0; i < 4; ++i) { int c = tid + 256 * i; h[(size_t)r * 1024 + c] = v[i] * rstd * w[c] * (1.f + scale[c]) + shift[c]; }
}
__global__ void __launch_bounds__(256) k_sgemm(const float* A, const float* B, float* C, int M, int N, int K) {
    __shared__ float As[16][65]; __shared__ float Bs[16][64];
    int tid = threadIdx.x, tx = tid & 15, ty = tid >> 4, m0 = blockIdx.y * 64, n0 = blockIdx.x * 64;
    float acc[4][4];
#pragma unroll
    for (int i = 0; i < 4; ++i)
#pragma unroll
        for (int j = 0; j < 4; ++j) acc[i][j] = 0.f;
    for (int k0 = 0; k0 < K; k0 += 16) {
#pragma unroll
        for (int i = 0; i < 4; ++i) { int idx = tid + 256 * i, r = idx >> 4, c = idx & 15; As[c][r] = A[(size_t)(m0 + r) * K + k0 + c]; }
#pragma unroll
        for (int i = 0; i < 4; ++i) { int idx = tid + 256 * i, r = idx >> 6, c = idx & 63; Bs[r][c] = (n0 + c < N) ? B[(size_t)(k0 + r) * N + n0 + c] : 0.f; }
        __syncthreads();
#pragma unroll
        for (int kk = 0; kk < 16; ++kk) {
            float a[4], b[4];
#pragma unroll
            for (int i = 0; i < 4; ++i) { a[i] = As[kk][ty * 4 + i]; b[i] = Bs[kk][tx * 4 + i]; }
#pragma unroll
            for (int i = 0; i < 4; ++i)
#pragma unroll
                for (int j = 0; j < 4; ++j) acc[i][j] += a[i] * b[j];
        }
        __syncthreads();
    }
#pragma unroll
    for (int i = 0; i < 4; ++i)
#pragma unroll
        for (int j = 0; j < 4; ++j) { int n = n0 + tx * 4 + j; if (n < N) C[(size_t)(m0 + ty * 4 + i) * N + n] = acc[i][j]; }
}
__device__ __forceinline__ float siluf(float x) { return x / (1.f + expf(-x)); }
__device__ __forceinline__ float sigmf(float x) { return 1.f / (1.f + expf(-x)); }
__device__ __forceinline__ float logsig(float x) { return fminf(x, 0.f) - log1pf(expf(-fabsf(x))); }

__global__ void __launch_bounds__(128) k_mlstm(const float* proj, const float* conv_w, const float* conv_b, const float* b_i, const float* b_f, float* hraw) {
    int h = blockIdx.x >> 2, vs = blockIdx.x & 3, tid = threadIdx.x, vl = tid >> 2, kq = tid & 3;
    __shared__ float qs[128], ks[128], gs[2];
    float C[32], n[32];
#pragma unroll
    for (int j = 0; j < 32; ++j) { C[j] = 0.f; n[j] = 0.f; }
    float m = 0.f;
    int cq = h * 128 + tid, ck = 512 + h * 128 + tid;
    float wq0 = conv_w[cq], wq1 = conv_w[1024 + cq], wq2 = conv_w[2048 + cq], wq3 = conv_w[3072 + cq], bq = conv_b[cq];
    float wk0 = conv_w[ck], wk1 = conv_w[1024 + ck], wk2 = conv_w[2048 + ck], wk3 = conv_w[3072 + ck], bk = conv_b[ck];
    float xq0 = 0, xq1 = 0, xq2 = 0, xk0 = 0, xk1 = 0, xk2 = 0;
    for (int t = 0; t < T; ++t) {
        const float* row = proj + (size_t)t * INC;
        float xq = row[cq], xk = row[ck];
        qs[tid] = siluf(bq + wq0 * xq0 + wq1 * xq1 + wq2 * xq2 + wq3 * xq);
        ks[tid] = siluf(bk + wk0 * xk0 + wk1 * xk1 + wk2 * xk2 + wk3 * xk) * 0.08838834764831845f;
        xq0 = xq1; xq1 = xq2; xq2 = xq; xk0 = xk1; xk1 = xk2; xk2 = xk;
        if (tid == 0) { gs[0] = row[2048 + h] + b_i[h]; gs[1] = logsig(row[2052 + h] + b_f[h]); }
        __syncthreads();
        float li = gs[0], lf = gs[1];
        float mn = fmaxf(lf + m, li), dec = expf(lf + m - mn), ie = expf(li - mn);
        m = mn;
        float v = row[1024 + h * 128 + vs * 32 + vl];
        float num = 0.f, qn = 0.f;
#pragma unroll
        for (int j = 0; j < 32; ++j) { float kk = ks[kq * 32 + j], qq = qs[kq * 32 + j]; C[j] = dec * C[j] + ie * kk * v; n[j] = dec * n[j] + ie * kk; num += qq * C[j]; qn += qq * n[j]; }
        num += __shfl_xor(num, 1); num += __shfl_xor(num, 2); qn += __shfl_xor(qn, 1); qn += __shfl_xor(qn, 2);
        float den = fmaxf(fabsf(qn), expf(-m));
        if (kq == 0) hraw[(size_t)t * 512 + h * 128 + vs * 32 + vl] = num / den;
        __syncthreads();
    }
}
__global__ void k_mlstm_post(const float* hraw, const float* proj, const float* nw, float* hm) {
    __shared__ float red[128];
    int t = blockIdx.x, h = blockIdx.y, tid = threadIdx.x;
    float v = hraw[(size_t)t * 512 + h * 128 + tid];
    red[tid] = v * v; __syncthreads();
    for (int o = 64; o > 0; o >>= 1) { if (tid < o) red[tid] += red[tid + o]; __syncthreads(); }
    float rstd = 1.f / sqrtf(red[0] / 128.f + EPS);
    hm[(size_t)t * 512 + h * 128 + tid] = v * rstd * nw[h * 128 + tid] * sigmf(proj[(size_t)t * INC + 1536 + h * 128 + tid]);
}
struct Freq { float f[8]; };
__global__ void k_qknorm(const float* proj, const int* pos, const float* qw, const float* kw, Freq fr, float* qd, float* kd) {
    __shared__ float red[64]; __shared__ float vals[64];
    int t = blockIdx.x, g = blockIdx.y & 7, isk = blockIdx.y >> 3, e = threadIdx.x;
    float v = proj[(size_t)t * INC + (isk ? 2568 : 2056) + g * 64 + e];
    red[e] = v * v; __syncthreads();
    for (int o = 32; o > 0; o >>= 1) { if (e < o) red[e] += red[e + o]; __syncthreads(); }
    float rstd = 1.f / sqrtf(red[0] / 64.f + EPS);
    float y = v * rstd * (isk ? kw[e] : qw[e]);
    vals[e] = y; __syncthreads();
    if (e < 16) {
        int i = e & 7; float ang = (float)pos[t] * fr.f[i];
        float cs = (float)cos((double)ang), sn = (float)sin((double)ang);
        float r1 = vals[i], r2 = vals[8 + i];
        y = (e < 8) ? (r1 * cs - r2 * sn) : (r2 * cs + r1 * sn);
    }
    (isk ? kd : qd)[(size_t)t * 512 + g * 64 + e] = y;
}
__global__ void k_attn_post(const float* hraw, const float* w, float* hd) {
    __shared__ float red[128];
    int t = blockIdx.x, h = blockIdx.y, tid = threadIdx.x;
    float v = hraw[(size_t)t * 512 + h * 128 + tid];
    red[tid] = v * v; __syncthreads();
    for (int o = 64; o > 0; o >>= 1) { if (tid < o) red[tid] += red[tid + o]; __syncthreads(); }
    float rstd = 1.f / sqrtf(red[0] / 128.f + EPS);
    hd[(size_t)t * 512 + h * 128 + tid] = v * rstd * w[tid] * 0.8f;
}
__global__ void k_merge(const float* proj, const float* t1, const float* t2, float* merged) {
    int t = blockIdx.x; for (int c = threadIdx.x; c < 1024; c += 256) {
        merged[(size_t)t * 1024 + c] = sigmf(proj[(size_t)t * INC + 3592 + c]) * t1[(size_t)t * 1024 + c] + sigmf(proj[(size_t)t * INC + 4616 + c]) * t2[(size_t)t * 1024 + c]; }
}
__global__ void k_resid(const float* x, const float* gate, const float* t3, float* out) {
    int t = blockIdx.x; for (int c = threadIdx.x; c < 1024; c += 256) out[(size_t)t * 1024 + c] = x[(size_t)t * 1024 + c] + gate[c] * t3[(size_t)t * 1024 + c];
}
__global__ void __launch_bounds__(256) k_moe(const float* h2, const float* w_rg, const float* b_rg, const float* w_re, const float* b_re,
                                            const float* w_gate, const float* w_up, const float* w_down, const float* gate2, float* out, float* route_dump) {
    __shared__ float hs[1024]; __shared__ float lg[36]; __shared__ float act[256]; __shared__ int sel[2]; __shared__ float wsel[2];
    int t = blockIdx.x, tid = threadIdx.x;
    for (int i = tid; i < 1024; i += 256) hs[i] = h2[(size_t)t * 1024 + i];
    __syncthreads();
    if (tid < 36) {
        float s;
        if (tid < 32) { s = b_re[tid]; for (int k = 0; k < 1024; ++k) s += hs[k] * w_re[k * 32 + tid]; }
        else { int g = tid - 32; s = b_rg[g]; for (int k = 0; k < 1024; ++k) s += hs[k] * w_rg[k * 4 + g]; }
        lg[tid] = s;
    }
    __syncthreads();
    if (tid == 0) {
        int g = 0; float gm = lg[32];
        for (int i = 1; i < 4; ++i) if (lg[32 + i] > gm) { gm = lg[32 + i]; g = i; }
        float gs = 0.f; for (int i = 0; i < 4; ++i) gs += expf(lg[32 + i] - gm);
        float pg = 1.f / gs;
        int j1 = 0; float m1 = lg[g * 8];
        for (int i = 1; i < 8; ++i) if (lg[g * 8 + i] > m1) { m1 = lg[g * 8 + i]; j1 = i; }
        int j2 = -1; float m2 = -INFINITY;
        for (int i = 0; i < 8; ++i) if (i != j1 && lg[g * 8 + i] > m2) { m2 = lg[g * 8 + i]; j2 = i; }
        float e2 = expf(m2 - m1), w1 = pg / (1.f + e2), w2 = pg * e2 / (1.f + e2);
        sel[0] = g * 8 + j1; sel[1] = g * 8 + j2; wsel[0] = w1; wsel[1] = w2;
        if (route_dump) { route_dump[t * 4 + 0] = (float)sel[0]; route_dump[t * 4 + 1] = (float)sel[1]; route_dump[t * 4 + 2] = w1; route_dump[t * 4 + 3] = w2; }
    }
    __syncthreads();
    float y[4] = {0.f, 0.f, 0.f, 0.f};
    for (int s = 0; s < 2; ++s) {
        int e = sel[s]; float wt = wsel[s];
        const float* wg = w_gate + (size_t)e * 1024 * 256; const float* wu = w_up + (size_t)e * 1024 * 256; const float* wd = w_down + (size_t)e * 256 * 1024;
        float g = 0.f, u = 0.f;
        for (int k = 0; k < 1024; ++k) { g += hs[k] * wg[k * 256 + tid]; u += hs[k] * wu[k * 256 + tid]; }
        __syncthreads();
        act[tid] = siluf(g) * u; __syncthreads();
#pragma unroll
        for (int i = 0; i < 4; ++i) { float a = 0.f; for (int j = 0; j < 256; ++j) a += act[j] * wd[j * 1024 + tid + 256 * i]; y[i] += wt * a; }
    }
#pragma unroll
    for (int i = 0; i < 4; ++i) { int c = tid + 256 * i; out[(size_t)t * 1024 + c] += gate2[c] * y[i]; }
}

struct NaiveBuf { float *mod, *h, *proj, *qd, *kd, *hraw, *hm, *hd, *t1, *t2, *merged, *t3, *h2, *route; };
inline size_t naive_carve(char* base, NaiveBuf& B) {
    size_t off = 0; auto take = [&](size_t nfl) { float* p = (float*)(base + off); off += ((nfl * 4 + 255) / 256) * 256; return p; };
    B.mod = take(8 * 6144); B.h = take((size_t)T * 1024); B.proj = take((size_t)T * INC); B.qd = take((size_t)T * 512); B.kd = take((size_t)T * 512);
    B.hraw = take((size_t)T * 512); B.hm = take((size_t)T * 512); B.hd = take((size_t)T * 512); B.t1 = take((size_t)T * 1024); B.t2 = take((size_t)T * 1024);
    B.merged = take((size_t)T * 1024); B.t3 = take((size_t)T * 1024); B.h2 = take((size_t)T * 1024); B.route = take((size_t)T * 4);
    return off;
}
__global__ void k_lam(const float* q1, const float* k1, const float* q2, const float* k2, float* lam) {
    if (threadIdx.x == 0) { float a = 0.f, b = 0.f; for (int i = 0; i < 64; ++i) { a += q1[i] * k1[i]; b += q2[i] * k2[i]; } lam[0] = expf(a) - expf(b) + 0.2f; }
}
__global__ void __launch_bounds__(128) k_attn_l(const float* qd, const float* kd, const float* proj, const float* lam, float* hraw);
inline void naive_batch(void* const* d_in, int b, const NaiveBuf& B, float* lamp, float* out_b, hipStream_t st) {
    const float* x = (const float*)d_in[0] + (size_t)b * T * 1024; const int* pos = (const int*)d_in[2] + (size_t)b * T;
    auto F = [&](int i) { return (const float*)d_in[i]; };
    const float* mod = B.mod + b * 6144;
    k_modnorm<<<T, 256, 0, st>>>(x, F(5), mod + 1024, mod, B.h);
    k_sgemm<<<dim3((INC + 63) / 64, T / 64), 256, 0, st>>>(B.h, F(6), B.proj, T, INC, 1024);
    k_mlstm<<<16, 128, 0, st>>>(B.proj, F(9), F(10), F(7), F(8), B.hraw);
    k_mlstm_post<<<dim3(T, 4), 128, 0, st>>>(B.hraw, B.proj, F(11), B.hm);
    Freq fr; for (int i = 0; i < 8; ++i) fr.f[i] = (float)std::pow(500000.0, -(double)(2 * i) / 16.0);
    k_qknorm<<<dim3(T, 16), 64, 0, st>>>(B.proj, pos, F(12), F(13), fr, B.qd, B.kd);
    k_attn_l<<<dim3(T, 4), 128, 0, st>>>(B.qd, B.kd, B.proj, lamp, B.hraw);
    k_attn_post<<<dim3(T, 4), 128, 0, st>>>(B.hraw, F(18), B.hd);
    k_sgemm<<<dim3(16, T / 64), 256, 0, st>>>(B.hm, F(19), B.t1, T, 1024, 512);
    k_sgemm<<<dim3(16, T / 64), 256, 0, st>>>(B.hd, F(20), B.t2, T, 1024, 512);
    k_merge<<<T, 256, 0, st>>>(B.proj, B.t1, B.t2, B.merged);
    k_sgemm<<<dim3(16, T / 64), 256, 0, st>>>(B.merged, F(21), B.t3, T, 1024, 1024);
    k_resid<<<T, 256, 0, st>>>(x, mod + 2048, B.t3, out_b);
    k_modnorm<<<T, 256, 0, st>>>(out_b, F(22), mod + 4096, mod + 3072, B.h2);
    k_moe<<<T, 256, 0, st>>>(B.h2, F(23), F(24), F(25), F(26), F(27), F(28), F(29), mod + 5120, out_b, B.route);
}
__global__ void __launch_bounds__(128) k_attn_l(const float* qd, const float* kd, const float* proj, const float* lam, float* hraw) {
    __shared__ float sc[2][4096]; __shared__ float qv[128]; __shared__ float red[4][128];
    const float lamv = lam[0];
    int q = blockIdx.x, h = blockIdx.y, tid = threadIdx.x;
    qv[tid] = qd[(size_t)q * 512 + h * 128 + tid]; __syncthreads();
    float mx0 = -INFINITY, mx1 = -INFINITY;
    for (int k = tid; k <= q; k += 128) {
        const float* kr = kd + (size_t)k * 512 + h * 128; float s0 = 0.f, s1 = 0.f;
        for (int d = 0; d < 64; ++d) { s0 += qv[d] * kr[d]; s1 += qv[64 + d] * kr[64 + d]; }
        s0 *= 0.125f; s1 *= 0.125f; sc[0][k] = s0; sc[1][k] = s1; mx0 = fmaxf(mx0, s0); mx1 = fmaxf(mx1, s1);
    }
    red[0][tid] = mx0; red[1][tid] = mx1; __syncthreads();
    for (int o = 64; o > 0; o >>= 1) { if (tid < o) { red[0][tid] = fmaxf(red[0][tid], red[0][tid + o]); red[1][tid] = fmaxf(red[1][tid], red[1][tid + o]); } __syncthreads(); }
    mx0 = red[0][0]; mx1 = red[1][0]; __syncthreads();
    float l0 = 0.f, l1 = 0.f;
    for (int k = tid; k <= q; k += 128) { float e0 = expf(sc[0][k] - mx0), e1 = expf(sc[1][k] - mx1); sc[0][k] = e0; sc[1][k] = e1; l0 += e0; l1 += e1; }
    red[2][tid] = l0; red[3][tid] = l1; __syncthreads();
    for (int o = 64; o > 0; o >>= 1) { if (tid < o) { red[2][tid] += red[2][tid + o]; red[3][tid] += red[3][tid + o]; } __syncthreads(); }
    l0 = red[2][0]; l1 = red[3][0];
    for (int k = tid; k <= q; k += 128) sc[0][k] = sc[0][k] / l0 - lamv * (sc[1][k] / l1);
    __syncthreads();
    float o = 0.f;
    for (int k = 0; k <= q; ++k) o += sc[0][k] * proj[(size_t)k * INC + 3080 + h * 128 + tid];
    hraw[(size_t)q * 512 + h * 128 + tid] = o;
}
}
extern "C" void kernel_launch(void* const* d_in, const int* in_sizes, int n_in, void* d_out, int out_size, void* d_ws, size_t ws_size, hipStream_t stream) {
    using namespace nv;
    NaiveBuf B; size_t used = naive_carve((char*)d_ws, B);
    float* lamp = (float*)((char*)d_ws + used);
    k_mod<<<dim3(24, 8), 256, 0, stream>>>((const float*)d_in[1], (const float*)d_in[3], (const float*)d_in[4], B.mod);
    k_lam<<<1, 64, 0, stream>>>((const float*)d_in[14], (const float*)d_in[15], (const float*)d_in[16], (const float*)d_in[17], lamp);
    for (int b = 0; b < NB; ++b) naive_batch(d_in, b, B, lamp, (float*)d_out + (size_t)b * T * 1024, stream);
}
```

```cpp
#include <hip/hip_runtime.h>
#include <hip/hip_bf16.h>
#include <cstdio>
#include <cstdint>
#include <cmath>
#define LAS __attribute__((address_space(3)))
#define DI __device__ __forceinline__
typedef unsigned short bf16_t;
typedef short bf16x8 __attribute__((ext_vector_type(8)));
typedef short s16x4 __attribute__((ext_vector_type(4)));
typedef float f32x4 __attribute__((ext_vector_type(4)));
typedef float f32x16 __attribute__((ext_vector_type(16)));
typedef float f32x2 __attribute__((ext_vector_type(2)));
typedef unsigned u32x4 __attribute__((ext_vector_type(4)));
typedef unsigned u32x2 __attribute__((ext_vector_type(2)));
typedef __bf16 bf16x2_t __attribute__((ext_vector_type(2)));
DI unsigned pk2(float lo, float hi) { f32x2 v = {lo, hi}; bf16x2_t b = __builtin_convertvector(v, bf16x2_t); return __builtin_bit_cast(unsigned, b); }
DI float bflo(unsigned w) { return __uint_as_float(w << 16); }
DI float bfhi(unsigned w) { return __uint_as_float(w & 0xffff0000u); }
DI float bf2f(bf16_t u) { return __uint_as_float((unsigned)u << 16); }
DI float fexp(float x) { return __builtin_amdgcn_exp2f(x * 1.4426950408889634f); }
DI float fsigm(float x) { return __builtin_amdgcn_rcpf(1.f + fexp(-x)); }

namespace pg8 {
constexpr int BM = 256, BK = 64, HALF = 128, HTB = HALF * BK * 2, STAGE_BYTES = 8 * HTB, NXCD = 8, WGM = 8;
__host__ __device__ __forceinline__ int lds_byte(int r, int c) { const int st = (r >> 4) * 2 + (c >> 5), rr = r & 15, cc = c & 31, ob = rr * 64 + cc * 2; return st * 1024 + (ob ^ (((ob >> 9) & 1) << 5)); }
__host__ __device__ __forceinline__ void stage_rc(int b, int& R, int& C) { const int st = b / 1024, sb = b % 1024, swz = sb ^ (((sb >> 9) & 1) << 5); R = (st >> 1) * 16 + swz / 64; C = (st & 1) * 32 + (swz % 64) / 2; }
__host__ __device__ __forceinline__ int perm32(int rho) { const int n = rho >> 4, i = rho & 15; return 8 * (i >> 2) + 4 * n + (i & 3); }

struct Unit { int pm, pn, e, l, mt; };
struct Gemm { const bf16_t* A; const bf16_t* Bt; int K; size_t bstride; };

struct StaticOrder {
    int nM, nN, nwg, G, c;
    __host__ __device__ void init(int M, int N, int G_, int c_) { nM = M / BM; nN = N / BM; nwg = nM * nN; G = G_; c = c_; }
    __host__ __device__ bool next(int i, Unit& u) const {
        const long L = (long)i * G + c; if (L >= nwg) return false;
        int wgid = (int)L; { const int q = nwg / NXCD, r = nwg % NXCD, xcd = wgid % NXCD, off = wgid / NXCD; wgid = (xcd < r ? xcd * (q + 1) : r * (q + 1) + (xcd - r) * q) + off; }
        const int nig = WGM * nN, gid = wgid / nig, fm = gid * WGM, gsz = (nM - fm) < WGM ? (nM - fm) : WGM;
        u.pm = fm + ((wgid % nig) % gsz); u.pn = (wgid % nig) / gsz; u.e = 0; u.l = 0; u.mt = 0; return true;
    }
    DI unsigned gather(const Unit&, int, int, int) const { return 0u; }
};

template <class Epi, class Sched, bool ALIGN_EPI, bool GATHER>
DI void gemm_phase(LAS unsigned char* lds, const Gemm g, const Sched& S, const Epi& E) {
    const int tid = threadIdx.x, wid = __builtin_amdgcn_readfirstlane(tid >> 6), lane = tid & 63, wr = wid >> 2, wc = wid & 3, fr = lane & 15, fq = lane >> 4;
    const int K = g.K, nt = K / BK;
    unsigned voffA[2], voffB[2]; int gR[2], gC2[2];
#pragma unroll
    for (int i = 0; i < 2; ++i) { int R, C; stage_rc(tid * 16 + i * 8192, R, C); const int Rb = Epi::PERM ? ((R & ~31) + perm32(R & 31)) : R;
        voffA[i] = (unsigned)(R * K + C) * 2u; voffB[i] = (unsigned)(Rb * K + C) * 2u; gR[i] = R; gC2[i] = C * 2; }
    const size_t kstep = (size_t)(BK * 2);
    const size_t hstep = (size_t)HALF * K * 2;
    const size_t tstep = 2 * hstep;
    const unsigned ldsw = (unsigned)wid * 1024u;
    const int aoff = lds_byte(wr * 64 + fr, fq * 8), boff = lds_byte(wc * 32 + fr, fq * 8);
#define PG8_SA(b, h) (((b) * 2 + (h)) * HTB)
#define PG8_SB(b, h) ((4 + (b) * 2 + (h)) * HTB)
#define PG8_STAGE(bufoff, gbase, voff) do { _Pragma("unroll") for (int _i = 0; _i < 2; ++_i) \
        __builtin_amdgcn_global_load_lds((const unsigned*)((const char*)(gbase) + (voff)[_i]), (LAS unsigned*)(lds + (bufoff) + ldsw + _i * 8192), 16, 0, 0); } while (0)
#define PG8_STAGE_A(bufoff, dptr, h, kb, nx) do { if constexpr (GATHER) { unsigned _vo[2]; _vo[0] = (nx) ? gN[h][0] : gO[h][0]; _vo[1] = (nx) ? gN[h][1] : gO[h][1]; PG8_STAGE(bufoff, (const char*)g.A + (kb), _vo); } \
        else { PG8_STAGE(bufoff, dptr, voffA); } } while (0)
#define PG8_LDA(dst, b, h) do { _Pragma("unroll") for (int m = 0; m < 4; ++m) _Pragma("unroll") for (int k = 0; k < 2; ++k) dst[m][k] = *(const LAS bf16x8*)(lds + PG8_SA(b, h) + aoff + m * 2048 + k * 1024); } while (0)
#define PG8_LDB(dst, b, h) do { _Pragma("unroll") for (int n = 0; n < 2; ++n) _Pragma("unroll") for (int k = 0; k < 2; ++k) dst[n][k] = *(const LAS bf16x8*)(lds + PG8_SB(b, h) + boff + n * 2048 + k * 1024); } while (0)
#define PG8_MMA(ai, bj, At, Bt) do { __builtin_amdgcn_s_setprio(1); _Pragma("unroll") for (int m = 0; m < 4; ++m) _Pragma("unroll") for (int n = 0; n < 2; ++n) _Pragma("unroll") for (int k = 0; k < 2; ++k) \
        acc[ai][bj][m][n] = __builtin_amdgcn_mfma_f32_16x16x32_bf16(Bt[n][k], At[m][k], acc[ai][bj][m][n], 0, 0, 0); __builtin_amdgcn_s_setprio(0); } while (0)
#define PG8_WAIT_V(n) asm volatile("s_waitcnt vmcnt(" #n ")" ::: "memory")
#define PG8_WAIT_L(n) asm volatile("s_waitcnt lgkmcnt(" #n ")" ::: "memory")
#define PG8_BAR __builtin_amdgcn_s_barrier()
#define PG8_SCHED __builtin_amdgcn_sched_barrier(0)
    Unit cur, nxt; int ui = 0;
    if (!S.next(0, cur)) return;
    f32x4 acc[2][2][4][2];
#pragma unroll
    for (int a = 0; a < 2; ++a)
#pragma unroll
        for (int b = 0; b < 2; ++b)
#pragma unroll
            for (int m = 0; m < 4; ++m)
#pragma unroll
                for (int n = 0; n < 2; ++n) acc[a][b][m][n] = (f32x4){0.f, 0.f, 0.f, 0.f};
    bf16x8 At[4][2], B0[2][2], B1[2][2];
    unsigned gO[2][2], gN[2][2];
    if constexpr (GATHER) {
#pragma unroll
        for (int h = 0; h < 2; ++h)
#pragma unroll
            for (int i = 0; i < 2; ++i) { gO[h][i] = S.gather(cur, h * HALF + gR[i], gC2[i], K); gN[h][i] = gO[h][i]; }
    } else { gO[0][0] = gO[0][1] = gO[1][0] = gO[1][1] = 0u; gN[0][0] = gN[0][1] = gN[1][0] = gN[1][1] = 0u; }
    const char* cA = (const char*)g.A + (GATHER ? (size_t)0 : (size_t)cur.pm * tstep);
    const char* cB = (const char*)g.Bt + ((size_t)cur.e * g.bstride) * 2 + (size_t)cur.pn * tstep;
    PG8_STAGE(PG8_SB(0, 0), cB, voffB); PG8_STAGE(PG8_SB(0, 1), cB + hstep, voffB); PG8_STAGE_A(PG8_SA(0, 0), cA, 0, 0, false); PG8_STAGE_A(PG8_SA(0, 1), cA + hstep, 1, 0, false);
    if (wr == 1) PG8_BAR;
    PG8_WAIT_V(2); PG8_BAR;
    PG8_STAGE(PG8_SB(1, 0), cB + kstep, voffB); PG8_STAGE_A(PG8_SA(1, 0), cA + kstep, 0, kstep, false); PG8_STAGE(PG8_SB(1, 1), cB + hstep + kstep, voffB);
    PG8_WAIT_V(6); PG8_BAR;
    for (;;) {
        const bool has_next = S.next(ui + 1, nxt);
        if constexpr (GATHER) {
            if (has_next) {
#pragma unroll
                for (int h = 0; h < 2; ++h)
#pragma unroll
                    for (int i = 0; i < 2; ++i) gN[h][i] = S.gather(nxt, h * HALF + gR[i], gC2[i], K);
            } else {
#pragma unroll
                for (int h = 0; h < 2; ++h)
#pragma unroll
                    for (int i = 0; i < 2; ++i) gN[h][i] = gO[h][i];
            }
        }
        const char* nA = GATHER ? cA : (has_next ? (const char*)g.A + (size_t)nxt.pm * tstep : cA);
        const char* nB = has_next ? (const char*)g.Bt + ((size_t)nxt.e * g.bstride) * 2 + (size_t)nxt.pn * tstep : cB;
        for (int t = 0; t < nt; t += 2) {
            if constexpr (Epi::HAS_MID) { if (t == Epi::MID_T) { E.mid(acc, cur, wr, wc, fr, fq); PG8_SCHED; } }
            const bool last = (t == nt - 2);
            const char* a1 = cA + (size_t)(t + 1) * kstep;
            const char* a2 = last ? nA : cA + (size_t)(t + 2) * kstep; const char* b2 = last ? nB : cB + (size_t)(t + 2) * kstep;
            const char* a3 = a2 + kstep; const char* b3 = b2 + kstep;
            const size_t k1 = (size_t)(t + 1) * kstep, k2 = last ? (size_t)0 : (size_t)(t + 2) * kstep, k3 = k2 + kstep;
            PG8_LDB(B0, 0, 0); PG8_LDB(B1, 0, 1); PG8_SCHED; PG8_LDA(At, 0, 0); PG8_STAGE_A(PG8_SA(1, 1), a1 + hstep, 1, k1, false);
            PG8_WAIT_V(8); PG8_WAIT_L(0); PG8_BAR; PG8_MMA(0, 0, At, B0); PG8_MMA(0, 1, At, B1); PG8_BAR; PG8_SCHED;
            PG8_LDA(At, 0, 1); PG8_STAGE(PG8_SB(0, 0), b2, voffB); PG8_STAGE(PG8_SB(0, 1), b2 + hstep, voffB); PG8_STAGE_A(PG8_SA(0, 0), a2, 0, k2, last);
            PG8_WAIT_V(8); PG8_WAIT_L(0); PG8_BAR; PG8_MMA(1, 0, At, B0); PG8_MMA(1, 1, At, B1); PG8_BAR; PG8_SCHED;
            PG8_LDB(B0, 1, 0); PG8_LDB(B1, 1, 1); PG8_SCHED; PG8_LDA(At, 1, 0); PG8_STAGE_A(PG8_SA(0, 1), a2 + hstep, 1, k2, last);
            PG8_WAIT_V(8); PG8_WAIT_L(0); PG8_BAR; PG8_MMA(0, 0, At, B0); PG8_MMA(0, 1, At, B1); PG8_BAR; PG8_SCHED;
            PG8_LDA(At, 1, 1); PG8_STAGE(PG8_SB(1, 0), b3, voffB); PG8_STAGE(PG8_SB(1, 1), b3 + hstep, voffB); PG8_STAGE_A(PG8_SA(1, 0), a3, 0, k3, last);
            PG8_WAIT_V(8); PG8_WAIT_L(0); PG8_BAR; PG8_MMA(1, 0, At, B0); PG8_MMA(1, 1, At, B1); PG8_BAR; PG8_SCHED;
        }
        if constexpr (ALIGN_EPI) { if (wr == 0) PG8_BAR; }
        E(acc, cur, wr, wc, fr, fq);
        if (!has_next) break;
#pragma unroll
        for (int a = 0; a < 2; ++a)
#pragma unroll
            for (int b = 0; b < 2; ++b)
#pragma unroll
                for (int m = 0; m < 4; ++m)
#pragma unroll
                    for (int n = 0; n < 2; ++n) acc[a][b][m][n] = (f32x4){0.f, 0.f, 0.f, 0.f};
        cur = nxt; cA = nA; cB = nB; ++ui;
        if constexpr (GATHER) {
#pragma unroll
            for (int h = 0; h < 2; ++h)
#pragma unroll
                for (int i = 0; i < 2; ++i) gO[h][i] = gN[h][i];
        }
        if constexpr (ALIGN_EPI) { if (wr == 1) PG8_BAR; }
    }
    PG8_WAIT_V(0);
    if constexpr (!ALIGN_EPI) { if (wr == 0) PG8_BAR; }
    PG8_BAR;
#undef PG8_SA
#undef PG8_SB
#undef PG8_STAGE
#undef PG8_STAGE_A
#undef PG8_LDA
#undef PG8_LDB
#undef PG8_MMA
#undef PG8_WAIT_V
#undef PG8_WAIT_L
#undef PG8_BAR
#undef PG8_SCHED
}
}
constexpr int NBATCH = 8, SEQ = 4096, MTOK = 32768, DMODEL = 1024, NIN = 5632;
constexpr float QSCALE = 0.125f * 1.4426950408889634f;
constexpr float REPS = 1e-6f;
constexpr size_t MiB = 1u << 20;
constexpr size_t WS_CTL = 0, CTL_ZERO_BYTES = 1 * MiB;
constexpr size_t WS_MOD = 1 * MiB, WS_WG8 = 1 * MiB + 256 * 1024, WS_ROUTE = 1 * MiB + 512 * 1024;
constexpr size_t WS_CS = 2 * MiB, WS_LOGI = 4 * MiB, WS_LOGF = 4 * MiB + 512 * 1024, WS_WR = 5 * MiB;
constexpr size_t WS_WIN = 6 * MiB, WS_WBR = 17 * MiB, WS_WOUT = 19 * MiB, WS_WGU = 21 * MiB, WS_WD = 53 * MiB;
constexpr size_t WS_R1 = 70 * MiB;
constexpr size_t WS_QM = 134 * MiB, WS_KM = 166 * MiB, WS_VM = 198 * MiB, WS_OG = 230 * MiB;
constexpr size_t WS_QD = 262 * MiB, WS_KD = 294 * MiB, WS_VD = 326 * MiB;
constexpr size_t WS_GM = 358 * MiB, WS_GD = 422 * MiB;
constexpr size_t WS_MG = WS_QM;
constexpr size_t WS_TOK = WS_VM, WS_WT = WS_VM + 8 * MiB;
constexpr size_t WS_ACT = WS_QD;
constexpr size_t WS_END = 486 * MiB;
constexpr int CW_BAR = 4096, CW_ATTQ = 8192, CW_CNT = 12288, CW_ERR = 16384;

__host__ __device__ __forceinline__ int dperm(int p) { return p < 16 ? (8 * ((p >> 2) & 1) + 4 * (p >> 3) + (p & 3)) : p; }
__host__ __device__ __forceinline__ int win_col(int L) {
    if (L < 2048) return L;
    if (L < 3072) { const int Lp = L - 2048, isk = Lp >> 9, Lt = Lp & 511, th = Lt >> 8, P = Lt & 255, bj = P >> 7, g = (P >> 5) & 3, r = P & 31;
        return (isk ? 2568 : 2056) + 64 * (4 * th + g) + dperm(32 * bj + r); }
    if (L < 3584) return 3080 + (L - 3072);
    if (L < 4608) return 3592 + (L - 3584);
    return 4616 + (L - 4608);
}

using pg8::Unit;
DI u32x4 pack8(const f32x4& a, const f32x4& b) { u32x4 w; w.x = pk2(a[0], a[1]); w.y = pk2(a[2], a[3]); w.z = pk2(b[0], b[1]); w.w = pk2(b[2], b[3]); return w; }
DI float bfidx(const u32x4& w, int i) { const unsigned x = (i < 2) ? w.x : (i < 4) ? w.y : (i < 6) ? w.z : w.w; return (i & 1) ? bfhi(x) : bflo(x); }

struct EpiInProj {
    static constexpr bool PERM = true, HAS_MID = false; static constexpr int MID_T = 0;
    bf16_t *QM, *KM, *VM, *OG, *QD, *KD, *VD, *GM, *GD; const float* cs; const float *qnw, *knw;
    DI void mid(f32x4 (&)[2][2][4][2], const Unit&, int, int, int, int) const {}
    DI void operator()(const f32x4 (&acc)[2][2][4][2], const Unit& u, int wr, int wc, int fr, int fq) const {
        const int pn = u.pn, row0 = u.pm * 256 + wr * 64 + fr;
        if (pn >= 8 && pn < 12) {
            const bool isk = pn >= 10; const int grp = 4 * (pn & 1) + wc;
            bf16_t* dst = isk ? KD : QD; const float* nw = isk ? knw : qnw;
            f32x4 w[2][2];
#pragma unroll
            for (int n = 0; n < 2; ++n) { w[0][n] = *(const f32x4*)(nw + (fq < 2 ? (8 * n + 4 * fq) : (8 * fq + 4 * n))); w[1][n] = *(const f32x4*)(nw + 32 + 8 * fq + 4 * n); }
            const float osc = isk ? 1.0f : QSCALE;
#pragma unroll
            for (int ai = 0; ai < 2; ++ai)
#pragma unroll
                for (int m = 0; m < 4; ++m) {
                    const int row = row0 + ai * 128 + m * 16;
                    f32x4 y[2][2]; float ss = 0.f;
#pragma unroll
                    for (int bj = 0; bj < 2; ++bj)
#pragma unroll
                        for (int n = 0; n < 2; ++n) { y[bj][n] = acc[ai][bj][m][n]; const f32x4 q = y[bj][n] * y[bj][n]; ss += (q[0] + q[1]) + (q[2] + q[3]); }
                    ss += __shfl_xor(ss, 16); ss += __shfl_xor(ss, 32);
                    const float rstd = __builtin_amdgcn_rsqf(ss * (1.0f / 64.0f) + REPS);
#pragma unroll
                    for (int bj = 0; bj < 2; ++bj)
#pragma unroll
                        for (int n = 0; n < 2; ++n) y[bj][n] = y[bj][n] * rstd * w[bj][n];
                    if (fq < 2) {
                        const f32x4 c4 = *(const f32x4*)(cs + (size_t)row * 16 + 4 * fq), s4 = *(const f32x4*)(cs + (size_t)row * 16 + 8 + 4 * fq);
                        const f32x4 a = y[0][0], b = y[0][1];
                        y[0][0] = a * c4 - b * s4; y[0][1] = b * c4 + a * s4;
                    }
#pragma unroll
                    for (int bj = 0; bj < 2; ++bj) *(u32x4*)(dst + (size_t)row * 512 + 64 * grp + 32 * bj + 8 * fq) = pack8(y[bj][0] * osc, y[bj][1] * osc);
                }
            return;
        }
        bf16_t* base; int ld, colt; bool sg;
        if (pn < 8) { base = pn < 2 ? QM : pn < 4 ? KM : pn < 6 ? VM : OG; ld = 512; colt = (pn & 1) * 256; sg = pn >= 6; }
        else if (pn < 14) { base = VD; ld = 512; colt = (pn & 1) * 256; sg = false; }
        else if (pn < 18) { base = GM; ld = 1024; colt = (pn - 14) * 256; sg = true; }
        else { base = GD; ld = 1024; colt = (pn - 18) * 256; sg = true; }
        const int col0 = colt + wc * 32 + 8 * fq;
#pragma unroll
        for (int ai = 0; ai < 2; ++ai)
#pragma unroll
            for (int m = 0; m < 4; ++m) { bf16_t* rowp = base + (size_t)(row0 + ai * 128 + m * 16) * ld + col0;
#pragma unroll
                for (int bj = 0; bj < 2; ++bj) { f32x4 v0 = acc[ai][bj][m][0], v1 = acc[ai][bj][m][1];
                    if (sg) {
#pragma unroll
                        for (int j = 0; j < 4; ++j) { v0[j] = fsigm(v0[j]); v1[j] = fsigm(v1[j]); } }
                    *(u32x4*)(rowp + bj * 128) = pack8(v0, v1); } }
    }
};

struct EpiBranch {
    static constexpr bool PERM = true, HAS_MID = true; static constexpr int MID_T = 8;
    const bf16_t *GM, *GD; bf16_t* MG;
    DI void mid(f32x4 (&acc)[2][2][4][2], const Unit& u, int wr, int wc, int fr, int fq) const {
        unsigned lo = (unsigned)((wr * 64 + fr) * 1024 + wc * 32 + 8 * fq); asm volatile("" : "+v"(lo));
        const size_t ub = (size_t)u.pm * 256 * 1024 + (size_t)u.pn * 256; const bf16_t* gmb = GM + ub; const bf16_t* gdb = GD + ub;
#pragma unroll
        for (int ai = 0; ai < 2; ++ai)
#pragma unroll
            for (int m = 0; m < 4; ++m)
#pragma unroll
                for (int bj = 0; bj < 2; ++bj) { const unsigned off = lo + (unsigned)((ai * 128 + m * 16) * 1024 + bj * 128);
                    const u32x4 gm = *(const u32x4*)(gmb + off), gd = *(const u32x4*)(gdb + off);
#pragma unroll
                    for (int n = 0; n < 2; ++n)
#pragma unroll
                        for (int j = 0; j < 4; ++j) acc[ai][bj][m][n][j] *= bfidx(gm, 4 * n + j) * __builtin_amdgcn_rcpf(fmaxf(bfidx(gd, 4 * n + j), 1e-30f));
                    if (bj == 1) asm volatile("" ::: "memory"); }
    }
    DI void operator()(const f32x4 (&acc)[2][2][4][2], const Unit& u, int wr, int wc, int fr, int fq) const {
        unsigned lo = (unsigned)((wr * 64 + fr) * 1024 + wc * 32 + 8 * fq); asm volatile("" : "+v"(lo));
        const size_t ub = (size_t)u.pm * 256 * 1024 + (size_t)u.pn * 256; const bf16_t* gdb = GD + ub; bf16_t* mgb = MG + ub;
#pragma unroll
        for (int ai = 0; ai < 2; ++ai)
#pragma unroll
            for (int m = 0; m < 4; ++m)
#pragma unroll
                for (int bj = 0; bj < 2; ++bj) { const unsigned off = lo + (unsigned)((ai * 128 + m * 16) * 1024 + bj * 128);
                    const u32x4 gd = *(const u32x4*)(gdb + off); f32x4 v[2];
#pragma unroll
                    for (int n = 0; n < 2; ++n)
#pragma unroll
                        for (int j = 0; j < 4; ++j) v[n][j] = acc[ai][bj][m][n][j] * fmaxf(bfidx(gd, 4 * n + j), 1e-30f);
                    *(u32x4*)(mgb + off) = pack8(v[0], v[1]); if (bj == 1) asm volatile("" ::: "memory"); }
    }
};

struct EpiOut {
    static constexpr bool PERM = false, HAS_MID = false; static constexpr int MID_T = 0;
    const float* x; const float* mod; float* out;
    DI void mid(f32x4 (&)[2][2][4][2], const Unit&, int, int, int, int) const {}
    DI void operator()(const f32x4 (&acc)[2][2][4][2], const Unit& u, int wr, int wc, int fr, int fq) const {
        const int row0 = u.pm * 256 + wr * 64 + fr, col0 = u.pn * 256 + wc * 32 + 4 * fq; const int b = u.pm >> 4;
        f32x4 gv[2][2];
#pragma unroll
        for (int bj = 0; bj < 2; ++bj)
#pragma unroll
            for (int n = 0; n < 2; ++n) gv[bj][n] = *(const f32x4*)(mod + b * 6144 + 2048 + col0 + bj * 128 + n * 16);
#pragma unroll
        for (int ai = 0; ai < 2; ++ai)
#pragma unroll
            for (int m = 0; m < 4; ++m) { const size_t off = (size_t)(row0 + ai * 128 + m * 16) * 1024 + col0;
#pragma unroll
                for (int bj = 0; bj < 2; ++bj)
#pragma unroll
                    for (int n = 0; n < 2; ++n) { const f32x4 xv = *(const f32x4*)(x + off + bj * 128 + n * 16); *(f32x4*)(out + off + bj * 128 + n * 16) = xv + gv[bj][n] * acc[ai][bj][m][n]; } }
    }
};

struct EpiRouter {
    static constexpr bool PERM = false, HAS_MID = false; static constexpr int MID_T = 0;
    const float *brg, *bre; unsigned* cnt; int* tok; float* wt; float* route;
    DI void mid(f32x4 (&)[2][2][4][2], const Unit&, int, int, int, int) const {}
    DI void operator()(const f32x4 (&acc)[2][2][4][2], const Unit& u, int wr, int wc, int fr, int fq) const {
        if (wc != 0) return;
        const int row0 = u.pm * 256 + wr * 64 + fr;
        const f32x4 bg = *(const f32x4*)brg;
#pragma unroll
        for (int ai = 0; ai < 2; ++ai)
#pragma unroll
            for (int m = 0; m < 4; ++m) {
                const int row = row0 + ai * 128 + m * 16;
                float gl[4];
#pragma unroll
                for (int j = 0; j < 4; ++j) gl[j] = __shfl(acc[ai][1][m][0][j], fr) + bg[j];
                int g = 0; float gmx = gl[0];
#pragma unroll
                for (int j = 1; j < 4; ++j) if (gl[j] > gmx) { gmx = gl[j]; g = j; }
                float gs = 0.f;
#pragma unroll
                for (int j = 0; j < 4; ++j) gs += fexp(gl[j] - gmx);
                const float pg = 1.0f / gs;
                f32x4 sel0 = acc[ai][0][m][0], sel1 = acc[ai][0][m][1];
                asm volatile("" : "+v"(sel0), "+v"(sel1));
                f32x4 sel;
#pragma unroll
                for (int j = 0; j < 4; ++j) sel[j] = (g & 2) ? sel1[j] : sel0[j];
                const int srcA = fr + 32 * (g & 1), srcB = srcA + 16;
                float el[8];
#pragma unroll
                for (int j = 0; j < 4; ++j) { el[j] = __shfl(sel[j], srcA) + bre[8 * g + j]; el[4 + j] = __shfl(sel[j], srcB) + bre[8 * g + 4 + j]; }
                int j1 = 0; float m1 = el[0];
#pragma unroll
                for (int j = 1; j < 8; ++j) if (el[j] > m1) { m1 = el[j]; j1 = j; }
                int j2 = -1; float m2 = -INFINITY;
#pragma unroll
                for (int j = 0; j < 8; ++j) if (j != j1 && el[j] > m2) { m2 = el[j]; j2 = j; }
                const float e2 = fexp(m2 - m1), w1 = pg / (1.f + e2), w2 = pg * e2 / (1.f + e2);
                if (fq == 0) {
                    const int L1 = 8 * g + j1, L2 = 32 + 8 * g + j2;
                    const unsigned p1 = atomicAdd(cnt + L1, 1u), p2 = atomicAdd(cnt + L2, 1u);
                    tok[(size_t)L1 * 32768 + p1] = row; wt[(size_t)L1 * 32768 + p1] = w1;
                    tok[(size_t)L2 * 32768 + p2] = row; wt[(size_t)L2 * 32768 + p2] = w2;
                    *(f32x4*)(route + (size_t)row * 4) = (f32x4){(float)L1, (float)(L2 - 32), w1, w2};
                }
            }
    }
};

struct GroupedOrder {
    const LAS int* pref;
    int g0, g1, nN, G, c; const int* tok; const unsigned* cnt;
    DI bool next(int i, Unit& u) const {
        const int j = i * G + c; if (j >= (g1 - g0) * nN) return false;
        const int gm = g0 + j / nN; int l = 0;
#pragma unroll 1
        for (int t = 1; t < 64; ++t) if (pref[t] <= gm) l = t;
        u.pm = gm; u.pn = j % nN; u.e = l & 31; u.l = l; u.mt = gm - pref[l]; return true;
    }
    DI unsigned gather(const Unit& u, int r, int c2, int K) const {
        const int n = (int)cnt[u.l]; int idx = u.mt * 256 + r; idx = idx < n ? idx : n - 1;
        return (unsigned)tok[(size_t)u.l * 32768 + idx] * (unsigned)(K * 2) + (unsigned)c2;
    }
};
struct EpiGateUp {
    static constexpr bool PERM = true, HAS_MID = false; static constexpr int MID_T = 0;
    bf16_t* ACT;
    DI void mid(f32x4 (&)[2][2][4][2], const Unit&, int, int, int, int) const {}
    DI void operator()(const f32x4 (&acc)[2][2][4][2], const Unit& u, int wr, int wc, int fr, int fq) const {
        const int row0 = u.pm * 256 + wr * 64 + fr, col0 = u.pn * 128 + wc * 32 + 8 * fq;
#pragma unroll
        for (int ai = 0; ai < 2; ++ai)
#pragma unroll
            for (int m = 0; m < 4; ++m) { f32x4 v[2];
#pragma unroll
                for (int n = 0; n < 2; ++n)
#pragma unroll
                    for (int j = 0; j < 4; ++j) { const float gg = acc[ai][0][m][n][j]; v[n][j] = gg * fsigm(gg) * acc[ai][1][m][n][j]; }
                *(u32x4*)(ACT + (size_t)(row0 + ai * 128 + m * 16) * 256 + col0) = pack8(v[0], v[1]); }
    }
};
struct EpiDown {
    static constexpr bool PERM = false, HAS_MID = false; static constexpr int MID_T = 0;
    const int* tok; const float* wt; const unsigned* cnt; const float* mod; float* out;
    DI void mid(f32x4 (&)[2][2][4][2], const Unit&, int, int, int, int) const {}
    DI void operator()(const f32x4 (&acc)[2][2][4][2], const Unit& u, int wr, int wc, int fr, int fq) const {
        const int n = (int)cnt[u.l]; int i0 = u.mt * 256 + wr * 64 + fr; asm volatile("" : "+v"(i0));
        const int col0 = u.pn * 256 + wc * 32 + 4 * fq;
        const int* tl = tok + (size_t)u.l * 32768; const float* wl = wt + (size_t)u.l * 32768;
#pragma unroll
        for (int ai = 0; ai < 2; ++ai)
#pragma unroll
            for (int m = 0; m < 4; ++m) { const int i = i0 + ai * 128 + m * 16;
                if (i < n) { const int t = tl[i]; const float w = wl[i]; const float* gp = mod + (t >> 12) * 6144 + 5120 + col0; float* op = out + (size_t)t * 1024 + col0;
#pragma unroll
                    for (int bj = 0; bj < 2; ++bj)
#pragma unroll
                        for (int nn = 0; nn < 2; ++nn) { const f32x4 g2 = *(const f32x4*)(gp + bj * 128 + nn * 16); f32x4 o = *(const f32x4*)(op + bj * 128 + nn * 16); o = o + g2 * (acc[ai][bj][m][nn] * w); *(f32x4*)(op + bj * 128 + nn * 16) = o; } }
                asm volatile("" ::: "memory"); }
    }
};
namespace att {
typedef short v4i16_t __attribute__((ext_vector_type(4)));
constexpr int XP = 132;
constexpr int OFF_K = 0, OFF_V = 32768, OFF_WS = 69632;
DI int crow(int r, int hi) { return (r & 3) + 8 * (r >> 2) + 4 * hi; }
DI s16x4 vtr(const LAS char* p) { return __builtin_bit_cast(s16x4, __builtin_amdgcn_ds_read_tr16_b64_v4i16((LAS v4i16_t*)p)); }

DI void unit(int b, int h, int qb, const bf16_t* __restrict__ QD, const bf16_t* __restrict__ KD, const bf16_t* __restrict__ VD, bf16_t* HMD, float lam, const float* subw, LAS char* lds) {
    int tid = threadIdx.x; asm volatile("" : "+v"(tid));
    const int lane = tid & 63, wid = __builtin_amdgcn_readfirstlane(tid >> 6), r32 = lane & 31, hi = lane >> 5, map = wid >> 2, wq = wid & 3;
    const int q0 = qb * 128, NT = 2 * qb + 2; const size_t rowbase = (size_t)b * SEQ;
    bf16x8 qf[4];
    { const bf16_t* qp = QD + (rowbase + q0 + 32 * wq + r32) * 512 + h * 128 + map * 64 + 8 * hi;
#pragma unroll
      for (int d0 = 0; d0 < 4; ++d0) qf[d0] = *(const bf16x8*)(qp + 16 * d0); }
    f32x16 o[4];
#pragma unroll
    for (int i = 0; i < 4; ++i)
#pragma unroll
        for (int r = 0; r < 16; ++r) o[i][r] = 0.f;
    float lsum = 0.f;
    const bf16_t* kg[2]; const bf16_t* vg[2];
#pragma unroll
    for (int i = 0; i < 2; ++i) { const int id = tid + 512 * i;
        kg[i] = KD + (rowbase + (id & 63)) * 512 + h * 128 + (id >> 6) * 8;
        vg[i] = VD + (rowbase + ((id >> 2) & 63)) * 512 + h * 128 + (id >> 8) * 32 + (id & 3) * 8; }
    u32x4 kr[2], vr[2];
#pragma unroll
    for (int i = 0; i < 2; ++i) { kr[i] = *(const u32x4*)kg[i]; vr[i] = *(const u32x4*)vg[i]; }
#pragma unroll
    for (int i = 0; i < 2; ++i) { *(LAS u32x4*)(lds + OFF_K + (tid + 512 * i) * 16) = kr[i]; *(LAS u32x4*)(lds + OFF_V + (tid + 512 * i) * 16) = vr[i]; }
    __syncthreads();
    const int qabs = q0 + 32 * wq + r32;
    for (int t = 0; t < NT; ++t) {
        const int cb = (t & 1) * 16384, nb = 16384 - cb;
        if (t + 1 < NT) {
#pragma unroll
            for (int i = 0; i < 2; ++i) { kr[i] = *(const u32x4*)(kg[i] + (size_t)(t + 1) * 64 * 512); vr[i] = *(const u32x4*)(vg[i] + (size_t)(t + 1) * 64 * 512); }
        }
        if (64 * t <= q0 + 32 * wq + 31) {
            const LAS char* kb = lds + OFF_K + cb + (8 * map + hi) * 1024 + r32 * 16;
            f32x16 p0, p1;
#pragma unroll
            for (int r = 0; r < 16; ++r) { p0[r] = 0.f; p1[r] = 0.f; }
#pragma unroll
            for (int d0 = 0; d0 < 4; ++d0) {
                const bf16x8 a0 = *(const LAS bf16x8*)(kb + d0 * 2048), a1 = *(const LAS bf16x8*)(kb + d0 * 2048 + 512);
                p0 = __builtin_amdgcn_mfma_f32_32x32x16_bf16(a0, qf[d0], p0, 0, 0, 0);
                p1 = __builtin_amdgcn_mfma_f32_32x32x16_bf16(a1, qf[d0], p1, 0, 0, 0);
            }
            const bool needmask = (64 * t + 63 > q0 + 32 * wq);
            const int kbase = 64 * t + 4 * hi;
#pragma unroll
            for (int r = 0; r < 16; ++r) {
                float e0 = __builtin_amdgcn_exp2f(p0[r]), e1 = __builtin_amdgcn_exp2f(p1[r]);
                if (needmask) { const int kv = kbase + (r & 3) + 8 * (r >> 2); if (kv > qabs) e0 = 0.f; if (kv + 32 > qabs) e1 = 0.f; }
                p0[r] = e0; p1[r] = e1; lsum += e0 + e1;
            }
            bf16x8 pa[4];
            { u32x4 w;
              w.x = pk2(p0[0], p0[1]); w.y = pk2(p0[2], p0[3]); w.z = pk2(p0[4], p0[5]); w.w = pk2(p0[6], p0[7]); pa[0] = __builtin_bit_cast(bf16x8, w);
              w.x = pk2(p0[8], p0[9]); w.y = pk2(p0[10], p0[11]); w.z = pk2(p0[12], p0[13]); w.w = pk2(p0[14], p0[15]); pa[1] = __builtin_bit_cast(bf16x8, w);
              w.x = pk2(p1[0], p1[1]); w.y = pk2(p1[2], p1[3]); w.z = pk2(p1[4], p1[5]); w.w = pk2(p1[6], p1[7]); pa[2] = __builtin_bit_cast(bf16x8, w);
              w.x = pk2(p1[8], p1[9]); w.y = pk2(p1[10], p1[11]); w.z = pk2(p1[12], p1[13]); w.w = pk2(p1[14], p1[15]); pa[3] = __builtin_bit_cast(bf16x8, w); }
            const LAS char* vb = lds + OFF_V + cb + ((lane >> 4) & 1) * 32 + (lane & 3) * 8 + (4 * hi + ((lane & 15) >> 2)) * 64;
#pragma unroll
            for (int dt = 0; dt < 4; ++dt)
#pragma unroll
                for (int ks = 0; ks < 4; ++ks) {
                    const s16x4 lo = vtr(vb + dt * 4096 + ks * 1024), hh = vtr(vb + dt * 4096 + ks * 1024 + 512);
                    const bf16x8 vf = (bf16x8){lo[0], lo[1], lo[2], lo[3], hh[0], hh[1], hh[2], hh[3]};
                    o[dt] = __builtin_amdgcn_mfma_f32_32x32x16_bf16(pa[ks], vf, o[dt], 0, 0, 0);
                }
        }
        if (t + 1 < NT) {
#pragma unroll
            for (int i = 0; i < 2; ++i) { *(LAS u32x4*)(lds + OFF_K + nb + (tid + 512 * i) * 16) = kr[i]; *(LAS u32x4*)(lds + OFF_V + nb + (tid + 512 * i) * 16) = vr[i]; }
        }
        __syncthreads();
    }
    const float ltot = lsum + __shfl_xor(lsum, 32);
    LAS float* wsf = (LAS float*)(lds + OFF_WS) + wid * 64;
    if (hi == 0) wsf[r32] = 1.0f / ltot;
    __syncthreads();
    float rl[16];
#pragma unroll
    for (int r = 0; r < 16; ++r) rl[r] = wsf[crow(r, hi)];
    LAS float* X = (LAS float*)lds + wq * 32 * XP;
    if (map == 1) {
#pragma unroll
        for (int dt = 0; dt < 4; ++dt)
#pragma unroll
            for (int r = 0; r < 16; ++r) X[crow(r, hi) * XP + 32 * dt + r32] = lam * o[dt][r] * rl[r];
    }
    __syncthreads();
    if (map == 0) {
#pragma unroll
        for (int dt = 0; dt < 4; ++dt)
#pragma unroll
            for (int r = 0; r < 16; ++r) { const int idx = crow(r, hi) * XP + 32 * dt + r32; X[idx] = o[dt][r] * rl[r] - X[idx]; }
    }
    __syncthreads();
    if (map == 0) {
        const int row = lane >> 1, seg = lane & 1;
        f32x4 xv[16]; float ss = 0.f;
#pragma unroll
        for (int i = 0; i < 16; ++i) { xv[i] = *(const LAS f32x4*)(X + row * XP + 64 * seg + 4 * i); const f32x4 q = xv[i] * xv[i]; ss += (q[0] + q[1]) + (q[2] + q[3]); }
        ss += __shfl_xor(ss, 1);
        const float rs = __builtin_amdgcn_rsqf(ss * (1.0f / 128.0f) + REPS) * 0.8f;
        bf16_t* op = HMD + (rowbase + q0 + 32 * wq + row) * 1024 + 512 + h * 128 + 64 * seg;
#pragma unroll
        for (int i = 0; i < 8; ++i) { const f32x4 w0 = *(const f32x4*)(subw + 64 * seg + 8 * i), w1 = *(const f32x4*)(subw + 64 * seg + 8 * i + 4);
            *(u32x4*)(op + 8 * i) = pack8(xv[2 * i] * w0 * rs, xv[2 * i + 1] * w1 * rs); }
    }
    __syncthreads();
}
}

namespace ml {
constexpr int PQ = 272, PS = 144;
constexpr int OQ = 0, OK = 17408, OKW = 34816, OV = 53248, OP = 71680, OF = 80896, OH = 90368;
constexpr int F_N = 0, F_QN = 128, F_RSP = 192, F_SSQ = 320, F_CW = 832, F_G = 2112;

DI void run(int bh, const bf16_t* __restrict__ QM, const bf16_t* __restrict__ KM, const bf16_t* __restrict__ VM, const bf16_t* __restrict__ OG,
            const float* __restrict__ LOGI, const float* __restrict__ LOGF, const float* __restrict__ conv_w, const float* __restrict__ conv_b, const float* __restrict__ nw, bf16_t* HMD, LAS char* lds) {
    const int tid = threadIdx.x, lane = tid & 63, wid = __builtin_amdgcn_readfirstlane(tid >> 6), fr = lane & 15, gq = lane >> 4;
    const int b = bh >> 2, h = bh & 3; const size_t R0 = (size_t)b * SEQ;
    LAS float* fl = (LAS float*)(lds + OF);
    const int tens = tid >> 8, cch = (tid >> 4) & 15, rg = tid & 15;
    const bf16_t* csrc = (tens ? KM : QM) + h * 128 + 8 * cch;
    LAS float* cwl = fl + F_CW;
    for (int i = tid; i < 2 * 5 * 128; i += 512) { const int tn = i / 640, j = (i % 640) >> 7, col = i & 127, ch = tn * 512 + h * 128 + col; cwl[i] = (j < 4) ? conv_w[j * 1024 + ch] : conv_b[ch]; }
    const int vch = tid >> 5, sp = tid & 31;
    const bf16_t* vsrc = VM + h * 128 + 8 * vch;
    const float nwv = nw[h * 128 + 16 * wid + fr];
    f32x4 Cacc[8];
#pragma unroll
    for (int i = 0; i < 8; ++i) Cacc[i] = (f32x4){0.f, 0.f, 0.f, 0.f};
    if (tid < 128) fl[F_N + tid] = 0.f;
    float mprev = 0.f;
    u32x4 xr[7], vv[2]; float lf, li;
#define ML_PREFETCH(c) do { \
        _Pragma("unroll") for (int rr = 0; rr < 7; ++rr) { const int gr = 64 * (c) + 4 * rg + rr - 3; xr[rr] = (gr >= 0) ? *(const u32x4*)(csrc + (R0 + gr) * 512) : (u32x4){0u, 0u, 0u, 0u}; } \
        _Pragma("unroll") for (int rr = 0; rr < 2; ++rr) vv[rr] = *(const u32x4*)(vsrc + (R0 + 64 * (c) + 2 * sp + rr) * 512); \
        lf = LOGF[(size_t)bh * SEQ + 64 * (c) + lane]; li = LOGI[(size_t)bh * SEQ + 64 * (c) + lane]; } while (0)
    ML_PREFETCH(0);
    __syncthreads();
    for (int c = 0; c < 64; ++c) {
        float bc = lf;
#pragma unroll
        for (int d = 1; d < 64; d <<= 1) { const float t = __shfl_up(bc, d); if (lane >= d) bc += t; }
        const float ag = li - bc; float pm = ag;
#pragma unroll
        for (int d = 1; d < 64; d <<= 1) { const float t = __shfl_up(pm, d); if (lane >= d) pm = fmaxf(pm, t); }
        const float gg = fmaxf(mprev, pm);
        const float g63 = __shfl(gg, 63), blast = __shfl(bc, 63);
        const float wexp = fexp(ag - g63), inter = fexp(mprev - gg), emt = fexp(-(bc + gg)), decay = fexp(mprev - g63), mnew = blast + g63;
        if (wid == 0) { fl[F_G + lane] = ag; fl[F_G + 64 + lane] = gg; fl[F_G + 128 + lane] = inter; fl[F_G + 192 + lane] = emt; }
        {
            float wx[4];
#pragma unroll
            for (int r = 0; r < 4; ++r) wx[r] = __shfl(wexp, 4 * rg + r);
            const LAS float* cwp = cwl + tens * 640 + 8 * cch;
#pragma unroll
            for (int hh = 0; hh < 2; ++hh) {
                float ov[4][4], cw[4][4];
                { const f32x4 b0 = *(const LAS f32x4*)(cwp + 512 + 4 * hh);
#pragma unroll
                  for (int r = 0; r < 4; ++r) { ov[r][0] = b0[0]; ov[r][1] = b0[1]; ov[r][2] = b0[2]; ov[r][3] = b0[3]; } }
#pragma unroll
                for (int j = 0; j < 4; ++j) { const f32x4 w0 = *(const LAS f32x4*)(cwp + 128 * j + 4 * hh); cw[j][0] = w0[0]; cw[j][1] = w0[1]; cw[j][2] = w0[2]; cw[j][3] = w0[3]; }
#pragma unroll
                for (int rr = 0; rr < 7; ++rr) {
                    const unsigned wa = hh ? xr[rr].z : xr[rr].x, wb = hh ? xr[rr].w : xr[rr].y;
                    const float xe[4] = {bflo(wa), bfhi(wa), bflo(wb), bfhi(wb)};
#pragma unroll
                    for (int r = 0; r < 4; ++r) { const int j = rr - r;
                        if (j >= 0 && j < 4) {
#pragma unroll
                            for (int e = 0; e < 4; ++e) ov[r][e] += cw[j][e] * xe[e]; } }
                }
#pragma unroll
                for (int r = 0; r < 4; ++r)
#pragma unroll
                    for (int e = 0; e < 4; ++e) { const float v = ov[r][e]; ov[r][e] = v * fsigm(v) * (tens ? 0.08838834764831845f : 1.0f); }
#pragma unroll
                for (int r = 0; r < 4; ++r) { u32x2 w; w.x = pk2(ov[r][0], ov[r][1]); w.y = pk2(ov[r][2], ov[r][3]);
                    *(LAS u32x2*)(lds + (tens ? OK : OQ) + (4 * rg + r) * PQ + cch * 16 + 8 * hh) = w; }
                if (tens) {
#pragma unroll
                    for (int e = 0; e < 4; ++e) { u32x2 w; w.x = pk2(ov[0][e] * wx[0], ov[1][e] * wx[1]); w.y = pk2(ov[2][e] * wx[2], ov[3][e] * wx[3]);
                        *(LAS u32x2*)(lds + OKW + (8 * cch + 4 * hh + e) * PS + (4 * rg) * 2) = w; }
                }
                __builtin_amdgcn_sched_barrier(0);
            }
            float v0[8], v1[8];
            v0[0] = bflo(vv[0].x); v0[1] = bfhi(vv[0].x); v0[2] = bflo(vv[0].y); v0[3] = bfhi(vv[0].y); v0[4] = bflo(vv[0].z); v0[5] = bfhi(vv[0].z); v0[6] = bflo(vv[0].w); v0[7] = bfhi(vv[0].w);
            v1[0] = bflo(vv[1].x); v1[1] = bfhi(vv[1].x); v1[2] = bflo(vv[1].y); v1[3] = bfhi(vv[1].y); v1[4] = bflo(vv[1].z); v1[5] = bfhi(vv[1].z); v1[6] = bflo(vv[1].w); v1[7] = bfhi(vv[1].w);
#pragma unroll
            for (int e = 0; e < 8; ++e) *(LAS unsigned*)(lds + OV + (8 * vch + e) * PS + (2 * sp) * 2) = pk2(v0[e], v1[e]);
        }
        const float lf_c = lf, li_c = li; (void)lf_c; (void)li_c;
        __syncthreads();
        {
            const int tt = wid >> 1, sh = wid & 1;
            f32x4 s0 = {0.f, 0.f, 0.f, 0.f}, s1 = {0.f, 0.f, 0.f, 0.f};
#pragma unroll
            for (int ks = 0; ks < 4; ++ks) {
                const bf16x8 a = *(const LAS bf16x8*)(lds + OQ + (16 * tt + fr) * PQ + (32 * ks + 8 * gq) * 2);
                const bf16x8 b0 = *(const LAS bf16x8*)(lds + OK + (32 * sh + fr) * PQ + (32 * ks + 8 * gq) * 2);
                const bf16x8 b1 = *(const LAS bf16x8*)(lds + OK + (32 * sh + 16 + fr) * PQ + (32 * ks + 8 * gq) * 2);
                s0 = __builtin_amdgcn_mfma_f32_16x16x32_bf16(a, b0, s0, 0, 0, 0);
                s1 = __builtin_amdgcn_mfma_f32_16x16x32_bf16(a, b1, s1, 0, 0, 0);
            }
            const int sA = 32 * sh + fr, sB = sA + 16;
            const float aA = fl[F_G + sA], aB = fl[F_G + sB];
#pragma unroll
            for (int rg2 = 0; rg2 < 4; ++rg2) {
                const int t = 16 * tt + 4 * gq + rg2; const float gt = fl[F_G + 64 + t];
                const float pA = (sA <= t) ? s0[rg2] * fexp(aA - gt) : 0.f, pB = (sB <= t) ? s1[rg2] * fexp(aB - gt) : 0.f;
                *(LAS bf16_t*)(lds + OP + t * PS + sA * 2) = (bf16_t)(pk2(pA, 0.f) & 0xffffu);
                *(LAS bf16_t*)(lds + OP + t * PS + sB * 2) = (bf16_t)(pk2(pB, 0.f) & 0xffffu);
                float rs = pA + pB;
                rs += __shfl_xor(rs, 1); rs += __shfl_xor(rs, 2); rs += __shfl_xor(rs, 4); rs += __shfl_xor(rs, 8);
                if (fr == 0) fl[F_RSP + sh * 64 + t] = rs;
            }
            const int tq = tid >> 3, kseg = tid & 7;
            const u32x4 qa = *(const LAS u32x4*)(lds + OQ + tq * PQ + kseg * 32), qb2 = *(const LAS u32x4*)(lds + OQ + tq * PQ + kseg * 32 + 16);
            const LAS float* np = fl + F_N + 16 * kseg;
            float d = bflo(qa.x) * np[0] + bfhi(qa.x) * np[1] + bflo(qa.y) * np[2] + bfhi(qa.y) * np[3] + bflo(qa.z) * np[4] + bfhi(qa.z) * np[5] + bflo(qa.w) * np[6] + bfhi(qa.w) * np[7]
                    + bflo(qb2.x) * np[8] + bfhi(qb2.x) * np[9] + bflo(qb2.y) * np[10] + bfhi(qb2.y) * np[11] + bflo(qb2.z) * np[12] + bfhi(qb2.z) * np[13] + bflo(qb2.w) * np[14] + bfhi(qb2.w) * np[15];
            d += __shfl_xor(d, 1); d += __shfl_xor(d, 2); d += __shfl_xor(d, 4);
            if (kseg == 0) fl[F_QN + tq] = d;
        }
        __syncthreads();
        if (c + 1 < 64) ML_PREFETCH(c + 1);
        f32x4 y[4];
#pragma unroll
        for (int tt = 0; tt < 4; ++tt) y[tt] = (f32x4){0.f, 0.f, 0.f, 0.f};
#pragma unroll
        for (int ks = 0; ks < 4; ++ks) {
            u32x4 cbw; cbw.x = pk2(Cacc[2 * ks][0], Cacc[2 * ks][1]); cbw.y = pk2(Cacc[2 * ks][2], Cacc[2 * ks][3]); cbw.z = pk2(Cacc[2 * ks + 1][0], Cacc[2 * ks + 1][1]); cbw.w = pk2(Cacc[2 * ks + 1][2], Cacc[2 * ks + 1][3]);
            const bf16x8 bfr = __builtin_bit_cast(bf16x8, cbw);
#pragma unroll
            for (int tt = 0; tt < 4; ++tt) {
                const u32x2 a0 = *(const LAS u32x2*)(lds + OQ + (16 * tt + fr) * PQ + (32 * ks + 4 * gq) * 2), a1 = *(const LAS u32x2*)(lds + OQ + (16 * tt + fr) * PQ + (32 * ks + 16 + 4 * gq) * 2);
                const u32x4 aw = {a0.x, a0.y, a1.x, a1.y};
                y[tt] = __builtin_amdgcn_mfma_f32_16x16x32_bf16(__builtin_bit_cast(bf16x8, aw), bfr, y[tt], 0, 0, 0);
            }
            __builtin_amdgcn_sched_barrier(0);
        }
#pragma unroll
        for (int tt = 0; tt < 4; ++tt)
#pragma unroll
            for (int rg2 = 0; rg2 < 4; ++rg2) { const int t = 16 * tt + 4 * gq + rg2; y[tt][rg2] *= fl[F_G + 128 + t]; }
#pragma unroll
        for (int k2 = 0; k2 < 2; ++k2) {
            const bf16x8 bv = *(const LAS bf16x8*)(lds + OV + (16 * wid + fr) * PS + (32 * k2 + 8 * gq) * 2);
#pragma unroll
            for (int tt = 0; tt < 4; ++tt) { const bf16x8 a = *(const LAS bf16x8*)(lds + OP + (16 * tt + fr) * PS + (32 * k2 + 8 * gq) * 2);
                y[tt] = __builtin_amdgcn_mfma_f32_16x16x32_bf16(a, bv, y[tt], 0, 0, 0); }
            __builtin_amdgcn_sched_barrier(0);
        }
#pragma unroll
        for (int tt = 0; tt < 4; ++tt)
#pragma unroll
            for (int rg2 = 0; rg2 < 4; ++rg2) { const int t = 16 * tt + 4 * gq + rg2;
                float den = fl[F_RSP + t] + fl[F_RSP + 64 + t] + fl[F_G + 128 + t] * fl[F_QN + t];
                den = fmaxf(fabsf(den), fl[F_G + 192 + t]);
                const float hv = y[tt][rg2] / den; y[tt][rg2] = hv;
                float sq = hv * hv; sq += __shfl_xor(sq, 1); sq += __shfl_xor(sq, 2); sq += __shfl_xor(sq, 4); sq += __shfl_xor(sq, 8);
                if (fr == 0) fl[F_SSQ + wid * 64 + t] = sq; }
        __syncthreads();
        u32x4 ogp[2];
#pragma unroll
        for (int i = 0; i < 2; ++i) { const int id = tid + 512 * i; ogp[i] = *(const u32x4*)(OG + (R0 + 64 * c + (id >> 4)) * 512 + h * 128 + 8 * (id & 15)); }
#pragma unroll
        for (int tt = 0; tt < 4; ++tt)
#pragma unroll
            for (int rg2 = 0; rg2 < 4; ++rg2) { const int t = 16 * tt + 4 * gq + rg2; float tot = 0.f;
#pragma unroll
                for (int w = 0; w < 8; ++w) tot += fl[F_SSQ + w * 64 + t];
                const float ov = y[tt][rg2] * __builtin_amdgcn_rsqf(tot * (1.0f / 128.0f) + REPS) * nwv;
                *(LAS bf16_t*)(lds + OH + t * PQ + (16 * wid + fr) * 2) = (bf16_t)(pk2(ov, 0.f) & 0xffffu); }
#pragma unroll
        for (int kt = 0; kt < 8; ++kt) Cacc[kt] = Cacc[kt] * decay;
#pragma unroll
        for (int k2 = 0; k2 < 2; ++k2) {
            const bf16x8 bv = *(const LAS bf16x8*)(lds + OV + (16 * wid + fr) * PS + (32 * k2 + 8 * gq) * 2);
#pragma unroll
            for (int kt = 0; kt < 8; ++kt) { const bf16x8 a = *(const LAS bf16x8*)(lds + OKW + (16 * kt + fr) * PS + (32 * k2 + 8 * gq) * 2);
                Cacc[kt] = __builtin_amdgcn_mfma_f32_16x16x32_bf16(a, bv, Cacc[kt], 0, 0, 0); }
            __builtin_amdgcn_sched_barrier(0);
        }
        if (tid < 128) { float s = 0.f;
#pragma unroll
            for (int i = 0; i < 8; ++i) { const u32x4 w = *(const LAS u32x4*)(lds + OKW + tid * PS + i * 16); s += (bflo(w.x) + bfhi(w.x)) + (bflo(w.y) + bfhi(w.y)) + (bflo(w.z) + bfhi(w.z)) + (bflo(w.w) + bfhi(w.w)); }
            fl[F_N + tid] = decay * fl[F_N + tid] + s; }
        mprev = mnew;
        __syncthreads();
#pragma unroll
        for (int i = 0; i < 2; ++i) { const int id = tid + 512 * i, row = id >> 4, ch = id & 15;
            const u32x4 hv4 = *(const LAS u32x4*)(lds + OH + row * PQ + ch * 16);
            u32x4 o4; o4.x = pk2(bflo(hv4.x) * bflo(ogp[i].x), bfhi(hv4.x) * bfhi(ogp[i].x)); o4.y = pk2(bflo(hv4.y) * bflo(ogp[i].y), bfhi(hv4.y) * bfhi(ogp[i].y));
            o4.z = pk2(bflo(hv4.z) * bflo(ogp[i].z), bfhi(hv4.z) * bfhi(ogp[i].z)); o4.w = pk2(bflo(hv4.w) * bflo(ogp[i].w), bfhi(hv4.w) * bfhi(ogp[i].w));
            *(u32x4*)(HMD + (R0 + 64 * c + row) * 1024 + h * 128 + 8 * ch) = o4; }
    }
#undef ML_PREFETCH
}
}
constexpr int NWAVES = 8, LDS_BYTES = 147456, RING_BYTES = 131072, MISC_OFF = RING_BYTES + 320, PREF_OFF = RING_BYTES + 1024;
#define RLX_AGENT __ATOMIC_RELAXED, __HIP_MEMORY_SCOPE_AGENT
#define XB_TMO      128
#define XB_XCNT(j)  (256  + 64 * (j))
#define XB_XSUB(j)  (1280 + 64 * (j))
#define XB_XGEN(j)  (2304 + 64 * (j))
#define XB_TOP      3328
#define XB_TOPGEN   3392
#define XCD_BAR_WORDS 3456
#define XB_SPIN_CAP (1u << 18)
DI unsigned xb_ld(unsigned* p)              { return __hip_atomic_load(p, __ATOMIC_RELAXED, __HIP_MEMORY_SCOPE_AGENT); }
DI unsigned xb_add(unsigned* p, unsigned v) { return __hip_atomic_fetch_add(p, v, __ATOMIC_RELAXED, __HIP_MEMORY_SCOPE_AGENT); }
DI unsigned xb_xcc_id() { return (unsigned)__builtin_amdgcn_s_getreg((3 << 11) | 20) & 0xFu; }
#define XB_SPIN(cond, bar) do { unsigned _sp = 0; while (cond) { __builtin_amdgcn_s_sleep(1); \
    if ((++_sp & 255u) == 0u) { if (xb_ld(&(bar)[XB_TMO])) break; if (_sp > XB_SPIN_CAP) { atomicAdd(&(bar)[XB_TMO], 1u); break; } } } } while (0)
struct XcdBarrier { unsigned* bar; unsigned x; volatile LAS unsigned* st; };
DI XcdBarrier xcd_barrier_post(unsigned* bar, volatile LAS unsigned* st) {
    XcdBarrier b; b.bar = bar; b.x = xb_xcc_id(); b.st = st;
    if (threadIdx.x == 0) (void)xb_add(&bar[XB_XCNT(b.x)], 1u);
    return b;
}
DI void xcd_barrier_complete(unsigned* bar, unsigned x, unsigned& nloc, unsigned& nx) {
    const unsigned G = gridDim.x * gridDim.y * gridDim.z;
    unsigned sum, cnt, mine, sp = 0u;
    for (;;) {
        sum = 0u; cnt = 0u; mine = 0u;
#pragma unroll
        for (unsigned j = 0; j < 16; ++j) { const unsigned c = xb_ld(&bar[XB_XCNT(j)]); sum += c; cnt += (c > 0u) ? 1u : 0u; mine = (j == x) ? c : mine; }
        if (sum == G) break;
        __builtin_amdgcn_s_sleep(1);
        if ((++sp & 255u) == 0u) { if (xb_ld(&bar[XB_TMO])) break; if (sp > XB_SPIN_CAP) { atomicAdd(&bar[XB_TMO], 1u); break; } }
    }
    nloc = mine > 0u ? mine : 1u; nx = cnt > 0u ? cnt : 1u;
}
DI void xcd_barrier(const XcdBarrier& b) {
    asm volatile("s_waitcnt vmcnt(0)" ::: "memory");
    __syncthreads();
    if (threadIdx.x == 0) {
        unsigned* bar = b.bar;
        __builtin_amdgcn_s_waitcnt(0);
        unsigned nloc = b.st[0], nx = b.st[1];
        if (nloc == 0u) { xcd_barrier_complete(bar, b.x, nloc, nx); b.st[0] = nloc; b.st[1] = nx; }
        const unsigned old = xb_add(&bar[XB_XSUB(b.x)], 1u);
        const unsigned gen = old / nloc;
        if (old + 1u == (gen + 1u) * nloc) {
            __builtin_amdgcn_fence(__ATOMIC_RELEASE, "agent");
            asm volatile("s_waitcnt vmcnt(0)" ::: "memory");
            const unsigned og = xb_add(&bar[XB_TOP], 1u);
            const unsigned tg = og / nx;
            if (og + 1u == (tg + 1u) * nx) xb_add(&bar[XB_TOPGEN], 1u);
            else XB_SPIN(xb_ld(&bar[XB_TOPGEN]) == tg, bar);
            __builtin_amdgcn_fence(__ATOMIC_ACQUIRE, "agent");
            xb_add(&bar[XB_XGEN(b.x)], 1u);
            asm volatile("s_waitcnt vmcnt(0)" ::: "memory");
        } else {
            XB_SPIN(xb_ld(&bar[XB_XGEN(b.x)]) == gen, bar);
            __builtin_amdgcn_fence(__ATOMIC_ACQUIRE, "agent");
            asm volatile("s_waitcnt vmcnt(0)" ::: "memory");
        }
    }
    __syncthreads();
}

struct Args { const void* in[30]; float* out; unsigned char* ws; float freq[8]; int ph_lo, ph_hi; };

DI float wave_sum(float v) {
#pragma unroll
    for (int o = 1; o < 64; o <<= 1) v += __shfl_xor(v, o);
    return v;
}
DI float logsigf(float x) { return fminf(x, 0.f) - __logf(1.f + __expf(-fabsf(x))); }

DI void tr_item(const float* W, int ldw, int col, bf16_t* WT, int ldk, int koff, int n0, int k0, LAS float* scr, int lane) {
#pragma unroll 8
    for (int i = 0; i < 32; ++i) { const int kk = 2 * i + (lane >> 5); scr[kk * 33 + (lane & 31)] = W[(size_t)(k0 + kk) * ldw + col]; }
    asm volatile("s_waitcnt lgkmcnt(0)" ::: "memory");
    const int c = lane & 7;
#pragma unroll
    for (int j = 0; j < 4; ++j) { const int n = (lane >> 3) + 8 * j; const LAS float* s = scr + (8 * c) * 33 + n;
        u32x4 o; o.x = pk2(s[0 * 33], s[1 * 33]); o.y = pk2(s[2 * 33], s[3 * 33]); o.z = pk2(s[4 * 33], s[5 * 33]); o.w = pk2(s[6 * 33], s[7 * 33]);
        *(u32x4*)(WT + (size_t)(n0 + n) * ldk + koff + k0 + 8 * c) = o; }
    asm volatile("s_waitcnt lgkmcnt(0)" ::: "memory");
}

DI void p0_prologue(const Args& a, LAS unsigned char* lds, int tid, int lane, int wave) {
    unsigned char* ws = a.ws;
    const int gw = blockIdx.x * NWAVES + wave, NGW = gridDim.x * NWAVES;
    const float* w_in = (const float*)a.in[6];
    {
        LAS float* cl = (LAS float*)(lds + 69632);
        const float* c = (const float*)a.in[1];
        for (int i = tid; i < 8192; i += NWAVES * 64) cl[i] = c[i];
        __syncthreads();
        const int it = blockIdx.x + 256 * wave;
        if (wave < 2 && it < 384) {
            const float* w_ada = (const float*)a.in[3]; const float* b_ada = (const float*)a.in[4]; float* mod = (float*)(ws + WS_MOD);
            const int col = 16 * it + (lane & 15), kq = lane >> 4;
            float s[8];
#pragma unroll
            for (int b = 0; b < 8; ++b) s[b] = 0.f;
#pragma unroll 4
            for (int k = kq; k < 1024; k += 4) { const float w = w_ada[(size_t)k * 6144 + col];
#pragma unroll
                for (int b = 0; b < 8; ++b) s[b] += cl[b * 1024 + k] * w; }
#pragma unroll
            for (int b = 0; b < 8; ++b) { s[b] += __shfl_xor(s[b], 16); s[b] += __shfl_xor(s[b], 32); }
            if (kq == 0) { const float bb = b_ada[col];
#pragma unroll
                for (int b = 0; b < 8; ++b) mod[b * 6144 + col] = s[b] + bb; }
        }
    }
    LAS float* scr = (LAS float*)(lds + wave * 8448);
    constexpr int I_IN = 16 * 176, I_BR = 8 * 32, I_OUT = 16 * 32, I_GU = 32 * 256, I_D = 32 * 128;
    constexpr int NITEMS = I_IN + 2 * I_BR + I_OUT + I_GU + I_D;
    for (int it = gw; it < NITEMS; it += NGW) {
        int r = it;
        if (r < I_IN) { const int kb = r / 176, nb = r % 176; tr_item(w_in, 5640, win_col(32 * nb + (lane & 31)), (bf16_t*)(ws + WS_WIN), 1024, 0, 32 * nb, 64 * kb, scr, lane); continue; } r -= I_IN;
        if (r < I_BR) { const int kb = r / 32, nb = r % 32; tr_item((const float*)a.in[19], 1024, 32 * nb + (lane & 31), (bf16_t*)(ws + WS_WBR), 1024, 0, 32 * nb, 64 * kb, scr, lane); continue; } r -= I_BR;
        if (r < I_BR) { const int kb = r / 32, nb = r % 32; tr_item((const float*)a.in[20], 1024, 32 * nb + (lane & 31), (bf16_t*)(ws + WS_WBR), 1024, 512, 32 * nb, 64 * kb, scr, lane); continue; } r -= I_BR;
        if (r < I_OUT) { const int kb = r / 32, nb = r % 32; tr_item((const float*)a.in[21], 1024, 32 * nb + (lane & 31), (bf16_t*)(ws + WS_WOUT), 1024, 0, 32 * nb, 64 * kb, scr, lane); continue; } r -= I_OUT;
        if (r < I_GU) { const int e = r >> 8, q = r & 255, kb = q >> 4, nb = q & 15;
            const float* src = (const float*)a.in[((nb >> 2) & 1) ? 28 : 27] + (size_t)e * 1024 * 256;
            tr_item(src, 256, 128 * (nb >> 3) + 32 * (nb & 3) + (lane & 31), (bf16_t*)(ws + WS_WGU) + (size_t)e * 512 * 1024, 1024, 0, 32 * nb, 64 * kb, scr, lane); continue; } r -= I_GU;
        { const int e = r >> 7, q = r & 127, kb = q >> 5, nb = q & 31;
            tr_item((const float*)a.in[29] + (size_t)e * 256 * 1024, 1024, 32 * nb + (lane & 31), (bf16_t*)(ws + WS_WD) + (size_t)e * 1024 * 256, 256, 0, 32 * nb, 64 * kb, scr, lane); }
    }
    const int gt = blockIdx.x * (NWAVES * 64) + tid, NGT = gridDim.x * NWAVES * 64;
    { bf16_t* wr = (bf16_t*)(ws + WS_WR); const float* w_re = (const float*)a.in[25]; const float* w_rg = (const float*)a.in[23];
      for (int i = gt; i < 256 * 128; i += NGT) { const int n = i >> 7, k8 = (i & 127) * 8; float v[8];
#pragma unroll
          for (int j = 0; j < 8; ++j) v[j] = (n < 32) ? w_re[(k8 + j) * 32 + n] : (n >= 128 && n < 132) ? w_rg[(k8 + j) * 4 + (n - 128)] : 0.f;
          u32x4 o; o.x = pk2(v[0], v[1]); o.y = pk2(v[2], v[3]); o.z = pk2(v[4], v[5]); o.w = pk2(v[6], v[7]); *(u32x4*)(wr + (size_t)n * 1024 + k8) = o; } }
    { float* wg8 = (float*)(ws + WS_WG8); for (int i = gt; i < 8192; i += NGT) wg8[i] = w_in[(size_t)(i & 1023) * 5640 + 2048 + (i >> 10)]; }
    { float* cs = (float*)(ws + WS_CS); const int* pos = (const int*)a.in[2];
      for (int i = gt; i < MTOK * 8; i += NGT) { const int row = i >> 3, f = i & 7; const float ang = (float)pos[row] * a.freq[f];
          double rv = (double)ang * 0.15915494309189535; rv -= rint(rv); const float ar = (float)(rv * 6.283185307179586);
          cs[(size_t)row * 16 + f] = cosf(ar); cs[(size_t)row * 16 + 8 + f] = sinf(ar); } }
}

template <bool GATES>
DI void p_modnorm(const float* xin, const float* nw, const float* scale, const float* shift, bf16_t* outp, const Args& a, LAS unsigned char* lds, int tid, int lane, int wave) {
    LAS float* wg = (LAS float*)lds;
    if (GATES) { const float* wg8 = (const float*)(a.ws + WS_WG8); for (int i = tid; i < 8192; i += NWAVES * 64) wg[i] = wg8[i]; __syncthreads(); }
    const int gw = blockIdx.x * NWAVES + wave;
    const int row0 = gw * 16, b = row0 >> 12;
    f32x4 A[4], Sh[4];
#pragma unroll
    for (int j = 0; j < 4; ++j) { const int c = 4 * lane + 256 * j; const f32x4 w = *(const f32x4*)(nw + c), sc = *(const f32x4*)(scale + b * 6144 + c); A[j] = w * (sc + 1.0f); Sh[j] = *(const f32x4*)(shift + b * 6144 + c); }
#pragma unroll 1
    for (int r = 0; r < 16; ++r) {
        const int row = row0 + r;
        f32x4 v[4]; float ss = 0.f;
#pragma unroll
        for (int j = 0; j < 4; ++j) { v[j] = *(const f32x4*)(xin + (size_t)row * 1024 + 4 * lane + 256 * j); const f32x4 q = v[j] * v[j]; ss += (q[0] + q[1]) + (q[2] + q[3]); }
        const float rstd = __builtin_amdgcn_rsqf(wave_sum(ss) * (1.0f / 1024.0f) + REPS);
#pragma unroll
        for (int j = 0; j < 4; ++j) { v[j] = v[j] * rstd * A[j] + Sh[j]; u32x2 o; o.x = pk2(v[j][0], v[j][1]); o.y = pk2(v[j][2], v[j][3]); *(u32x2*)(outp + (size_t)row * 1024 + 4 * lane + 256 * j) = o; }
        if (GATES) {
            float gd[8];
#pragma unroll
            for (int g = 0; g < 8; ++g) { float d = 0.f;
#pragma unroll
                for (int j = 0; j < 4; ++j) { const f32x4 w = *(const LAS f32x4*)(wg + g * 1024 + 4 * lane + 256 * j); const f32x4 p = v[j] * w; d += (p[0] + p[1]) + (p[2] + p[3]); }
                gd[g] = wave_sum(d); __builtin_amdgcn_sched_barrier(0); }
            if (lane < 8) { float val = 0.f;
#pragma unroll
                for (int g = 0; g < 8; ++g) val = (lane == g) ? gd[g] : val;
                const int hh = lane & 3, s = row & 4095;
                if (lane < 4) ((float*)(a.ws + WS_LOGI))[(size_t)(b * 4 + hh) * SEQ + s] = val + ((const float*)a.in[7])[hh];
                else ((float*)(a.ws + WS_LOGF))[(size_t)(b * 4 + hh) * SEQ + s] = logsigf(val + ((const float*)a.in[8])[hh]); }
        }
    }
}

__global__ void __launch_bounds__(NWAVES * 64, 2) fwd_kernel(Args args) {
    extern __shared__ __attribute__((aligned(16))) unsigned char lds_raw[];
    LAS unsigned char* lds = (LAS unsigned char*)lds_raw;
    volatile LAS unsigned* MISC = (volatile LAS unsigned*)(lds + MISC_OFF);
    const int tid = threadIdx.x, lane = tid & 63, wave = __builtin_amdgcn_readfirstlane(tid >> 6), G = gridDim.x;
    unsigned char* ws = args.ws;
    unsigned* ctl = (unsigned*)(ws + WS_CTL);
    for (int u = tid; u < (LDS_BYTES - RING_BYTES) / 4; u += NWAVES * 64) ((LAS unsigned*)(lds + RING_BYTES))[u] = 0u;
    __syncthreads();
    const bool multi = (args.ph_hi - args.ph_lo) > 1;
    XcdBarrier bar; bar.bar = ctl + CW_BAR; bar.x = 0; bar.st = nullptr;
    if (multi) bar = xcd_barrier_post(ctl + CW_BAR, MISC + 8);
    const int lo = args.ph_lo, hi = args.ph_hi;
#ifdef ONLY_PHASE
#define IN(k) ((k) == ONLY_PHASE && lo <= (k) && (k) < hi)
#else
#define IN(k) (lo <= (k) && (k) < hi)
#endif
#define SEAM(k) do { if (IN(k) && IN((k) + 1)) xcd_barrier(bar); } while (0)
    float* mod = (float*)(ws + WS_MOD);
    bf16_t* R1 = (bf16_t*)(ws + WS_R1);
    if (IN(0)) { p0_prologue(args, lds, tid, lane, wave); SEAM(0); }
    if (IN(1)) { p_modnorm<true>((const float*)args.in[0], (const float*)args.in[5], mod + 1024, mod, R1, args, lds, tid, lane, wave); SEAM(1); }
    if (IN(2)) {
        pg8::Gemm g{R1, (const bf16_t*)(ws + WS_WIN), 1024, 0}; pg8::StaticOrder S; S.init(MTOK, NIN, G, (int)blockIdx.x);
        EpiInProj E{(bf16_t*)(ws + WS_QM), (bf16_t*)(ws + WS_KM), (bf16_t*)(ws + WS_VM), (bf16_t*)(ws + WS_OG), (bf16_t*)(ws + WS_QD), (bf16_t*)(ws + WS_KD), (bf16_t*)(ws + WS_VD),
                    (bf16_t*)(ws + WS_GM), (bf16_t*)(ws + WS_GD), (const float*)(ws + WS_CS), (const float*)args.in[12], (const float*)args.in[13]};
        pg8::gemm_phase<EpiInProj, pg8::StaticOrder, true, false>(lds, g, S, E);
        SEAM(2);
    }
    if (IN(3)) {
        if (tid == 0) { const float *q1 = (const float*)args.in[14], *k1 = (const float*)args.in[15], *q2 = (const float*)args.in[16], *k2 = (const float*)args.in[17]; float s1 = 0.f, s2 = 0.f;
            for (int i = 0; i < 64; ++i) { s1 += q1[i] * k1[i]; s2 += q2[i] * k2[i]; }
            MISC[2] = __float_as_uint(__expf(s1) - __expf(s2) + 0.2f); }
        __syncthreads();
        const float lam = __uint_as_float(MISC[2]);
#ifndef NO_ML
        if (blockIdx.x < 32)
            ml::run((int)blockIdx.x, (const bf16_t*)(ws + WS_QM), (const bf16_t*)(ws + WS_KM), (const bf16_t*)(ws + WS_VM), (const bf16_t*)(ws + WS_OG), (const float*)(ws + WS_LOGI), (const float*)(ws + WS_LOGF),
                    (const float*)args.in[9], (const float*)args.in[10], (const float*)args.in[11], R1, (LAS char*)lds);
#endif
        const int x = blockIdx.x & 7;
        for (int s = 0; s < 8; ++s) { const int q = (x + s) & 7;
            for (;;) {
                if (tid == 0) MISC[0] = xb_add(ctl + CW_ATTQ + 64 * q, 1u);
                __syncthreads();
                const int i = (int)MISC[0];
                __syncthreads();
                if (i >= 128) break;
                const int qb = 31 - (i >> 2), bh = 4 * q + (i & 3);
#ifndef NO_ATT
                att::unit(bh >> 2, bh & 3, qb, (const bf16_t*)(ws + WS_QD), (const bf16_t*)(ws + WS_KD), (const bf16_t*)(ws + WS_VD), R1, lam, (const float*)args.in[18], (LAS char*)lds);
#endif
            } }
        SEAM(3);
    }
    if (IN(4)) {
        pg8::Gemm g{R1, (const bf16_t*)(ws + WS_WBR), 1024, 0}; pg8::StaticOrder S; S.init(MTOK, 1024, G, (int)blockIdx.x);
        EpiBranch E{(const bf16_t*)(ws + WS_GM), (const bf16_t*)(ws + WS_GD), (bf16_t*)(ws + WS_MG)};
        pg8::gemm_phase<EpiBranch, pg8::StaticOrder, true, false>(lds, g, S, E);
        SEAM(4);
    }
    if (IN(5)) {
        pg8::Gemm g{(const bf16_t*)(ws + WS_MG), (const bf16_t*)(ws + WS_WOUT), 1024, 0}; pg8::StaticOrder S; S.init(MTOK, 1024, G, (int)blockIdx.x);
        EpiOut E{(const float*)args.in[0], mod, args.out};
        pg8::gemm_phase<EpiOut, pg8::StaticOrder, true, false>(lds, g, S, E);
        SEAM(5);
    }
    if (IN(6)) { p_modnorm<false>(args.out, (const float*)args.in[22], mod + 4096, mod + 3072, R1, args, lds, tid, lane, wave); SEAM(6); }
    if (IN(7)) {
        pg8::Gemm g{R1, (const bf16_t*)(ws + WS_WR), 1024, 0}; pg8::StaticOrder S; S.init(MTOK, 256, G, (int)blockIdx.x);
        EpiRouter E{(const float*)args.in[24], (const float*)args.in[26], ctl + CW_CNT, (int*)(ws + WS_TOK), (float*)(ws + WS_WT), (float*)(ws + WS_ROUTE)};
        pg8::gemm_phase<EpiRouter, pg8::StaticOrder, true, false>(lds, g, S, E);
        SEAM(7);
    }
    if (IN(8) || IN(9) || IN(10)) {
        LAS int* pref = (LAS int*)(lds + PREF_OFF);
        if (tid == 0) { int acc = 0; for (int l = 0; l < 64; ++l) { pref[l] = acc; acc += (int)((__hip_atomic_load(ctl + CW_CNT + l, RLX_AGENT) + 255u) >> 8); } pref[64] = acc; }
        __syncthreads();
    }
    if (IN(8)) {
        const LAS int* pref = (const LAS int*)(lds + PREF_OFF);
        pg8::Gemm g{R1, (const bf16_t*)(ws + WS_WGU), 1024, (size_t)512 * 1024};
        GroupedOrder S{pref, 0, pref[64], 2, G, (int)blockIdx.x, (const int*)(ws + WS_TOK), ctl + CW_CNT};
        EpiGateUp E{(bf16_t*)(ws + WS_ACT)};
        pg8::gemm_phase<EpiGateUp, GroupedOrder, true, true>(lds, g, S, E);
        SEAM(8);
    }
#pragma unroll 1
    for (int rk = 0; rk < 2; ++rk) {
        if (IN(9 + rk)) {
            const LAS int* pref = (const LAS int*)(lds + PREF_OFF);
            pg8::Gemm g{(const bf16_t*)(ws + WS_ACT), (const bf16_t*)(ws + WS_WD), 256, (size_t)1024 * 256};
            GroupedOrder S{pref, pref[32 * rk], pref[32 * rk + 32], 4, G, (int)blockIdx.x, (const int*)(ws + WS_TOK), ctl + CW_CNT};
            EpiDown E{(const int*)(ws + WS_TOK), (const float*)(ws + WS_WT), ctl + CW_CNT, mod, args.out};
            pg8::gemm_phase<EpiDown, GroupedOrder, true, false>(lds, g, S, E);
            if (rk == 0) SEAM(9);
        }
    }
#undef IN
#undef SEAM
}
#ifdef DBG_ORACLE
constexpr int DBG_B = 1, DBG_T = 2048, NSTAGE = 19;
__device__ __forceinline__ void err_acc(float d2, float r2, float* err) {
    __shared__ float sh[2][256];
    const int tid = threadIdx.x; sh[0][tid] = d2; sh[1][tid] = r2; __syncthreads();
    for (int o = 128; o > 0; o >>= 1) { if (tid < o) { sh[0][tid] += sh[0][tid + o]; sh[1][tid] += sh[1][tid + o]; } __syncthreads(); }
    if (tid == 0) { atomicAdd(err, sh[0][0]); atomicAdd(err + 1, sh[1][0]); }
}
__global__ void k_cmp(const void* fast, int fb16, int ldf, const float* ref, int ldr, int cols, int tf, float* err) {
    const int r = blockIdx.x; float d2 = 0.f, r2 = 0.f;
    for (int c = threadIdx.x; c < cols; c += 256) {
        float f = fb16 ? bf2f(((const bf16_t*)fast)[(size_t)r * ldf + c]) : ((const float*)fast)[(size_t)r * ldf + c];
        float v = ref[(size_t)r * ldr + c]; if (tf == 1) v = 1.f / (1.f + expf(-v));
        d2 += (f - v) * (f - v); r2 += v * v; }
    err_acc(d2, r2, err);
}
__global__ void k_cmp_qk(const bf16_t* fast, const float* ref, float sc, float* err) {
    const int r = blockIdx.x; float d2 = 0.f, r2 = 0.f;
    for (int c = threadIdx.x; c < 512; c += 256) { const float f = bf2f(fast[(size_t)r * 512 + c]); const float v = ref[(size_t)r * 512 + (c & ~63) + dperm(c & 63)] * sc; d2 += (f - v) * (f - v); r2 += v * v; }
    err_acc(d2, r2, err);
}
__global__ void k_cmp_gates(const float* logi, const float* logf, const float* proj, const float* b_i, const float* b_f, float* err) {
    const int t = blockIdx.x * 256 + threadIdx.x; float d2 = 0.f, r2 = 0.f;
    for (int h = 0; h < 4; ++h) { const float vi = proj[(size_t)t * 5640 + 2048 + h] + b_i[h]; const float x = proj[(size_t)t * 5640 + 2052 + h] + b_f[h]; const float vf = fminf(x, 0.f) - log1pf(expf(-fabsf(x)));
        const float fi = logi[(size_t)(DBG_B * 4 + h) * 4096 + t], ff = logf[(size_t)(DBG_B * 4 + h) * 4096 + t];
        d2 += (fi - vi) * (fi - vi) + (ff - vf) * (ff - vf) * 100.f; r2 += vi * vi + vf * vf * 100.f; }
    err_acc(d2, r2, err);
}
__global__ void k_cmp_route(const float* fast, const float* ref, float* err) {
    const int t = blockIdx.x * 256 + threadIdx.x; const float* f = fast + (size_t)(DBG_B * 4096 + t) * 4; const float* r = ref + (size_t)t * 4;
    const float mis = (f[0] != r[0] || f[1] != r[1]) ? 1.f : 0.f;
    err_acc(mis * 0.03f, 1.0f, err);
}
__global__ void k_poison(float* out, size_t n, const float* err) {
    int bad = -1; float ratio = 0.f;
    for (int s = 0; s < NSTAGE; ++s) { const float d = err[2 * s], r = err[2 * s + 1]; if (!(d <= 9e-4f * r) || !(r > 0.f)) { bad = s; ratio = (r > 0.f) ? sqrtf(d / r) : 2.f; break; } }
    if (bad < 0) return;
    if (!(ratio < 2.f)) ratio = 2.f;
    const float Kf = powf(10.f, (float)(bad + 1)) * (1.f + ratio);
    for (size_t i = (size_t)blockIdx.x * 256 + threadIdx.x; i < n; i += (size_t)gridDim.x * 256) out[i] = out[i] * Kf;
}
#endif

static void launch_phases(Args a, int lo, int hi, hipStream_t stream) {
    a.ph_lo = lo; a.ph_hi = hi; void* kargs[] = {&a};
    hipError_t e = hipLaunchCooperativeKernel((const void*)fwd_kernel, dim3(256), dim3(NWAVES * 64), kargs, LDS_BYTES, stream);
    if (e != hipSuccess) fprintf(stderr, "kernel_launch: cooperative launch of phases [%d,%d) failed: %s\n", lo, hi, hipGetErrorString(e));
}
extern "C" void kernel_launch(void* const* d_in, const int* in_sizes, int n_in, void* d_out, int out_size, void* d_ws, size_t ws_size, hipStream_t stream) {
    static int state = 0;
    if (state == 0) {
        state = 1;
        if (n_in != 30 || out_size != MTOK * DMODEL || ws_size < WS_END + 26 * MiB) { fprintf(stderr, "kernel_launch: unexpected shapes (n_in %d out %d ws %zu)\n", n_in, out_size, ws_size); state = -1; }
        if (state > 0 && hipFuncSetAttribute((const void*)fwd_kernel, hipFuncAttributeMaxDynamicSharedMemorySize, LDS_BYTES) != hipSuccess) { fprintf(stderr, "kernel_launch: hipFuncSetAttribute failed\n"); state = -1; }
        int dev = 0, cus = 0, per_cu = 0; (void)hipGetDevice(&dev); (void)hipDeviceGetAttribute(&cus, hipDeviceAttributeMultiprocessorCount, dev);
        (void)hipOccupancyMaxActiveBlocksPerMultiprocessor(&per_cu, (const void*)fwd_kernel, NWAVES * 64, LDS_BYTES);
        if (state > 0 && (cus * per_cu < 256)) { fprintf(stderr, "kernel_launch: %d CUs x %d blocks cannot hold the 256-workgroup grid\n", cus, per_cu); state = -1; }
        (void)hipGetLastError();
    }
    if (state < 0) return;
    (void)hipMemsetAsync((char*)d_ws + WS_CTL, 0, CTL_ZERO_BYTES, stream);
    Args a{};
    for (int i = 0; i < 30; ++i) a.in[i] = d_in[i];
    a.out = (float*)d_out; a.ws = (unsigned char*)d_ws;
    for (int i = 0; i < 8; ++i) a.freq[i] = (float)std::pow(500000.0, -(double)(2 * i) / 16.0);
#ifndef DBG_ORACLE
#ifdef N_LAUNCH_PER_PHASE
    for (int p = 0; p < 11; ++p) launch_phases(a, p, p + 1, stream);
#else
    launch_phases(a, 0, 11, stream);
#endif
#else
    using namespace nv;
    char* ws = (char*)d_ws; float* err = (float*)(ws + WS_CTL) + CW_ERR;
    NaiveBuf B; naive_carve((char*)d_out, ws + WS_END, B, DBG_T);
    float* lamp = (float*)(ws + WS_END + 25 * MiB); float* outn = (float*)(ws + WS_END + 17 * MiB);
    k_mod<<<dim3(24, 8), 256, 0, stream>>>((const float*)d_in[1], (const float*)d_in[3], (const float*)d_in[4], B.mod);
    k_lam<<<1, 64, 0, stream>>>((const float*)d_in[14], (const float*)d_in[15], (const float*)d_in[16], (const float*)d_in[17], lamp);
    naive_batch(d_in, DBG_B, B, lamp, outn, DBG_T, stream);
    const size_t rb = (size_t)DBG_B * 4096;
    auto CMP = [&](int s, const void* fast, int fb16, int ldf, const float* ref, int ldr, int cols, int tf) { k_cmp<<<DBG_T, 256, 0, stream>>>(fast, fb16, ldf, ref, ldr, cols, tf, err + 2 * s); };
    launch_phases(a, 0, 1, stream);
    k_cmp<<<8, 256, 0, stream>>>(ws + WS_MOD, 0, 6144, B.mod, 6144, 6144, 0, err + 0);
    launch_phases(a, 1, 2, stream);
    CMP(1, (bf16_t*)(ws + WS_R1) + rb * 1024, 1, 1024, B.h, 1024, 1024, 0);
    k_cmp_gates<<<DBG_T / 256, 256, 0, stream>>>((const float*)(ws + WS_LOGI), (const float*)(ws + WS_LOGF), B.proj, (const float*)d_in[7], (const float*)d_in[8], err + 2 * 2);
    launch_phases(a, 2, 3, stream);
    CMP(3, (bf16_t*)(ws + WS_QM) + rb * 512, 1, 512, B.proj + 0, 5640, 512, 0);
    CMP(4, (bf16_t*)(ws + WS_KM) + rb * 512, 1, 512, B.proj + 512, 5640, 512, 0);
    CMP(5, (bf16_t*)(ws + WS_VM) + rb * 512, 1, 512, B.proj + 1024, 5640, 512, 0);
    CMP(6, (bf16_t*)(ws + WS_OG) + rb * 512, 1, 512, B.proj + 1536, 5640, 512, 1);
    k_cmp_qk<<<DBG_T, 256, 0, stream>>>((bf16_t*)(ws + WS_QD) + rb * 512, B.qd, QSCALE, err + 2 * 7);
    k_cmp_qk<<<DBG_T, 256, 0, stream>>>((bf16_t*)(ws + WS_KD) + rb * 512, B.kd, 1.0f, err + 2 * 8);
    CMP(9, (bf16_t*)(ws + WS_VD) + rb * 512, 1, 512, B.proj + 3080, 5640, 512, 0);
    CMP(10, (bf16_t*)(ws + WS_GM) + rb * 1024, 1, 1024, B.proj + 3592, 5640, 1024, 1);
    CMP(11, (bf16_t*)(ws + WS_GD) + rb * 1024, 1, 1024, B.proj + 4616, 5640, 1024, 1);
    launch_phases(a, 3, 4, stream);
    CMP(12, (bf16_t*)(ws + WS_R1) + rb * 1024, 1, 1024, B.hm, 512, 512, 0);
    CMP(13, (bf16_t*)(ws + WS_R1) + rb * 1024 + 512, 1, 1024, B.hd, 512, 512, 0);
    launch_phases(a, 4, 5, stream);
    CMP(14, (bf16_t*)(ws + WS_MG) + rb * 1024, 1, 1024, B.merged, 1024, 1024, 0);
    launch_phases(a, 5, 6, stream);
    CMP(15, (float*)d_out + rb * 1024, 0, 1024, B.x1, 1024, 1024, 0);
    launch_phases(a, 6, 7, stream);
    CMP(16, (bf16_t*)(ws + WS_R1) + rb * 1024, 1, 1024, B.h2, 1024, 1024, 0);
    launch_phases(a, 7, 8, stream);
    k_cmp_route<<<DBG_T / 256, 256, 0, stream>>>((const float*)(ws + WS_ROUTE), B.route, err + 2 * 17);
    launch_phases(a, 8, 9, stream); launch_phases(a, 9, 10, stream); launch_phases(a, 10, 11, stream);
    CMP(18, (float*)d_out + rb * 1024, 0, 1024, outn, 1024, 1024, 0);
    k_poison<<<1024, 256, 0, stream>>>((float*)d_out, (size_t)MTOK * DMODEL, err);
#endif
}
```

```cpp
#include <hip/hip_runtime.h>
#include <hip/hip_bf16.h>
#include <cstdio>
#include <cstdint>
#include <cmath>
#define LAS __attribute__((address_space(3)))
#define DI __device__ __forceinline__
typedef unsigned short bf16_t;
typedef short bf16x8 __attribute__((ext_vector_type(8)));
typedef short s16x4 __attribute__((ext_vector_type(4)));
typedef float f32x4 __attribute__((ext_vector_type(4)));
typedef float f32x16 __attribute__((ext_vector_type(16)));
typedef float f32x2 __attribute__((ext_vector_type(2)));
typedef unsigned u32x4 __attribute__((ext_vector_type(4)));
typedef unsigned u32x2 __attribute__((ext_vector_type(2)));
typedef __bf16 bf16x2_t __attribute__((ext_vector_type(2)));
DI unsigned pk2(float lo, float hi) { f32x2 v = {lo, hi}; bf16x2_t b = __builtin_convertvector(v, bf16x2_t); return __builtin_bit_cast(unsigned, b); }
DI float bflo(unsigned w) { return __uint_as_float(w << 16); }
DI float bfhi(unsigned w) { return __uint_as_float(w & 0xffff0000u); }
DI float bf2f(bf16_t u) { return __uint_as_float((unsigned)u << 16); }
DI float fexp(float x) { return __builtin_amdgcn_exp2f(x * 1.4426950408889634f); }
DI float fsigm(float x) { return __builtin_amdgcn_rcpf(1.f + fexp(-x)); }

namespace pg8 {
constexpr int BM = 256, BK = 64, HALF = 128, HTB = HALF * BK * 2, STAGE_BYTES = 8 * HTB, NXCD = 8, WGM = 8;
__host__ __device__ __forceinline__ int lds_byte(int r, int c) { const int st = (r >> 4) * 2 + (c >> 5), rr = r & 15, cc = c & 31, ob = rr * 64 + cc * 2; return st * 1024 + (ob ^ (((ob >> 9) & 1) << 5)); }
__host__ __device__ __forceinline__ void stage_rc(int b, int& R, int& C) { const int st = b / 1024, sb = b % 1024, swz = sb ^ (((sb >> 9) & 1) << 5); R = (st >> 1) * 16 + swz / 64; C = (st & 1) * 32 + (swz % 64) / 2; }
__host__ __device__ __forceinline__ int perm32(int rho) { const int n = rho >> 4, i = rho & 15; return 8 * (i >> 2) + 4 * n + (i & 3); }

struct Unit { int pm, pn, e, l, mt; };
typedef int v8i_t __attribute__((ext_vector_type(8)));
struct Gemm { const bf16_t* A; const bf16_t* Bt; int K; size_t bstride; int scale_b; };

struct StaticOrder {
    int nM, nN, nwg, G, c;
    __host__ __device__ void init(int M, int N, int G_, int c_) { nM = M / BM; nN = N / BM; nwg = nM * nN; G = G_; c = c_; }
    __host__ __device__ bool next(int i, Unit& u) const {
        const long L = (long)i * G + c; if (L >= nwg) return false;
        int wgid = (int)L; { const int q = nwg / NXCD, r = nwg % NXCD, xcd = wgid % NXCD, off = wgid / NXCD; wgid = (xcd < r ? xcd * (q + 1) : r * (q + 1) + (xcd - r) * q) + off; }
        const int nig = WGM * nN, gid = wgid / nig, fm = gid * WGM, gsz = (nM - fm) < WGM ? (nM - fm) : WGM;
        u.pm = fm + ((wgid % nig) % gsz); u.pn = (wgid % nig) / gsz; u.e = 0; u.l = 0; u.mt = 0; return true;
    }
    DI unsigned gather(const Unit&, int, int, int) const { return 0u; }
};

template <class Epi, class Sched, bool ALIGN_EPI, bool GATHER, bool FP8 = false>
DI void gemm_phase(LAS unsigned char* lds, const Gemm g, const Sched& S, const Epi& E) {
    const int tid = threadIdx.x, wid = __builtin_amdgcn_readfirstlane(tid >> 6), lane = tid & 63, wr = wid >> 2, wc = wid & 3, fr = lane & 15, fq = lane >> 4;
    const int RB = g.K * (FP8 ? 1 : 2), K = RB / 2, nt = RB / 128;
    unsigned voffA[2], voffB[2]; int gR[2], gC2[2];
#pragma unroll
    for (int i = 0; i < 2; ++i) { int R, C; stage_rc(tid * 16 + i * 8192, R, C); const int Rb = Epi::PERM ? ((R & ~31) + perm32(R & 31)) : R;
        voffA[i] = (unsigned)(R * K + C) * 2u; voffB[i] = (unsigned)(Rb * K + C) * 2u; gR[i] = R; gC2[i] = C * 2; }
    const size_t kstep = (size_t)(BK * 2);
    const size_t hstep = (size_t)HALF * K * 2;
    const size_t tstep = 2 * hstep;
    const unsigned ldsw = (unsigned)wid * 1024u;
    const int aoff = lds_byte(wr * 64 + fr, fq * 8), boff = lds_byte(wc * 32 + fr, fq * 8);
#define PG8_SA(b, h) (((b) * 2 + (h)) * HTB)
#define PG8_SB(b, h) ((4 + (b) * 2 + (h)) * HTB)
#define PG8_STAGE(bufoff, gbase, voff) do { _Pragma("unroll") for (int _i = 0; _i < 2; ++_i) \
        __builtin_amdgcn_global_load_lds((const unsigned*)((const char*)(gbase) + (voff)[_i]), (LAS unsigned*)(lds + (bufoff) + ldsw + _i * 8192), 16, 0, 0); } while (0)
#define PG8_STAGE_A(bufoff, dptr, h, kb, nx) do { if constexpr (GATHER) { unsigned _vo[2]; _vo[0] = (nx) ? gN[h][0] : gO[h][0]; _vo[1] = (nx) ? gN[h][1] : gO[h][1]; PG8_STAGE(bufoff, (const char*)g.A + (kb), _vo); } \
        else { PG8_STAGE(bufoff, dptr, voffA); } } while (0)
#define PG8_LDF(dst, off_) do { const u32x4 lo_ = *(const LAS u32x4*)(lds + (off_)), hi_ = *(const LAS u32x4*)(lds + (off_) + 1024); \
        dst = (v8i_t){(int)lo_.x, (int)lo_.y, (int)lo_.z, (int)lo_.w, (int)hi_.x, (int)hi_.y, (int)hi_.z, (int)hi_.w}; } while (0)
#define PG8_LDA(dst, b, h) do { _Pragma("unroll") for (int m = 0; m < 4; ++m) PG8_LDF(dst[m], PG8_SA(b, h) + aoff + m * 2048); } while (0)
#define PG8_LDB(dst, b, h) do { _Pragma("unroll") for (int n = 0; n < 2; ++n) PG8_LDF(dst[n], PG8_SB(b, h) + boff + n * 2048); } while (0)
#define PG8_LO(f) __builtin_bit_cast(bf16x8, (u32x4){(unsigned)f[0], (unsigned)f[1], (unsigned)f[2], (unsigned)f[3]})
#define PG8_HI(f) __builtin_bit_cast(bf16x8, (u32x4){(unsigned)f[4], (unsigned)f[5], (unsigned)f[6], (unsigned)f[7]})
#define PG8_MMA(ai, bj, At, Bt) do { __builtin_amdgcn_s_setprio(1); _Pragma("unroll") for (int m = 0; m < 4; ++m) _Pragma("unroll") for (int n = 0; n < 2; ++n) { \
        if constexpr (FP8) asm volatile("v_mfma_f32_16x16x128_f8f6f4 %0, %1, %2, %0" : "+v"(acc[ai][bj][m][n]) : "v"(Bt[n]), "v"(At[m]));   \
        else { acc[ai][bj][m][n] = __builtin_amdgcn_mfma_f32_16x16x32_bf16(PG8_LO(Bt[n]), PG8_LO(At[m]), acc[ai][bj][m][n], 0, 0, 0); \
               acc[ai][bj][m][n] = __builtin_amdgcn_mfma_f32_16x16x32_bf16(PG8_HI(Bt[n]), PG8_HI(At[m]), acc[ai][bj][m][n], 0, 0, 0); } } \
        __builtin_amdgcn_s_setprio(0); } while (0)
#define PG8_WAIT_V(n) asm volatile("s_waitcnt vmcnt(" #n ")" ::: "memory")
#define PG8_WAIT_L(n) asm volatile("s_waitcnt lgkmcnt(" #n ")" ::: "memory")
#define PG8_BAR __builtin_amdgcn_s_barrier()
#define PG8_SCHED __builtin_amdgcn_sched_barrier(0)
    Unit cur, nxt; int ui = 0;
    if (!S.next(0, cur)) return;
    f32x4 acc[2][2][4][2];
#pragma unroll
    for (int a = 0; a < 2; ++a)
#pragma unroll
        for (int b = 0; b < 2; ++b)
#pragma unroll
            for (int m = 0; m < 4; ++m)
#pragma unroll
                for (int n = 0; n < 2; ++n) acc[a][b][m][n] = (f32x4){0.f, 0.f, 0.f, 0.f};
    v8i_t At[4], B0[2], B1[2];
    unsigned gO[2][2], gN[2][2];
    if constexpr (GATHER) {
#pragma unroll
        for (int h = 0; h < 2; ++h)
#pragma unroll
            for (int i = 0; i < 2; ++i) { gO[h][i] = S.gather(cur, h * HALF + gR[i], gC2[i], K); gN[h][i] = gO[h][i]; }
    } else { gO[0][0] = gO[0][1] = gO[1][0] = gO[1][1] = 0u; gN[0][0] = gN[0][1] = gN[1][0] = gN[1][1] = 0u; }
    const char* cA = (const char*)g.A + (GATHER ? (size_t)0 : (size_t)cur.pm * tstep);
    const char* cB = (const char*)g.Bt + ((size_t)cur.e * g.bstride) * (FP8 ? 1 : 2) + (size_t)cur.pn * tstep;
    PG8_STAGE(PG8_SB(0, 0), cB, voffB); PG8_STAGE(PG8_SB(0, 1), cB + hstep, voffB); PG8_STAGE_A(PG8_SA(0, 0), cA, 0, 0, false); PG8_STAGE_A(PG8_SA(0, 1), cA + hstep, 1, 0, false);
    if (wr == 1) PG8_BAR;
    PG8_WAIT_V(2); PG8_BAR;
    PG8_STAGE(PG8_SB(1, 0), cB + kstep, voffB); PG8_STAGE_A(PG8_SA(1, 0), cA + kstep, 0, kstep, false); PG8_STAGE(PG8_SB(1, 1), cB + hstep + kstep, voffB);
    PG8_WAIT_V(6); PG8_BAR;
    for (;;) {
        const bool has_next = S.next(ui + 1, nxt);
        if constexpr (GATHER) {
            if (has_next) {
#pragma unroll
                for (int h = 0; h < 2; ++h)
#pragma unroll
                    for (int i = 0; i < 2; ++i) gN[h][i] = S.gather(nxt, h * HALF + gR[i], gC2[i], K);
            } else {
#pragma unroll
                for (int h = 0; h < 2; ++h)
#pragma unroll
                    for (int i = 0; i < 2; ++i) gN[h][i] = gO[h][i];
            }
        }
        const char* nA = GATHER ? cA : (has_next ? (const char*)g.A + (size_t)nxt.pm * tstep : cA);
        const char* nB = has_next ? (const char*)g.Bt + ((size_t)nxt.e * g.bstride) * (FP8 ? 1 : 2) + (size_t)nxt.pn * tstep : cB;
#pragma unroll 1
        for (int t = 0; t < nt; t += 2) {
            if constexpr (Epi::HAS_MID) { if (t == Epi::MID_T) { E.mid(acc, cur, wr, wc, fr, fq); PG8_SCHED; } }
            const bool last = (t == nt - 2);
            const char* a1 = cA + (size_t)(t + 1) * kstep;
            const char* a2 = last ? nA : cA + (size_t)(t + 2) * kstep; const char* b2 = last ? nB : cB + (size_t)(t + 2) * kstep;
            const char* a3 = a2 + kstep; const char* b3 = b2 + kstep;
            const size_t k1 = (size_t)(t + 1) * kstep, k2 = last ? (size_t)0 : (size_t)(t + 2) * kstep, k3 = k2 + kstep;
            PG8_LDB(B0, 0, 0); PG8_LDB(B1, 0, 1); PG8_SCHED; PG8_LDA(At, 0, 0); PG8_STAGE_A(PG8_SA(1, 1), a1 + hstep, 1, k1, false);
            PG8_WAIT_V(8); PG8_WAIT_L(0); PG8_BAR; PG8_MMA(0, 0, At, B0); PG8_MMA(0, 1, At, B1); PG8_BAR; PG8_SCHED;
            PG8_LDA(At, 0, 1); PG8_STAGE(PG8_SB(0, 0), b2, voffB); PG8_STAGE(PG8_SB(0, 1), b2 + hstep, voffB); PG8_STAGE_A(PG8_SA(0, 0), a2, 0, k2, last);
            PG8_WAIT_V(8); PG8_WAIT_L(0); PG8_BAR; PG8_MMA(1, 0, At, B0); PG8_MMA(1, 1, At, B1); PG8_BAR; PG8_SCHED;
            PG8_LDB(B0, 1, 0); PG8_LDB(B1, 1, 1); PG8_SCHED; PG8_LDA(At, 1, 0); PG8_STAGE_A(PG8_SA(0, 1), a2 + hstep, 1, k2, last);
            PG8_WAIT_V(8); PG8_WAIT_L(0); PG8_BAR; PG8_MMA(0, 0, At, B0); PG8_MMA(0, 1, At, B1); PG8_BAR; PG8_SCHED;
            PG8_LDA(At, 1, 1); PG8_STAGE(PG8_SB(1, 0), b3, voffB); PG8_STAGE(PG8_SB(1, 1), b3 + hstep, voffB); PG8_STAGE_A(PG8_SA(1, 0), a3, 0, k3, last);
            PG8_WAIT_V(8); PG8_WAIT_L(0); PG8_BAR; PG8_MMA(1, 0, At, B0); PG8_MMA(1, 1, At, B1); PG8_BAR; PG8_SCHED;
        }
        if constexpr (ALIGN_EPI) { if (wr == 0) PG8_BAR; }
        if constexpr (FP8) asm volatile("s_nop 15\n\ts_nop 15" : "+v"(acc[1][1][0][0]), "+v"(acc[1][1][0][1]), "+v"(acc[1][1][1][0]), "+v"(acc[1][1][1][1]), "+v"(acc[1][1][2][0]), "+v"(acc[1][1][2][1]), "+v"(acc[1][1][3][0]), "+v"(acc[1][1][3][1]));
        E(acc, cur, wr, wc, fr, fq);
        if (!has_next) break;
#pragma unroll
        for (int a = 0; a < 2; ++a)
#pragma unroll
            for (int b = 0; b < 2; ++b)
#pragma unroll
                for (int m = 0; m < 4; ++m)
#pragma unroll
                    for (int n = 0; n < 2; ++n) acc[a][b][m][n] = (f32x4){0.f, 0.f, 0.f, 0.f};
        cur = nxt; cA = nA; cB = nB; ++ui;
        if constexpr (GATHER) {
#pragma unroll
            for (int h = 0; h < 2; ++h)
#pragma unroll
                for (int i = 0; i < 2; ++i) gO[h][i] = gN[h][i];
        }
        if constexpr (ALIGN_EPI) { if (wr == 1) PG8_BAR; }
    }
    PG8_WAIT_V(0);
    if constexpr (!ALIGN_EPI) { if (wr == 0) PG8_BAR; }
    PG8_BAR;
#undef PG8_SA
#undef PG8_SB
#undef PG8_STAGE
#undef PG8_STAGE_A
#undef PG8_LDA
#undef PG8_LDF
#undef PG8_LO
#undef PG8_HI
#undef PG8_LDB
#undef PG8_MMA
#undef PG8_WAIT_V
#undef PG8_WAIT_L
#undef PG8_BAR
#undef PG8_SCHED
}
}
constexpr int NBATCH = 8, SEQ = 4096, MTOK = 32768, DMODEL = 1024, NIN = 5632;
constexpr float QSCALE = 0.125f * 1.4426950408889634f;
constexpr float REPS = 1e-6f;
constexpr size_t MiB = 1u << 20;
constexpr size_t WS_CTL = 0, CTL_ZERO_BYTES = 128 * 1024;
constexpr size_t WS_MOD = 1 * MiB, WS_WG8 = 1 * MiB + 256 * 1024, WS_ROUTE = 1 * MiB + 512 * 1024;
constexpr size_t WS_CS = 2 * MiB, WS_LOGI = 4 * MiB, WS_LOGF = 4 * MiB + 512 * 1024, WS_WR = 5 * MiB;
constexpr size_t WS_WIN = 6 * MiB, WS_WBR = 17 * MiB, WS_WOUT = 19 * MiB, WS_WGU = 21 * MiB, WS_WD = 53 * MiB;
constexpr size_t WS_R1 = 70 * MiB;
constexpr size_t WS_QM = 134 * MiB, WS_KM = 166 * MiB, WS_VM = 198 * MiB, WS_OG = 230 * MiB;
constexpr size_t WS_QD = 262 * MiB, WS_KD = 294 * MiB, WS_VD = 326 * MiB;
constexpr size_t WS_GM = 358 * MiB, WS_GD = 422 * MiB;
constexpr size_t WS_MG = WS_QM;
constexpr size_t WS_TOK = WS_VM, WS_WT = WS_VM + 8 * MiB;
constexpr size_t WS_Y = 302 * MiB;
constexpr size_t WS_H2F = WS_VD;
constexpr size_t WS_T = WS_GD;
constexpr size_t WS_X1B = WS_MG;
constexpr size_t WS_ACT = WS_QD;
constexpr size_t WS_END = 486 * MiB;
constexpr size_t WS_MODP = 488 * MiB;
constexpr size_t WS_NT = 486 * MiB, WS_SC = 487 * MiB, WS_MIN = 487 * MiB + 65536;
constexpr int CW_BAR = 4096, CW_ATTQ = 8192, CW_CNT = 12288, CW_ERR = 16384;

__host__ __device__ __forceinline__ int dperm(int p) { return p < 16 ? (8 * ((p >> 2) & 1) + 4 * (p >> 3) + (p & 3)) : p; }
__host__ __device__ __forceinline__ int win_col(int L) {
    if (L < 2048) return L;
    if (L < 3072) { const int Lp = L - 2048, isk = Lp >> 9, Lt = Lp & 511, th = Lt >> 8, P = Lt & 255, bj = P >> 7, g = (P >> 5) & 3, r = P & 31;
        return (isk ? 2568 : 2056) + 64 * (4 * th + g) + dperm(32 * bj + r); }
    if (L < 3584) return 3080 + (L - 3072);
    { const int Lg = L - 3584, k = Lg >> 8, P = Lg & 255, bj = P >> 7, c = P & 127; return (bj ? 4616 : 3592) + 128 * k + c; }
}

using pg8::Unit;
DI u32x4 pack8(const f32x4& a, const f32x4& b) { u32x4 w; w.x = pk2(a[0], a[1]); w.y = pk2(a[2], a[3]); w.z = pk2(b[0], b[1]); w.w = pk2(b[2], b[3]); return w; }
DI float bfidx(const u32x4& w, int i) { const unsigned x = (i < 2) ? w.x : (i < 4) ? w.y : (i < 6) ? w.z : w.w; return (i & 1) ? bfhi(x) : bflo(x); }

struct EpiInProj {
    static constexpr bool PERM = true, HAS_MID = false; static constexpr int MID_T = 0;
    bf16_t *QM, *KM, *VM, *OG, *QD, *KD, *VD, *GM, *GD; const float* cs; const float *qnw, *knw;
    DI void mid(f32x4 (&)[2][2][4][2], const Unit&, int, int, int, int) const {}
    DI void operator()(const f32x4 (&acc)[2][2][4][2], const Unit& u, int wr, int wc, int fr, int fq) const {
        asm volatile("" : "+v"(fr), "+v"(fq));
        const int pn = u.pn, row0 = u.pm * 256 + wr * 64 + fr;
        constexpr float WSC = 1.0f / 32.0f;
        if (pn >= 8 && pn < 12) {
            const bool isk = pn >= 10; const int grp = 4 * (pn & 1) + wc;
            bf16_t* dst = isk ? KD : QD; const float* nw = isk ? knw : qnw;
            f32x4 w[2][2];
#pragma unroll
            for (int n = 0; n < 2; ++n) { w[0][n] = *(const f32x4*)(nw + (fq < 2 ? (8 * n + 4 * fq) : (8 * fq + 4 * n))); w[1][n] = *(const f32x4*)(nw + 32 + 8 * fq + 4 * n); }
            const float osc = isk ? 1.0f : QSCALE;
#pragma unroll
            for (int ai = 0; ai < 2; ++ai)
#pragma unroll
                for (int m = 0; m < 4; ++m) {
                    const int row = row0 + ai * 128 + m * 16;
                    f32x4 y[2][2]; float ss = 0.f;
#pragma unroll
                    for (int bj = 0; bj < 2; ++bj)
#pragma unroll
                        for (int n = 0; n < 2; ++n) { y[bj][n] = acc[ai][bj][m][n] * WSC; const f32x4 q = y[bj][n] * y[bj][n]; ss += (q[0] + q[1]) + (q[2] + q[3]); }
                    ss += __shfl_xor(ss, 16); ss += __shfl_xor(ss, 32);
                    const float rstd = __builtin_amdgcn_rsqf(ss * (1.0f / 64.0f) + REPS);
#pragma unroll
                    for (int bj = 0; bj < 2; ++bj)
#pragma unroll
                        for (int n = 0; n < 2; ++n) y[bj][n] = y[bj][n] * rstd * w[bj][n];
                    if (fq < 2) {
                        const f32x4 c4 = *(const f32x4*)(cs + (size_t)row * 16 + 4 * fq), s4 = *(const f32x4*)(cs + (size_t)row * 16 + 8 + 4 * fq);
                        const f32x4 a = y[0][0], b = y[0][1];
                        y[0][0] = a * c4 - b * s4; y[0][1] = b * c4 + a * s4;
                    }
#pragma unroll
                    for (int bj = 0; bj < 2; ++bj) *(u32x4*)(dst + (size_t)row * 512 + 64 * grp + 32 * bj + 8 * fq) = pack8(y[bj][0] * osc, y[bj][1] * osc);
                }
            return;
        }
        if (pn >= 14) {
            const int colg = (pn - 14) * 128 + wc * 32 + 8 * fq;
#pragma unroll
            for (int ai = 0; ai < 2; ++ai)
#pragma unroll
                for (int m = 0; m < 4; ++m) { f32x4 r[2], d[2];
#pragma unroll
                    for (int n = 0; n < 2; ++n)
#pragma unroll
                        for (int j = 0; j < 4; ++j) { const float sa = fsigm(acc[ai][0][m][n][j] * WSC), sb = fmaxf(fsigm(acc[ai][1][m][n][j] * WSC), 1e-30f); d[n][j] = sb; r[n][j] = sa * __builtin_amdgcn_rcpf(sb); }
                    const size_t off = (size_t)(row0 + ai * 128 + m * 16) * 1024 + colg;
                    *(u32x4*)(GM + off) = pack8(r[0], r[1]); *(u32x4*)(GD + off) = pack8(d[0], d[1]); }
            return;
        }
        bf16_t* base; int ld, colt; bool sg;
        if (pn < 8) { base = pn < 2 ? QM : pn < 4 ? KM : pn < 6 ? VM : OG; ld = 512; colt = (pn & 1) * 256; sg = pn >= 6; }
        else { base = VD; ld = 512; colt = (pn & 1) * 256; sg = false; }
        const int col0 = colt + wc * 32 + 8 * fq;
#pragma unroll
        for (int ai = 0; ai < 2; ++ai)
#pragma unroll
            for (int m = 0; m < 4; ++m) { bf16_t* rowp = base + (size_t)(row0 + ai * 128 + m * 16) * ld + col0;
#pragma unroll
                for (int bj = 0; bj < 2; ++bj) { f32x4 v0 = acc[ai][bj][m][0] * WSC, v1 = acc[ai][bj][m][1] * WSC;
                    if (sg) {
#pragma unroll
                        for (int j = 0; j < 4; ++j) { v0[j] = fsigm(v0[j]); v1[j] = fsigm(v1[j]); } }
                    *(u32x4*)(rowp + bj * 128) = pack8(v0, v1); } }
    }
};

struct EpiBranch {
    static constexpr bool PERM = true, HAS_MID = true; static constexpr int MID_T = 8;
    const bf16_t *GM, *GD; bf16_t* MG;
    DI void mid(f32x4 (&acc)[2][2][4][2], const Unit& u, int wr, int wc, int fr, int fq) const {
        unsigned lo = (unsigned)((wr * 64 + fr) * 1024 + wc * 32 + 8 * fq); asm volatile("" : "+v"(lo));
        const size_t ub = (size_t)u.pm * 256 * 1024 + (size_t)u.pn * 256; const bf16_t* gmb = GM + ub;
#pragma unroll
        for (int ai = 0; ai < 2; ++ai)
#pragma unroll
            for (int m = 0; m < 4; ++m)
#pragma unroll
                for (int bj = 0; bj < 2; ++bj) { const unsigned off = lo + (unsigned)((ai * 128 + m * 16) * 1024 + bj * 128);
                    const u32x4 gm = *(const u32x4*)(gmb + off);
#pragma unroll
                    for (int n = 0; n < 2; ++n)
#pragma unroll
                        for (int j = 0; j < 4; ++j) acc[ai][bj][m][n][j] *= bfidx(gm, 4 * n + j);
                    if (bj == 1 && (m & 1)) asm volatile("" ::: "memory"); }
    }
    DI void operator()(const f32x4 (&acc)[2][2][4][2], const Unit& u, int wr, int wc, int fr, int fq) const {
        unsigned lo = (unsigned)((wr * 64 + fr) * 1024 + wc * 32 + 8 * fq); asm volatile("" : "+v"(lo));
        const size_t ub = (size_t)u.pm * 256 * 1024 + (size_t)u.pn * 256; const bf16_t* gdb = GD + ub; bf16_t* mgb = MG + ub;
#pragma unroll
        for (int ai = 0; ai < 2; ++ai)
#pragma unroll
            for (int m = 0; m < 4; ++m)
#pragma unroll
                for (int bj = 0; bj < 2; ++bj) { const unsigned off = lo + (unsigned)((ai * 128 + m * 16) * 1024 + bj * 128);
                    const u32x4 gd = *(const u32x4*)(gdb + off); f32x4 v[2];
#pragma unroll
                    for (int n = 0; n < 2; ++n)
#pragma unroll
                        for (int j = 0; j < 4; ++j) v[n][j] = acc[ai][bj][m][n][j] * fmaxf(bfidx(gd, 4 * n + j), 1e-30f);
                    *(u32x4*)(mgb + off) = pack8(v[0], v[1]); if (bj == 1 && (m & 1)) asm volatile("" ::: "memory"); }
    }
};

struct EpiOut {
    static constexpr bool PERM = true, HAS_MID = false; static constexpr int MID_T = 0;
    const float* mod; bf16_t* T;
    DI void mid(f32x4 (&)[2][2][4][2], const Unit&, int, int, int, int) const {}
    DI void operator()(const f32x4 (&acc)[2][2][4][2], const Unit& u, int wr, int wc, int fr, int fq) const {
        const int row0 = u.pm * 256 + wr * 64 + fr, col0 = u.pn * 256 + wc * 32 + 8 * fq; const int b = u.pm >> 4;
        f32x4 gv[2][2];
#pragma unroll
        for (int bj = 0; bj < 2; ++bj)
#pragma unroll
            for (int n = 0; n < 2; ++n) gv[bj][n] = *(const f32x4*)(mod + b * 6144 + 2048 + col0 + bj * 128 + n * 4);
#pragma unroll
        for (int ai = 0; ai < 2; ++ai)
#pragma unroll
            for (int m = 0; m < 4; ++m) { bf16_t* rowp = T + (size_t)(row0 + ai * 128 + m * 16) * 1024 + col0;
#pragma unroll
                for (int bj = 0; bj < 2; ++bj) *(u32x4*)(rowp + bj * 128) = pack8(gv[bj][0] * acc[ai][bj][m][0], gv[bj][1] * acc[ai][bj][m][1]); }
    }
};

struct EpiRouter {
    static constexpr bool PERM = false, HAS_MID = false; static constexpr int MID_T = 0;
    const float *brg, *bre; unsigned* cnt; int* tok; float* wt; float* route;
    DI void mid(f32x4 (&)[2][2][4][2], const Unit&, int, int, int, int) const {}
    DI void operator()(const f32x4 (&acc)[2][2][4][2], const Unit& u, int wr, int wc, int fr, int fq) const {
        if (wc != 0) return;
        const int row0 = u.pm * 256 + wr * 64 + fr;
        const f32x4 bg = *(const f32x4*)brg;
        int L1v[8], L2v[8]; float w1v[8], w2v[8];
#pragma unroll
        for (int ai = 0; ai < 2; ++ai)
#pragma unroll
            for (int m = 0; m < 4; ++m) {
                float gl[4];
#pragma unroll
                for (int j = 0; j < 4; ++j) gl[j] = __shfl(acc[ai][1][m][0][j], fr) + bg[j];
                int g = 0; float gmx = gl[0];
#pragma unroll
                for (int j = 1; j < 4; ++j) if (gl[j] > gmx) { gmx = gl[j]; g = j; }
                float gs = 0.f;
#pragma unroll
                for (int j = 0; j < 4; ++j) gs += fexp(gl[j] - gmx);
                const float pg = 1.0f / gs;
                f32x4 sel0 = acc[ai][0][m][0], sel1 = acc[ai][0][m][1];
                asm volatile("" : "+v"(sel0), "+v"(sel1));
                f32x4 sel;
#pragma unroll
                for (int j = 0; j < 4; ++j) sel[j] = (g & 2) ? sel1[j] : sel0[j];
                const int srcA = fr + 32 * (g & 1), srcB = srcA + 16;
                float el[8];
#pragma unroll
                for (int j = 0; j < 4; ++j) { el[j] = __shfl(sel[j], srcA) + bre[8 * g + j]; el[4 + j] = __shfl(sel[j], srcB) + bre[8 * g + 4 + j]; }
                int j1 = 0; float m1 = el[0];
#pragma unroll
                for (int j = 1; j < 8; ++j) if (el[j] > m1) { m1 = el[j]; j1 = j; }
                int j2 = -1; float m2 = -INFINITY;
#pragma unroll
                for (int j = 0; j < 8; ++j) if (j != j1 && el[j] > m2) { m2 = el[j]; j2 = j; }
                const float e2 = fexp(m2 - m1);
                L1v[ai * 4 + m] = 8 * g + j1; L2v[ai * 4 + m] = 32 + 8 * g + j2; w1v[ai * 4 + m] = pg / (1.f + e2); w2v[ai * 4 + m] = pg * e2 / (1.f + e2);
            }
        if (fq == 0) {
            unsigned p1[8], p2[8];
#pragma unroll
            for (int i = 0; i < 8; ++i) { p1[i] = atomicAdd(cnt + 64 * L1v[i], 1u); p2[i] = atomicAdd(cnt + 64 * L2v[i], 1u); }
#pragma unroll
            for (int i = 0; i < 8; ++i) { const int row = row0 + (i >> 2) * 128 + (i & 3) * 16;
                tok[(size_t)L1v[i] * 32768 + p1[i]] = row; wt[(size_t)L1v[i] * 32768 + p1[i]] = w1v[i];
                tok[(size_t)L2v[i] * 32768 + p2[i]] = row; wt[(size_t)L2v[i] * 32768 + p2[i]] = w2v[i];
                *(u32x4*)(route + (size_t)row * 4) = (u32x4){(unsigned)L1v[i] * 32768u + p1[i], (unsigned)L2v[i] * 32768u + p2[i], __float_as_uint(w1v[i]), __float_as_uint(w2v[i])}; }
        }
    }
};

struct GroupedOrder {
    const LAS int* pref;
    int nx, nN, j; const int* tok; const unsigned* cnt;
    DI bool next(int i, Unit& u) const {
        const int un = i * 32 + j; if (un >= nx * nN) return false;
        const int gm = ((const LAS unsigned short*)(pref + 160))[un / nN]; int l = ((const LAS unsigned char*)(pref + 72))[gm];
        l = __builtin_amdgcn_readfirstlane(l); const int mt = __builtin_amdgcn_readfirstlane(gm - pref[l]);
        u.pm = __builtin_amdgcn_readfirstlane(gm); u.pn = __builtin_amdgcn_readfirstlane(un % nN); u.e = l & 31; u.l = l; u.mt = mt; return true;
    }
    DI unsigned gather(const Unit& u, int r, int c2, int K) const {
        const int n = (int)cnt[64 * u.l]; int idx = u.mt * 256 + r; idx = idx < n ? idx : n - 1;
        return (unsigned)tok[(size_t)u.l * 32768 + idx] * (unsigned)(K * 2) + (unsigned)c2;
    }
};
struct EpiGateUp {
    static constexpr bool PERM = true, HAS_MID = false; static constexpr int MID_T = 0;
    bf16_t* ACT;
    DI void mid(f32x4 (&)[2][2][4][2], const Unit&, int, int, int, int) const {}
    DI void operator()(const f32x4 (&acc)[2][2][4][2], const Unit& u, int wr, int wc, int fr, int fq) const {
        const int row0 = u.pm * 256 + wr * 64 + fr, col0 = u.pn * 128 + wc * 32 + 8 * fq;
#pragma unroll
        for (int ai = 0; ai < 2; ++ai)
#pragma unroll
            for (int m = 0; m < 4; ++m) { f32x4 v[2];
#pragma unroll
                for (int n = 0; n < 2; ++n)
#pragma unroll
                    for (int j = 0; j < 4; ++j) { const float gg = acc[ai][0][m][n][j]; v[n][j] = gg * fsigm(gg) * acc[ai][1][m][n][j]; }
                *(u32x4*)(ACT + (size_t)(row0 + ai * 128 + m * 16) * 256 + col0) = pack8(v[0], v[1]); }
    }
};
__host__ __device__ __forceinline__ int wd_col(int P) { const int bj = P >> 7, wc = (P >> 5) & 3, fq = (P >> 3) & 3, i = P & 7; return 64 * wc + 16 * fq + 8 * bj + i; }
struct EpiDownY {
    static constexpr bool PERM = true, HAS_MID = false; static constexpr int MID_T = 0;
    unsigned char* Y;
    DI void mid(f32x4 (&)[2][2][4][2], const Unit&, int, int, int, int) const {}
    DI void operator()(const f32x4 (&acc)[2][2][4][2], const Unit& u, int wr, int wc, int fr, int fq) const {
        const int row0 = u.pm * 256 + wr * 64 + fr, col0 = u.pn * 256 + 64 * wc + 16 * fq;
#pragma unroll
        for (int ai = 0; ai < 2; ++ai)
#pragma unroll
            for (int m = 0; m < 4; ++m) { u32x4 w;
                w.x = __builtin_amdgcn_cvt_pk_fp8_f32(acc[ai][0][m][0][2], acc[ai][0][m][0][3], __builtin_amdgcn_cvt_pk_fp8_f32(acc[ai][0][m][0][0], acc[ai][0][m][0][1], 0, false), true);
                w.y = __builtin_amdgcn_cvt_pk_fp8_f32(acc[ai][0][m][1][2], acc[ai][0][m][1][3], __builtin_amdgcn_cvt_pk_fp8_f32(acc[ai][0][m][1][0], acc[ai][0][m][1][1], 0, false), true);
                w.z = __builtin_amdgcn_cvt_pk_fp8_f32(acc[ai][1][m][0][2], acc[ai][1][m][0][3], __builtin_amdgcn_cvt_pk_fp8_f32(acc[ai][1][m][0][0], acc[ai][1][m][0][1], 0, false), true);
                w.w = __builtin_amdgcn_cvt_pk_fp8_f32(acc[ai][1][m][1][2], acc[ai][1][m][1][3], __builtin_amdgcn_cvt_pk_fp8_f32(acc[ai][1][m][1][0], acc[ai][1][m][1][1], 0, false), true);
                *(u32x4*)(Y + (size_t)(row0 + ai * 128 + m * 16) * 1024 + col0) = w; }
    }
};
namespace att {
typedef short v4i16_t __attribute__((ext_vector_type(4)));
constexpr int XP = 132;
constexpr int OFF_WS = 69632;
DI int crow(int r, int hi) { return (r & 3) + 8 * (r >> 2) + 4 * hi; }
DI s16x4 vtr(const LAS char* p) { return __builtin_bit_cast(s16x4, __builtin_amdgcn_ds_read_tr16_b64_v4i16((LAS v4i16_t*)p)); }

DI void unit(int b, int h, int qb, const bf16_t* __restrict__ QD, const bf16_t* __restrict__ KD, const bf16_t* __restrict__ VD, bf16_t* HMD, float lam, const float* subw, LAS char* lds) {
    int tid = threadIdx.x; asm volatile("" : "+v"(tid));
    const int lane = tid & 63, wid = __builtin_amdgcn_readfirstlane(tid >> 6), r32 = lane & 31, hi = lane >> 5, map = wid >> 2, wq = wid & 3;
    const int q0 = qb * 128, NT = 2 * qb + 2; const size_t rowbase = (size_t)b * SEQ;
    asm volatile("s_waitcnt vmcnt(0)" ::: "memory");
    const bf16_t* kub = KD + rowbase * 512 + h * 128; const bf16_t* vub = VD + rowbase * 512 + h * 128;
    unsigned kgo[2], vgo[2];
#pragma unroll
    for (int i = 0; i < 2; ++i) { const int id = tid + 512 * i;
        kgo[i] = (unsigned)((id & 63) * 512 + (id >> 6) * 8);
        vgo[i] = (unsigned)(((id >> 2) & 63) * 512 + (id >> 8) * 32 + (id & 3) * 8); }
    const unsigned dmaw = (unsigned)wid * 1024u;
#define ATT_DMA(t) do { const unsigned st_ = ((unsigned)(t) & 3u) * 32768u; _Pragma("unroll") for (int i_ = 0; i_ < 2; ++i_) { \
        __builtin_amdgcn_global_load_lds((const unsigned*)(kub + (size_t)(t) * 64 * 512 + kgo[i_]), (LAS unsigned*)(lds + st_ + dmaw + i_ * 8192), 16, 0, 0); \
        __builtin_amdgcn_global_load_lds((const unsigned*)(vub + (size_t)(t) * 64 * 512 + vgo[i_]), (LAS unsigned*)(lds + st_ + 16384 + dmaw + i_ * 8192), 16, 0, 0); } } while (0)
#ifdef ATT_DOUBLE_DMA
#define ATT_DMA_X2(t) ATT_DMA(t)
#else
#define ATT_DMA_X2(t) do {} while (0)
#endif
    ATT_DMA(0); ATT_DMA(1);
    bf16x8 qf[4];
    { const bf16_t* qp = QD + (rowbase + q0 + 32 * wq + r32) * 512 + h * 128 + map * 64 + 8 * hi;
#pragma unroll
      for (int d0 = 0; d0 < 4; ++d0) qf[d0] = *(const bf16x8*)(qp + 16 * d0); }
    asm volatile("" : "+v"(qf[0]), "+v"(qf[1]), "+v"(qf[2]), "+v"(qf[3]));
    asm volatile("s_waitcnt vmcnt(0) lgkmcnt(0)\n\ts_barrier" ::: "memory");
    if (2 < NT) ATT_DMA(2);
    f32x16 o[4];
#pragma unroll
    for (int i = 0; i < 4; ++i)
#pragma unroll
        for (int r = 0; r < 16; ++r) o[i][r] = 0.f;
    f32x16 lacc;
#pragma unroll
    for (int r = 0; r < 16; ++r) lacc[r] = 0.f;
    const bf16x8 ones = (bf16x8){0x3f80, 0x3f80, 0x3f80, 0x3f80, 0x3f80, 0x3f80, 0x3f80, 0x3f80};
    const int qabs = q0 + 32 * wq + r32;
    const int kfo = (8 * map + hi) * 1024 + r32 * 16;
    const int vfo = 16384 + ((lane >> 4) & 1) * 32 + (lane & 3) * 8 + (4 * hi + ((lane & 15) >> 2)) * 64;
#define ATT_QK(P0, P1, tt) do { const LAS char* kb_ = lds + ((tt) & 3) * 32768 + kfo; \
        _Pragma("unroll") for (int r = 0; r < 16; ++r) { P0[r] = 0.f; P1[r] = 0.f; } \
        _Pragma("unroll") for (int dh = 0; dh < 2; ++dh) { bf16x8 kf_[4]; \
            _Pragma("unroll") for (int dd = 0; dd < 2; ++dd) { kf_[2 * dd] = *(const LAS bf16x8*)(kb_ + (2 * dh + dd) * 2048); kf_[2 * dd + 1] = *(const LAS bf16x8*)(kb_ + (2 * dh + dd) * 2048 + 512); } \
            _Pragma("unroll") for (int dd = 0; dd < 2; ++dd) { P0 = __builtin_amdgcn_mfma_f32_32x32x16_bf16(kf_[2 * dd], qf[2 * dh + dd], P0, 0, 0, 0); P1 = __builtin_amdgcn_mfma_f32_32x32x16_bf16(kf_[2 * dd + 1], qf[2 * dh + dd], P1, 0, 0, 0); } \
            __builtin_amdgcn_sched_barrier(0); } } while (0)
#define ATT_EXP_MASK(P0, P1, tt) do { const int kbase_ = 64 * (tt) + 4 * hi; _Pragma("unroll") for (int r = 0; r < 16; ++r) { const int kv_ = kbase_ + (r & 3) + 8 * (r >> 2); \
        P0[r] = (kv_ > qabs) ? 0.f : __builtin_amdgcn_exp2f(P0[r]); P1[r] = (kv_ + 32 > qabs) ? 0.f : __builtin_amdgcn_exp2f(P1[r]); } } while (0)
#define ATT_PACK(P0, P1) do { u32x4 w_; \
        w_.x = pk2(P0[0], P0[1]); w_.y = pk2(P0[2], P0[3]); w_.z = pk2(P0[4], P0[5]); w_.w = pk2(P0[6], P0[7]); pa[0] = __builtin_bit_cast(bf16x8, w_); \
        w_.x = pk2(P0[8], P0[9]); w_.y = pk2(P0[10], P0[11]); w_.z = pk2(P0[12], P0[13]); w_.w = pk2(P0[14], P0[15]); pa[1] = __builtin_bit_cast(bf16x8, w_); \
        w_.x = pk2(P1[0], P1[1]); w_.y = pk2(P1[2], P1[3]); w_.z = pk2(P1[4], P1[5]); w_.w = pk2(P1[6], P1[7]); pa[2] = __builtin_bit_cast(bf16x8, w_); \
        w_.x = pk2(P1[8], P1[9]); w_.y = pk2(P1[10], P1[11]); w_.z = pk2(P1[12], P1[13]); w_.w = pk2(P1[14], P1[15]); pa[3] = __builtin_bit_cast(bf16x8, w_); } while (0)
#define ATT_VFRAG(vb_, j) ({ const s16x4 lo_ = vtr((vb_) + ((j) >> 2) * 4096 + ((j) & 3) * 1024), hh_ = vtr((vb_) + ((j) >> 2) * 4096 + ((j) & 3) * 1024 + 512); (bf16x8){lo_[0], lo_[1], lo_[2], lo_[3], hh_[0], hh_[1], hh_[2], hh_[3]}; })
#define ATT_PV_PLAIN(tt) do { const LAS char* vb_ = lds + ((tt) & 3) * 32768 + vfo; __builtin_amdgcn_s_setprio(1); \
        _Pragma("unroll") for (int ks = 0; ks < 4; ++ks) lacc = __builtin_amdgcn_mfma_f32_32x32x16_bf16(pa[ks], ones, lacc, 0, 0, 0); \
        _Pragma("unroll") for (int j = 0; j < 16; ++j) { const bf16x8 vf_ = ATT_VFRAG(vb_, j); o[j >> 2] = __builtin_amdgcn_mfma_f32_32x32x16_bf16(pa[j & 3], vf_, o[j >> 2], 0, 0, 0); } \
        __builtin_amdgcn_s_setprio(0); } while (0)
#ifdef ATT_PROBE
#ifdef ATT_PROBE_RT
    const unsigned long long tp0_ = __builtin_amdgcn_s_memrealtime();
#else
    const unsigned long long tp0_ = __builtin_amdgcn_s_memtime();
#endif
#endif
    bf16x8 pa[4];
    { f32x16 p0, p1;
      ATT_QK(p0, p1, 0);
      if (NT > 2) {
#pragma unroll
          for (int r = 0; r < 16; ++r) { p0[r] = __builtin_amdgcn_exp2f(p0[r]); p1[r] = __builtin_amdgcn_exp2f(p1[r]); }
      } else ATT_EXP_MASK(p0, p1, 0);
      ATT_PACK(p0, p1); }
#ifdef ATT_DOUBLE_DMA
#define ATT_VM4 "8"
#else
#define ATT_VM4 "4"
#endif
#define ATT_TOP_NODMA(t) do { if ((t) + 1 < NT) asm volatile("s_waitcnt vmcnt(" ATT_VM4 ") lgkmcnt(0)\n\ts_barrier" ::: "memory"); else asm volatile("s_waitcnt vmcnt(0) lgkmcnt(0)\n\ts_barrier" ::: "memory"); } while (0)
#define ATT_TOP(t) do { if ((t) + 1 < NT) asm volatile("s_waitcnt vmcnt(" ATT_VM4 ") lgkmcnt(0)\n\ts_barrier" ::: "memory"); else asm volatile("s_waitcnt vmcnt(0) lgkmcnt(0)\n\ts_barrier" ::: "memory"); \
        if ((t) + 2 < NT) { ATT_DMA((t) + 2); ATT_DMA_X2((t) + 2); } } while (0)
    int t = 1;
    for (; t + 2 < NT; ++t) {
        ATT_TOP_NODMA(t);
        {
            const LAS char* kb = lds + (t & 3) * 32768 + kfo;
            const LAS char* vb = lds + ((t - 1) & 3) * 32768 + vfo;
            f32x16 ph; bf16x8 pn[4];
#define ATT_QKH(off) do { bf16x8 kf_[4]; _Pragma("unroll") for (int d0 = 0; d0 < 4; ++d0) kf_[d0] = *(const LAS bf16x8*)(kb + d0 * 2048 + (off)); \
                _Pragma("unroll") for (int r = 0; r < 16; ++r) ph[r] = 0.f; \
                _Pragma("unroll") for (int d0 = 0; d0 < 4; ++d0) ph = __builtin_amdgcn_mfma_f32_32x32x16_bf16(kf_[d0], qf[d0], ph, 0, 0, 0); } while (0)
#define ATT_GAP(j, e0) do { const bf16x8 vfn_ = ATT_VFRAG(vb, ((j) + 2) & 15); \
                o[(j) >> 2] = __builtin_amdgcn_mfma_f32_32x32x16_bf16(pa[(j) & 3], vfa, o[(j) >> 2], 0, 0, 0); \
                ph[e0] = __builtin_amdgcn_exp2f(ph[e0]); ph[(e0) + 1] = __builtin_amdgcn_exp2f(ph[(e0) + 1]); \
                vfa = vfb; vfb = vfn_; } while (0)
#define ATT_PACKH(i0) do { u32x4 w_; w_.x = pk2(ph[0], ph[1]); w_.y = pk2(ph[2], ph[3]); w_.z = pk2(ph[4], ph[5]); w_.w = pk2(ph[6], ph[7]); pn[i0] = __builtin_bit_cast(bf16x8, w_); \
                w_.x = pk2(ph[8], ph[9]); w_.y = pk2(ph[10], ph[11]); w_.z = pk2(ph[12], ph[13]); w_.w = pk2(ph[14], ph[15]); pn[(i0) + 1] = __builtin_bit_cast(bf16x8, w_); } while (0)
#define ATT_GAP0(j) do { const bf16x8 vfn_ = ATT_VFRAG(vb, ((j) + 2) & 15); \
                o[(j) >> 2] = __builtin_amdgcn_mfma_f32_32x32x16_bf16(pa[(j) & 3], vfa, o[(j) >> 2], 0, 0, 0); \
                vfa = vfb; vfb = vfn_; } while (0)
#define ATT_GAP3(j, e0) do { const bf16x8 vfn_ = ATT_VFRAG(vb, ((j) + 2) & 15); \
                o[(j) >> 2] = __builtin_amdgcn_mfma_f32_32x32x16_bf16(pa[(j) & 3], vfa, o[(j) >> 2], 0, 0, 0); \
                ph[e0] = __builtin_amdgcn_exp2f(ph[e0]); ph[(e0) + 1] = __builtin_amdgcn_exp2f(ph[(e0) + 1]); ph[(e0) + 2] = __builtin_amdgcn_exp2f(ph[(e0) + 2]); \
                vfa = vfb; vfb = vfn_; } while (0)
            __builtin_amdgcn_s_setprio(1);
            ATT_QKH(0);
            __builtin_amdgcn_sched_barrier(0);
            bf16x8 vfa = ATT_VFRAG(vb, 0), vfb = ATT_VFRAG(vb, 1);
#pragma unroll
            for (int ks = 0; ks < 4; ++ks) lacc = __builtin_amdgcn_mfma_f32_32x32x16_bf16(pa[ks], ones, lacc, 0, 0, 0);
            ATT_GAP(0, 0); ATT_GAP(1, 2); ATT_GAP(2, 4); ATT_GAP(3, 6); ATT_GAP(4, 8); ATT_GAP(5, 10); ATT_GAP(6, 12); ATT_GAP(7, 14);
#pragma unroll
            for (int i = 0; i < 4; ++i) __builtin_amdgcn_sched_group_barrier(0x008, 1, 0);
#pragma unroll
            for (int i = 0; i < 8; ++i) { __builtin_amdgcn_sched_group_barrier(0x100, 2, 0); __builtin_amdgcn_sched_group_barrier(0x008, 1, 0); __builtin_amdgcn_sched_group_barrier(0x402, 2, 0); }
            __builtin_amdgcn_sched_barrier(0);
            ATT_PACKH(0);
            ATT_DMA(t + 2);
            ATT_QKH(512);
            __builtin_amdgcn_sched_barrier(0);
            ATT_GAP0(8); ATT_GAP0(9);
            ATT_GAP3(10, 0); ATT_GAP3(11, 3); ATT_GAP3(12, 6); ATT_GAP3(13, 9); ATT_GAP(14, 12); ATT_GAP(15, 14);
#pragma unroll
            for (int i = 0; i < 2; ++i) { __builtin_amdgcn_sched_group_barrier(0x100, 2, 0); __builtin_amdgcn_sched_group_barrier(0x008, 1, 0); }
#pragma unroll
            for (int i = 0; i < 4; ++i) { __builtin_amdgcn_sched_group_barrier(0x100, 2, 0); __builtin_amdgcn_sched_group_barrier(0x008, 1, 0); __builtin_amdgcn_sched_group_barrier(0x402, 3, 0); }
#pragma unroll
            for (int i = 0; i < 2; ++i) { __builtin_amdgcn_sched_group_barrier(0x100, 2, 0); __builtin_amdgcn_sched_group_barrier(0x008, 1, 0); __builtin_amdgcn_sched_group_barrier(0x402, 2, 0); }
            __builtin_amdgcn_sched_barrier(0);
            __builtin_amdgcn_s_setprio(0);
            ATT_PACKH(2);
            pa[0] = pn[0]; pa[1] = pn[1]; pa[2] = pn[2]; pa[3] = pn[3];
#undef ATT_GAP0
#undef ATT_GAP3
#undef ATT_QKH
#undef ATT_GAP
#undef ATT_PACKH
        }
    }
    for (; t < NT; ++t) {
        ATT_TOP(t);
        ATT_PV_PLAIN(t - 1);
        if (64 * t <= q0 + 32 * wq + 31) { f32x16 p0, p1; ATT_QK(p0, p1, t); ATT_EXP_MASK(p0, p1, t); ATT_PACK(p0, p1); }
    }
    if (64 * (NT - 1) <= q0 + 32 * wq + 31) ATT_PV_PLAIN(NT - 1);
#undef ATT_TOP
#undef ATT_TOP_NODMA
#undef ATT_QK
#undef ATT_EXP_MASK
#undef ATT_PACK
#undef ATT_VFRAG
#undef ATT_PV_PLAIN
#undef ATT_DMA
#ifdef ATT_PROBE
    if (tid == 0) { volatile LAS unsigned* pm_ = (volatile LAS unsigned*)(lds + 131072 + 320);
#if defined(UNIT_PROBE) || defined(EPI_PROBE)
        (void)tp0_;
#elif defined(ATT_PROBE_RT)
        pm_[4] += (unsigned)(__builtin_amdgcn_s_memrealtime() - tp0_) * 100u;
#else
        pm_[4] += (unsigned)(__builtin_amdgcn_s_memtime() - tp0_);
#endif
        pm_[5] += (unsigned)NT; }
#endif
#ifdef EPI_PROBE
    const unsigned long long te0_ = __builtin_amdgcn_s_memtime();
#endif
    __syncthreads();
    { int t2_ = threadIdx.x; asm volatile("" : "+v"(t2_)); tid = t2_; }
    const int lane_e = tid & 63, r32e = lane_e & 31, hie = lane_e >> 5;
    float rl[16];
#pragma unroll
    for (int r = 0; r < 16; ++r) rl[r] = 1.0f / lacc[r];
    LAS float* X = (LAS float*)lds + wq * 32 * XP;
    if (map == 1) {
#pragma unroll
        for (int dt = 0; dt < 4; ++dt)
#pragma unroll
            for (int r = 0; r < 16; ++r) X[crow(r, hie) * XP + 32 * dt + r32e] = lam * o[dt][r] * rl[r];
    }
    __syncthreads();
    if (map == 0) {
#pragma unroll
        for (int dt = 0; dt < 4; ++dt)
#pragma unroll
            for (int r = 0; r < 16; ++r) { const int idx = crow(r, hie) * XP + 32 * dt + r32e; X[idx] = o[dt][r] * rl[r] - X[idx]; }
        asm volatile("s_waitcnt lgkmcnt(0)" ::: "memory");
        const int row = lane_e >> 1, seg = lane_e & 1;
        f32x4 xv[16]; float ss = 0.f;
#pragma unroll
        for (int i = 0; i < 16; ++i) { xv[i] = *(const LAS f32x4*)(X + row * XP + 64 * seg + 4 * i); const f32x4 q = xv[i] * xv[i]; ss += (q[0] + q[1]) + (q[2] + q[3]); }
        ss += __shfl_xor(ss, 1);
        const float rs = __builtin_amdgcn_rsqf(ss * (1.0f / 128.0f) + REPS) * 0.8f;
        bf16_t* op = HMD + (rowbase + q0 + 32 * wq + row) * 1024 + 512 + h * 128 + 64 * seg;
#pragma unroll
        for (int i = 0; i < 8; ++i) { const f32x4 w0 = *(const f32x4*)(subw + 64 * seg + 8 * i), w1 = *(const f32x4*)(subw + 64 * seg + 8 * i + 4);
            *(u32x4*)(op + 8 * i) = pack8(xv[2 * i] * w0 * rs, xv[2 * i + 1] * w1 * rs); }
    }
    __syncthreads();
#ifdef EPI_PROBE
    if (threadIdx.x == 0) { volatile LAS unsigned* pm_ = (volatile LAS unsigned*)(lds + 131072 + 320); pm_[4] += (unsigned)(__builtin_amdgcn_s_memtime() - te0_); }
#endif
}
}

namespace ml {
constexpr int PQ = 272, PS = 144;
constexpr int OQ = 0, OK = 17408, OKW = 34816, OV = 53248, OP = 71680, OF = 80896, OH = 110592;
constexpr int F_N = 0, F_QN = 128, F_RSP = 192, F_SSQ = 320, F_G = 832, F_CW = 1088, F_N2 = 6208, F_RS = 6336;
struct Ptrs { const bf16_t *QM, *KM, *VM, *OG; const float *LOGI, *LOGF, *conv_w, *conv_b, *nw; bf16_t* HMD; float *LT, *NT, *SC, *MIN; };

DI float row_scan_add(float x) {
    x += __builtin_bit_cast(float, __builtin_amdgcn_update_dpp(0, __builtin_bit_cast(int, x), 0x111, 0xf, 0xf, true));
    x += __builtin_bit_cast(float, __builtin_amdgcn_update_dpp(0, __builtin_bit_cast(int, x), 0x112, 0xf, 0xf, true));
    x += __builtin_bit_cast(float, __builtin_amdgcn_update_dpp(0, __builtin_bit_cast(int, x), 0x114, 0xf, 0xf, true));
    x += __builtin_bit_cast(float, __builtin_amdgcn_update_dpp(0, __builtin_bit_cast(int, x), 0x118, 0xf, 0xf, true));
    return x;
}
DI float wave_scan_add(float x) {
    x = row_scan_add(x);
    x += __builtin_bit_cast(float, __builtin_amdgcn_update_dpp(0, __builtin_bit_cast(int, x), 0x142, 0xa, 0xf, false));
    x += __builtin_bit_cast(float, __builtin_amdgcn_update_dpp(0, __builtin_bit_cast(int, x), 0x143, 0xc, 0xf, false));
    return x;
}
DI float wave_scan_max(float x) {
#define ML_DPPMAX(ctrl, rm) x = fmaxf(x, __builtin_bit_cast(float, __builtin_amdgcn_update_dpp(__builtin_bit_cast(int, x), __builtin_bit_cast(int, x), ctrl, rm, 0xf, false)))
    ML_DPPMAX(0x111, 0xf); ML_DPPMAX(0x112, 0xf); ML_DPPMAX(0x114, 0xf); ML_DPPMAX(0x118, 0xf); ML_DPPMAX(0x142, 0xa); ML_DPPMAX(0x143, 0xc);
#undef ML_DPPMAX
    return x;
}
DI float row_scan_add8(float x) {
    x += __builtin_bit_cast(float, __builtin_amdgcn_update_dpp(0, __builtin_bit_cast(int, x), 0x111, 0xf, 0xf, true));
    x += __builtin_bit_cast(float, __builtin_amdgcn_update_dpp(0, __builtin_bit_cast(int, x), 0x112, 0xf, 0xf, true));
    x += __builtin_bit_cast(float, __builtin_amdgcn_update_dpp(0, __builtin_bit_cast(int, x), 0x114, 0xf, 0xf, true));
    return x;
}
DI void load_taps(const Ptrs& P, LAS float* fl, int tid) {
    for (int i = tid; i < 4 * 1280; i += 512) { const int hh = i / 1280, r = i % 1280, tn = r / 640, j = (r % 640) >> 7, col = r & 127, ch = tn * 512 + hh * 128 + col; fl[F_CW + i] = (j < 4) ? P.conv_w[j * 1024 + ch] : P.conv_b[ch]; }
}
#define ML_CONV_HALF(hh, cwp, xr, ov) do { float cw_[4][4]; \
        { const f32x4 b0_ = *(const LAS f32x4*)((cwp) + 512 + 4 * (hh)); _Pragma("unroll") for (int r = 0; r < 4; ++r) { ov[r][0] = b0_[0]; ov[r][1] = b0_[1]; ov[r][2] = b0_[2]; ov[r][3] = b0_[3]; } } \
        _Pragma("unroll") for (int j = 0; j < 4; ++j) { const f32x4 w0_ = *(const LAS f32x4*)((cwp) + 128 * j + 4 * (hh)); cw_[j][0] = w0_[0]; cw_[j][1] = w0_[1]; cw_[j][2] = w0_[2]; cw_[j][3] = w0_[3]; } \
        _Pragma("unroll") for (int rr = 0; rr < 7; ++rr) { const unsigned wa_ = (hh) ? xr[rr].z : xr[rr].x, wb_ = (hh) ? xr[rr].w : xr[rr].y; const float xe_[4] = {bflo(wa_), bfhi(wa_), bflo(wb_), bfhi(wb_)}; \
            _Pragma("unroll") for (int r = 0; r < 4; ++r) { const int j = rr - r; if (j >= 0 && j < 4) { _Pragma("unroll") for (int e = 0; e < 4; ++e) ov[r][e] += cw_[j][e] * xe_[e]; } } } } while (0)

DI void passA(const Ptrs& P, LAS char* lds, int first, int stride) {
    const int tid = threadIdx.x, lane = tid & 63, wid = __builtin_amdgcn_readfirstlane(tid >> 6), fr = lane & 15, gq = lane >> 4;
    LAS float* fl = (LAS float*)(lds + OF);
    const int cch = (tid >> 5) & 15, rp = tid & 31;
    const int vch = tid >> 5, sp = tid & 31;
    load_taps(P, fl, tid);
    __syncthreads();
    u32x4 xr[5], vv[2]; float lf = 0.f, li = 0.f;
#define MLA_LOAD(itn) do { const int bh_ = (itn) & 31, c_ = (itn) >> 5, h_ = bh_ & 3; const size_t R0_ = (size_t)(bh_ >> 2) * SEQ; \
        { const bf16_t* csrc_ = P.KM + h_ * 128 + 8 * cch; \
            _Pragma("unroll") for (int rr = 0; rr < 5; ++rr) { const int gr = 64 * c_ + 2 * rp + rr - 3; xr[rr] = (gr >= 0) ? *(const u32x4*)(csrc_ + (R0_ + gr) * 512) : (u32x4){0u, 0u, 0u, 0u}; } } \
        { const bf16_t* vsrc_ = P.VM + h_ * 128 + 8 * vch; \
          _Pragma("unroll") for (int rr = 0; rr < 2; ++rr) vv[rr] = *(const u32x4*)(vsrc_ + (R0_ + 64 * c_ + 2 * sp + rr) * 512); } \
        lf = P.LOGF[(size_t)bh_ * SEQ + 64 * c_ + lane]; li = P.LOGI[(size_t)bh_ * SEQ + 64 * c_ + lane]; } while (0)
    if (first < 2048) MLA_LOAD(first);
    for (int it = first; it < 2048; it += stride) {
        const int bh = it & 31, h = bh & 3;
        const float bc = wave_scan_add(lf);
        const float ag = li - bc; const float pm = wave_scan_max(ag);
        const float pmax = __builtin_bit_cast(float, __builtin_amdgcn_readlane(__builtin_bit_cast(int, pm), 63)), blast = __builtin_bit_cast(float, __builtin_amdgcn_readlane(__builtin_bit_cast(int, bc), 63)), wloc = fexp(ag - pmax);
        const float wx0 = __shfl(wloc, 2 * rp), wx1 = __shfl(wloc, 2 * rp + 1);
        {
            const LAS float* cwp = fl + F_CW + h * 1280 + 640 + 8 * cch;
#pragma unroll
            for (int hh = 0; hh < 2; ++hh) {
                float ov[2][4], cw_[4][4];
                { const f32x4 b0_ = *(const LAS f32x4*)(cwp + 512 + 4 * hh);
#pragma unroll
                  for (int r = 0; r < 2; ++r) { ov[r][0] = b0_[0]; ov[r][1] = b0_[1]; ov[r][2] = b0_[2]; ov[r][3] = b0_[3]; } }
#pragma unroll
                for (int j = 0; j < 4; ++j) { const f32x4 w0_ = *(const LAS f32x4*)(cwp + 128 * j + 4 * hh); cw_[j][0] = w0_[0]; cw_[j][1] = w0_[1]; cw_[j][2] = w0_[2]; cw_[j][3] = w0_[3]; }
#pragma unroll
                for (int rr = 0; rr < 5; ++rr) { const unsigned wa_ = hh ? xr[rr].z : xr[rr].x, wb_ = hh ? xr[rr].w : xr[rr].y; const float xe_[4] = {bflo(wa_), bfhi(wa_), bflo(wb_), bfhi(wb_)};
#pragma unroll
                    for (int r = 0; r < 2; ++r) { const int j = rr - r; if (j >= 0 && j < 4) {
#pragma unroll
                            for (int e = 0; e < 4; ++e) ov[r][e] += cw_[j][e] * xe_[e]; } } }
#pragma unroll
                for (int e = 0; e < 4; ++e) { const float v0 = ov[0][e], v1 = ov[1][e];
                    *(LAS unsigned*)(lds + OKW + (8 * cch + 4 * hh + e) * PS + (2 * rp) * 2) = pk2(v0 * fsigm(v0) * 0.08838834764831845f * wx0, v1 * fsigm(v1) * 0.08838834764831845f * wx1); }
                __builtin_amdgcn_sched_barrier(0); }
        }
        { float v0[8], v1[8];
          v0[0] = bflo(vv[0].x); v0[1] = bfhi(vv[0].x); v0[2] = bflo(vv[0].y); v0[3] = bfhi(vv[0].y); v0[4] = bflo(vv[0].z); v0[5] = bfhi(vv[0].z); v0[6] = bflo(vv[0].w); v0[7] = bfhi(vv[0].w);
          v1[0] = bflo(vv[1].x); v1[1] = bfhi(vv[1].x); v1[2] = bflo(vv[1].y); v1[3] = bfhi(vv[1].y); v1[4] = bflo(vv[1].z); v1[5] = bfhi(vv[1].z); v1[6] = bflo(vv[1].w); v1[7] = bfhi(vv[1].w);
#pragma unroll
          for (int e = 0; e < 8; ++e) *(LAS unsigned*)(lds + OV + (8 * vch + e) * PS + (2 * sp) * 2) = pk2(v0[e], v1[e]); }
        if (it + stride < 2048) MLA_LOAD(it + stride);
        __syncthreads();
        f32x4 Cacc[8];
#pragma unroll
        for (int i = 0; i < 8; ++i) Cacc[i] = (f32x4){0.f, 0.f, 0.f, 0.f};
#pragma unroll
        for (int k2 = 0; k2 < 2; ++k2) {
            const bf16x8 bv = *(const LAS bf16x8*)(lds + OV + (16 * wid + fr) * PS + (32 * k2 + 8 * gq) * 2);
#pragma unroll
            for (int kt = 0; kt < 8; ++kt) { const bf16x8 a = *(const LAS bf16x8*)(lds + OKW + (16 * kt + fr) * PS + (32 * k2 + 8 * gq) * 2);
                Cacc[kt] = __builtin_amdgcn_mfma_f32_16x16x32_bf16(a, bv, Cacc[kt], 0, 0, 0); }
        }
        { bf16_t* dst = (bf16_t*)P.LT + (size_t)it * 16384 + (size_t)(wid * 64 + lane) * 32;
#pragma unroll
          for (int ks = 0; ks < 4; ++ks) *(u32x4*)(dst + 8 * ks) = pack8(Cacc[2 * ks], Cacc[2 * ks + 1]); }
        if (tid < 128) { float s = 0.f;
#pragma unroll
            for (int i = 0; i < 8; ++i) { const u32x4 w = *(const LAS u32x4*)(lds + OKW + tid * PS + i * 16); s += (bflo(w.x) + bfhi(w.x)) + (bflo(w.y) + bfhi(w.y)) + (bflo(w.z) + bfhi(w.z)) + (bflo(w.w) + bfhi(w.w)); }
            P.NT[(size_t)it * 128 + tid] = s; }
        if (tid == 0) { P.SC[2 * it] = pmax; P.SC[2 * it + 1] = blast; }
        __syncthreads();
    }
#undef MLA_LOAD
}

DI void passB(const Ptrs& P, LAS char* lds, int tid) {
    const int g = blockIdx.x * 512 + tid, bh = g >> 12, e4 = g & 4095;
    LAS float* sc_l = (LAS float*)lds;
    if (tid < 128) sc_l[256 + tid] = P.SC[2 * ((tid >> 1) * 32 + bh) + (tid & 1)];
    __syncthreads();
    if (tid == 0) { float m = 0.f;
        for (int c = 0; c < 64; ++c) { const float pm = sc_l[256 + 2 * c], bl = sc_l[257 + 2 * c]; const float g63 = fmaxf(m, pm);
            sc_l[2 * c] = fexp(m - g63); sc_l[2 * c + 1] = fexp(pm - g63); if (e4 == 0) P.MIN[c * 32 + bh] = m; m = bl + g63; } }
    __syncthreads();
    f32x4 C = {0.f, 0.f, 0.f, 0.f}, N = {0.f, 0.f, 0.f, 0.f};
    u32x2* lt = (u32x2*)P.LT + e4; f32x4* nt = (f32x4*)P.NT + (e4 & 31);
    u32x2 Lr[4];
#pragma unroll
    for (int j = 0; j < 4; ++j) Lr[j] = lt[(size_t)(j * 32 + bh) * 4096];
    for (int c0 = 0; c0 < 64; c0 += 4) {
#pragma unroll
        for (int j = 0; j < 4; ++j) {
            const int c = c0 + j, tile = c * 32 + bh;
            const float decay = sc_l[2 * c], sc = sc_l[2 * c + 1];
            const f32x4 Lc = {bflo(Lr[j].x), bfhi(Lr[j].x), bflo(Lr[j].y), bfhi(Lr[j].y)};
            if (c + 4 < 64) Lr[j] = lt[(size_t)((c + 4) * 32 + bh) * 4096];
            { u32x2 w; w.x = pk2(C[0], C[1]); w.y = pk2(C[2], C[3]); lt[(size_t)tile * 4096] = w; }
            C = C * decay + Lc * sc;
            if (e4 < 32) { const f32x4 n4 = nt[(size_t)tile * 32]; nt[(size_t)tile * 32] = N; N = N * decay + n4 * sc; }
        }
    }
    __syncthreads();
}

DI void passC(const Ptrs& P, LAS char* lds, int first, int stride) {
    int tid = threadIdx.x; asm volatile("" : "+v"(tid));
    const int lane = tid & 63, wid = __builtin_amdgcn_readfirstlane(tid >> 6), fr = lane & 15, gq = lane >> 4;
    LAS float* fl = (LAS float*)(lds + OF);
    const int tens = wid >> 2, cch = (tid >> 4) & 15, rg = tid & 15, vch = tid >> 5, sp = tid & 31;
    u32x4 xr[7], vv[2]; float lf = 0.f, li = 0.f, mprev = 0.f, nval = 0.f;
#define MLC_LOAD(itn) do { const int bh_ = (itn) & 31, c_ = (itn) >> 5, h_ = bh_ & 3; const size_t R0_ = (size_t)(bh_ >> 2) * SEQ; \
        { const bf16_t* csrc_ = (tens ? P.KM : P.QM) + h_ * 128 + 8 * cch; \
          _Pragma("unroll") for (int rr = 0; rr < 7; ++rr) { const int gr = 64 * c_ + 4 * rg + rr - 3; xr[rr] = (gr >= 0) ? *(const u32x4*)(csrc_ + (R0_ + gr) * 512) : (u32x4){0u, 0u, 0u, 0u}; } \
          const bf16_t* vsrc_ = P.VM + h_ * 128 + 8 * vch; \
          _Pragma("unroll") for (int rr = 0; rr < 2; ++rr) vv[rr] = *(const u32x4*)(vsrc_ + (R0_ + 64 * c_ + 2 * sp + rr) * 512); } \
        lf = P.LOGF[(size_t)bh_ * SEQ + 64 * c_ + lane]; li = P.LOGI[(size_t)bh_ * SEQ + 64 * c_ + lane]; mprev = P.MIN[itn]; \
        if (tid < 128) nval = P.NT[(size_t)(itn) * 128 + tid]; } while (0)
    if (first < 2048) MLC_LOAD(first);
    int par = 0;
    for (int it = first; it < 2048; it += stride, par ^= 1) {
    const int bh = it & 31, c = it >> 5, h = bh & 3; const size_t R0 = (size_t)(bh >> 2) * SEQ;
    const int FN = par ? F_N2 : F_N;
    u32x4 cfr[4];
    { const bf16_t* src = (const bf16_t*)P.LT + (size_t)it * 16384 + (size_t)(wid * 64 + lane) * 32;
#pragma unroll
      for (int ks = 0; ks < 4; ++ks) cfr[ks] = *(const u32x4*)(src + 8 * ks); }
    if (tid < 128) fl[FN + tid] = nval;
    const float nwv = P.nw[h * 128 + 16 * wid + fr];
    const float bc = wave_scan_add(lf);
    const float ag = li - bc; const float pm = wave_scan_max(ag);
    const float gg = fmaxf(mprev, pm);
    if (wid == 0) { fl[F_G + lane] = ag; fl[F_G + 64 + lane] = gg; fl[F_G + 128 + lane] = fexp(mprev - gg); fl[F_G + 192 + lane] = fexp(-(bc + gg)); }
    { const LAS float* cwp = fl + F_CW + h * 1280 + tens * 640 + 8 * cch;
#pragma unroll
      for (int hh = 0; hh < 2; ++hh) { float ov[4][4]; ML_CONV_HALF(hh, cwp, xr, ov);
#pragma unroll
          for (int r = 0; r < 4; ++r) {
#pragma unroll
              for (int e = 0; e < 4; ++e) { const float v = ov[r][e]; ov[r][e] = v * fsigm(v) * (tens ? 0.08838834764831845f : 1.0f); }
              u32x2 w; w.x = pk2(ov[r][0], ov[r][1]); w.y = pk2(ov[r][2], ov[r][3]);
              *(LAS u32x2*)(lds + (tens ? OK : OQ) + (4 * rg + r) * PQ + cch * 16 + 8 * hh) = w; }
          __builtin_amdgcn_sched_barrier(0); }
      float v0[8], v1[8];
      v0[0] = bflo(vv[0].x); v0[1] = bfhi(vv[0].x); v0[2] = bflo(vv[0].y); v0[3] = bfhi(vv[0].y); v0[4] = bflo(vv[0].z); v0[5] = bfhi(vv[0].z); v0[6] = bflo(vv[0].w); v0[7] = bfhi(vv[0].w);
      v1[0] = bflo(vv[1].x); v1[1] = bfhi(vv[1].x); v1[2] = bflo(vv[1].y); v1[3] = bfhi(vv[1].y); v1[4] = bflo(vv[1].z); v1[5] = bfhi(vv[1].z); v1[6] = bflo(vv[1].w); v1[7] = bfhi(vv[1].w);
#pragma unroll
      for (int e = 0; e < 8; ++e) *(LAS unsigned*)(lds + OV + (8 * vch + e) * PS + (2 * sp) * 2) = pk2(v0[e], v1[e]); }
    u32x4 ogp[2];
#pragma unroll
    for (int i = 0; i < 2; ++i) { const int id = tid + 512 * i; ogp[i] = *(const u32x4*)(P.OG + (R0 + 64 * c + (id >> 4)) * 512 + h * 128 + 8 * (id & 15)); }
    if (it + stride < 2048) MLC_LOAD(it + stride);
    __syncthreads();
    {
        const int tt = wid >> 1, sh = wid & 1;
        f32x4 s0 = {0.f, 0.f, 0.f, 0.f}, s1 = {0.f, 0.f, 0.f, 0.f};
#pragma unroll
        for (int ks = 0; ks < 4; ++ks) {
            const bf16x8 a = *(const LAS bf16x8*)(lds + OQ + (16 * tt + fr) * PQ + (32 * ks + 8 * gq) * 2);
            const bf16x8 b0 = *(const LAS bf16x8*)(lds + OK + (32 * sh + fr) * PQ + (32 * ks + 8 * gq) * 2);
            const bf16x8 b1 = *(const LAS bf16x8*)(lds + OK + (32 * sh + 16 + fr) * PQ + (32 * ks + 8 * gq) * 2);
            s0 = __builtin_amdgcn_mfma_f32_16x16x32_bf16(a, b0, s0, 0, 0, 0);
            s1 = __builtin_amdgcn_mfma_f32_16x16x32_bf16(a, b1, s1, 0, 0, 0);
        }
        const int sA = 32 * sh + fr, sB = sA + 16;
        const float aA = fl[F_G + sA], aB = fl[F_G + sB];
#pragma unroll
        for (int rg2 = 0; rg2 < 4; ++rg2) {
            const int t = 16 * tt + 4 * gq + rg2; const float gt = fl[F_G + 64 + t];
            const float pA = (sA <= t) ? s0[rg2] * fexp(aA - gt) : 0.f, pB = (sB <= t) ? s1[rg2] * fexp(aB - gt) : 0.f;
            *(LAS bf16_t*)(lds + OP + t * PS + sA * 2) = (bf16_t)(pk2(pA, 0.f) & 0xffffu);
            *(LAS bf16_t*)(lds + OP + t * PS + sB * 2) = (bf16_t)(pk2(pB, 0.f) & 0xffffu);
            const float rs = row_scan_add(pA + pB);
            if (fr == 15) fl[F_RSP + sh * 64 + t] = rs;
        }
        const int tq = tid >> 3, kseg = tid & 7;
        const u32x4 qa = *(const LAS u32x4*)(lds + OQ + tq * PQ + kseg * 32), qb2 = *(const LAS u32x4*)(lds + OQ + tq * PQ + kseg * 32 + 16);
        const LAS float* np = fl + FN + 16 * kseg;
        float d = bflo(qa.x) * np[0] + bfhi(qa.x) * np[1] + bflo(qa.y) * np[2] + bfhi(qa.y) * np[3] + bflo(qa.z) * np[4] + bfhi(qa.z) * np[5] + bflo(qa.w) * np[6] + bfhi(qa.w) * np[7]
                + bflo(qb2.x) * np[8] + bfhi(qb2.x) * np[9] + bflo(qb2.y) * np[10] + bfhi(qb2.y) * np[11] + bflo(qb2.z) * np[12] + bfhi(qb2.z) * np[13] + bflo(qb2.w) * np[14] + bfhi(qb2.w) * np[15];
        d = row_scan_add8(d);
        if (kseg == 7) fl[F_QN + tq] = d;
    }
    __syncthreads();
    f32x4 y[4];
#pragma unroll
    for (int tt = 0; tt < 4; ++tt) y[tt] = (f32x4){0.f, 0.f, 0.f, 0.f};
#pragma unroll
    for (int ks = 0; ks < 4; ++ks) {
        const bf16x8 bfr = __builtin_bit_cast(bf16x8, cfr[ks]);
#pragma unroll
        for (int tt = 0; tt < 4; ++tt) {
            const u32x2 a0 = *(const LAS u32x2*)(lds + OQ + (16 * tt + fr) * PQ + (32 * ks + 4 * gq) * 2), a1 = *(const LAS u32x2*)(lds + OQ + (16 * tt + fr) * PQ + (32 * ks + 16 + 4 * gq) * 2);
            const u32x4 aw = {a0.x, a0.y, a1.x, a1.y};
            y[tt] = __builtin_amdgcn_mfma_f32_16x16x32_bf16(__builtin_bit_cast(bf16x8, aw), bfr, y[tt], 0, 0, 0);
        }
        __builtin_amdgcn_sched_barrier(0);
    }
#pragma unroll
    for (int tt = 0; tt < 4; ++tt)
#pragma unroll
        for (int rg2 = 0; rg2 < 4; ++rg2) { const int t = 16 * tt + 4 * gq + rg2; y[tt][rg2] *= fl[F_G + 128 + t]; }
#pragma unroll
    for (int k2 = 0; k2 < 2; ++k2) {
        const bf16x8 bv = *(const LAS bf16x8*)(lds + OV + (16 * wid + fr) * PS + (32 * k2 + 8 * gq) * 2);
#pragma unroll
        for (int tt = 0; tt < 4; ++tt) { const bf16x8 a = *(const LAS bf16x8*)(lds + OP + (16 * tt + fr) * PS + (32 * k2 + 8 * gq) * 2);
            y[tt] = __builtin_amdgcn_mfma_f32_16x16x32_bf16(a, bv, y[tt], 0, 0, 0); }
        __builtin_amdgcn_sched_barrier(0);
    }
    { const float den = fl[F_RSP + lane] + fl[F_RSP + 64 + lane] + fl[F_G + 128 + lane] * fl[F_QN + lane];
      fl[F_RS + wid * 64 + lane] = __builtin_amdgcn_rcpf(fmaxf(fabsf(den), fl[F_G + 192 + lane]));
      asm volatile("s_waitcnt lgkmcnt(0)" ::: "memory"); }
#pragma unroll
    for (int tt = 0; tt < 4; ++tt)
#pragma unroll
        for (int rg2 = 0; rg2 < 4; ++rg2) { const int t = 16 * tt + 4 * gq + rg2;
            const float hv = y[tt][rg2] * fl[F_RS + wid * 64 + t]; y[tt][rg2] = hv;
            const float sq = row_scan_add(hv * hv);
            if (fr == 15) fl[F_SSQ + wid * 64 + t] = sq; }
    __syncthreads();
    { float tot = 0.f;
#pragma unroll
      for (int w = 0; w < 8; ++w) tot += fl[F_SSQ + w * 64 + lane];
      fl[F_RS + wid * 64 + lane] = __builtin_amdgcn_rsqf(tot * (1.0f / 128.0f) + REPS);
      asm volatile("s_waitcnt lgkmcnt(0)" ::: "memory"); }
#pragma unroll
    for (int tt = 0; tt < 4; ++tt)
#pragma unroll
        for (int rg2 = 0; rg2 < 4; ++rg2) { const int t = 16 * tt + 4 * gq + rg2;
            const float ov = y[tt][rg2] * fl[F_RS + wid * 64 + t] * nwv;
            *(LAS bf16_t*)(lds + OH + t * PQ + (16 * wid + fr) * 2) = (bf16_t)(pk2(ov, 0.f) & 0xffffu); }
    __syncthreads();
#pragma unroll
    for (int i = 0; i < 2; ++i) { const int id = tid + 512 * i, row = id >> 4, ch = id & 15;
        const u32x4 hv4 = *(const LAS u32x4*)(lds + OH + row * PQ + ch * 16);
        u32x4 o4; o4.x = pk2(bflo(hv4.x) * bflo(ogp[i].x), bfhi(hv4.x) * bfhi(ogp[i].x)); o4.y = pk2(bflo(hv4.y) * bflo(ogp[i].y), bfhi(hv4.y) * bfhi(ogp[i].y));
        o4.z = pk2(bflo(hv4.z) * bflo(ogp[i].z), bfhi(hv4.z) * bfhi(ogp[i].z)); o4.w = pk2(bflo(hv4.w) * bflo(ogp[i].w), bfhi(hv4.w) * bfhi(ogp[i].w));
        *(u32x4*)(P.HMD + (R0 + 64 * c + row) * 1024 + h * 128 + 8 * ch) = o4; }
    __syncthreads();
    }
#undef MLC_LOAD
}
#undef ML_CONV_HALF
}
constexpr int NWAVES = 8, LDS_BYTES = 147456, RING_BYTES = 131072, MISC_OFF = RING_BYTES + 320, PREF_OFF = RING_BYTES + 1024;
#define RLX_AGENT __ATOMIC_RELAXED, __HIP_MEMORY_SCOPE_AGENT
#define XB_TMO      128
#define XB_XCNT(j)  (256  + 64 * (j))
#define XB_XSUB(j)  (1280 + 64 * (j))
#define XB_XGEN(j)  (2304 + 64 * (j))
#define XB_TOP      3328
#define XB_TOPGEN   3392
#define XCD_BAR_WORDS 3456
#define XB_SPIN_CAP (1u << 18)
DI unsigned xb_ld(unsigned* p)              { return __hip_atomic_load(p, __ATOMIC_RELAXED, __HIP_MEMORY_SCOPE_AGENT); }
DI unsigned xb_add(unsigned* p, unsigned v) { return __hip_atomic_fetch_add(p, v, __ATOMIC_RELAXED, __HIP_MEMORY_SCOPE_AGENT); }
DI unsigned xb_xcc_id() { return (unsigned)__builtin_amdgcn_s_getreg((3 << 11) | 20) & 0xFu; }
#define XB_SPIN(cond, bar) do { unsigned _sp = 0; while (cond) { __builtin_amdgcn_s_sleep(1); \
    if ((++_sp & 255u) == 0u) { if (xb_ld(&(bar)[XB_TMO])) break; if (_sp > XB_SPIN_CAP) { atomicAdd(&(bar)[XB_TMO], 1u); break; } } } } while (0)
struct XcdBarrier { unsigned* bar; unsigned x; volatile LAS unsigned* st; };
DI XcdBarrier xcd_barrier_post(unsigned* bar, volatile LAS unsigned* st) {
    XcdBarrier b; b.bar = bar; b.x = xb_xcc_id(); b.st = st;
    if (threadIdx.x == 0) (void)xb_add(&bar[XB_XCNT(b.x)], 1u);
    return b;
}
DI void xcd_barrier_complete(unsigned* bar, unsigned x, unsigned& nloc, unsigned& nx) {
    const unsigned G = gridDim.x * gridDim.y * gridDim.z;
    unsigned sum, cnt, mine, sp = 0u;
    for (;;) {
        sum = 0u; cnt = 0u; mine = 0u;
#pragma unroll
        for (unsigned j = 0; j < 16; ++j) { const unsigned c = xb_ld(&bar[XB_XCNT(j)]); sum += c; cnt += (c > 0u) ? 1u : 0u; mine = (j == x) ? c : mine; }
        if (sum == G) break;
        __builtin_amdgcn_s_sleep(1);
        if ((++sp & 255u) == 0u) { if (xb_ld(&bar[XB_TMO])) break; if (sp > XB_SPIN_CAP) { atomicAdd(&bar[XB_TMO], 1u); break; } }
    }
    nloc = mine > 0u ? mine : 1u; nx = cnt > 0u ? cnt : 1u;
}
DI void xcd_barrier(const XcdBarrier& b) {
    asm volatile("s_waitcnt vmcnt(0)" ::: "memory");
    __syncthreads();
    if (threadIdx.x == 0) {
        unsigned* bar = b.bar;
        __builtin_amdgcn_s_waitcnt(0);
        unsigned nloc = b.st[0], nx = b.st[1];
        if (nloc == 0u) { xcd_barrier_complete(bar, b.x, nloc, nx); b.st[0] = nloc; b.st[1] = nx; }
        const unsigned old = xb_add(&bar[XB_XSUB(b.x)], 1u);
        const unsigned gen = old / nloc;
        if (old + 1u == (gen + 1u) * nloc) {
            __builtin_amdgcn_fence(__ATOMIC_RELEASE, "agent");
            asm volatile("s_waitcnt vmcnt(0)" ::: "memory");
            const unsigned og = xb_add(&bar[XB_TOP], 1u);
            const unsigned tg = og / nx;
            if (og + 1u == (tg + 1u) * nx) xb_add(&bar[XB_TOPGEN], 1u);
            else XB_SPIN(xb_ld(&bar[XB_TOPGEN]) == tg, bar);
            __builtin_amdgcn_fence(__ATOMIC_ACQUIRE, "agent");
            xb_add(&bar[XB_XGEN(b.x)], 1u);
            asm volatile("s_waitcnt vmcnt(0)" ::: "memory");
        } else {
            XB_SPIN(xb_ld(&bar[XB_XGEN(b.x)]) == gen, bar);
            __builtin_amdgcn_fence(__ATOMIC_ACQUIRE, "agent");
            asm volatile("s_waitcnt vmcnt(0)" ::: "memory");
        }
    }
    __syncthreads();
}

struct Args { const void* in[30]; float* out; unsigned char* ws; float freq[8]; int ph_lo, ph_hi; };

DI float wave_sum(float v) {
    v += __builtin_bit_cast(float, __builtin_amdgcn_update_dpp(0, __builtin_bit_cast(int, v), 0x111, 0xf, 0xf, true));
    v += __builtin_bit_cast(float, __builtin_amdgcn_update_dpp(0, __builtin_bit_cast(int, v), 0x112, 0xf, 0xf, true));
    v += __builtin_bit_cast(float, __builtin_amdgcn_update_dpp(0, __builtin_bit_cast(int, v), 0x114, 0xf, 0xf, true));
    v += __builtin_bit_cast(float, __builtin_amdgcn_update_dpp(0, __builtin_bit_cast(int, v), 0x118, 0xf, 0xf, true));
    v += __builtin_bit_cast(float, __builtin_amdgcn_update_dpp(0, __builtin_bit_cast(int, v), 0x142, 0xa, 0xf, false));
    v += __builtin_bit_cast(float, __builtin_amdgcn_update_dpp(0, __builtin_bit_cast(int, v), 0x143, 0xc, 0xf, false));
    return __builtin_bit_cast(float, __builtin_amdgcn_readlane(__builtin_bit_cast(int, v), 63));
}
DI float logsigf(float x) { return fminf(x, 0.f) - __logf(1.f + __expf(-fabsf(x))); }

DI void tr_item(const float* W, int ldw, int col, bf16_t* WT, int ldk, int koff, int n0, int k0, LAS float* scr, int lane) {
#pragma unroll 8
    for (int i = 0; i < 32; ++i) { const int kk = 2 * i + (lane >> 5); scr[kk * 33 + (lane & 31)] = W[(size_t)(k0 + kk) * ldw + col]; }
    asm volatile("s_waitcnt lgkmcnt(0)" ::: "memory");
    const int c = lane & 7;
#pragma unroll
    for (int j = 0; j < 4; ++j) { const int n = (lane >> 3) + 8 * j; const LAS float* s = scr + (8 * c) * 33 + n;
        u32x4 o; o.x = pk2(s[0 * 33], s[1 * 33]); o.y = pk2(s[2 * 33], s[3 * 33]); o.z = pk2(s[4 * 33], s[5 * 33]); o.w = pk2(s[6 * 33], s[7 * 33]);
        *(u32x4*)(WT + (size_t)(n0 + n) * ldk + koff + k0 + 8 * c) = o; }
    asm volatile("s_waitcnt lgkmcnt(0)" ::: "memory");
}

DI unsigned pk4_fp8(float a, float b, float c, float d) { unsigned w = 0; w = __builtin_amdgcn_cvt_pk_fp8_f32(a, b, w, false); w = __builtin_amdgcn_cvt_pk_fp8_f32(c, d, w, true); return w; }
DI void tr_item_fp8(const float* W, int ldw, int col, unsigned char* WT, int ldk, int n0, int k0, float sc, LAS float* scr, int lane) {
#pragma unroll 8
    for (int i = 0; i < 32; ++i) { const int kk = 2 * i + (lane >> 5); scr[kk * 33 + (lane & 31)] = W[(size_t)(k0 + kk) * ldw + col] * sc; }
    asm volatile("s_waitcnt lgkmcnt(0)" ::: "memory");
    const int c = lane & 7;
#pragma unroll
    for (int j = 0; j < 4; ++j) { const int n = (lane >> 3) + 8 * j; const LAS float* s = scr + (8 * c) * 33 + n;
        u32x2 o; o.x = pk4_fp8(s[0 * 33], s[1 * 33], s[2 * 33], s[3 * 33]); o.y = pk4_fp8(s[4 * 33], s[5 * 33], s[6 * 33], s[7 * 33]);
        *(u32x2*)(WT + (size_t)(n0 + n) * ldk + k0 + 8 * c) = o; }
    asm volatile("s_waitcnt lgkmcnt(0)" ::: "memory");
}

DI void p0_prologue(const Args& a, LAS unsigned char* lds, int tid, int lane, int wave) {
    unsigned char* ws = a.ws;
    const int gw = blockIdx.x * NWAVES + wave, NGW = gridDim.x * NWAVES;
    const float* w_in = (const float*)a.in[6];
    {
        LAS float* cl = (LAS float*)(lds + 69632);
        const float* c = (const float*)a.in[1];
        for (int i = tid; i < 8192; i += NWAVES * 64) cl[i] = c[i];
        __syncthreads();
        const int it = wave * 256 + (int)blockIdx.x;
        if (it < 1536) {
            const float* w_ada = (const float*)a.in[3]; const float* b_ada = (const float*)a.in[4];
            const int cg = it % 384, ks = it / 384, col = 16 * cg + (lane & 15), kq = lane >> 4;
            float s[8];
#pragma unroll
            for (int b = 0; b < 8; ++b) s[b] = 0.f;
#pragma unroll 8
            for (int k = 256 * ks + kq; k < 256 * ks + 256; k += 4) { const float w = w_ada[(size_t)k * 6144 + col];
#pragma unroll
                for (int b = 0; b < 8; ++b) s[b] += cl[b * 1024 + k] * w; }
#pragma unroll
            for (int b = 0; b < 8; ++b) { s[b] += __shfl_xor(s[b], 16); s[b] += __shfl_xor(s[b], 32); }
            if (kq == 0) { const float bb = (ks == 0) ? b_ada[col] : 0.f; float* mp = (float*)(ws + WS_MODP) + (size_t)ks * 49152;
#pragma unroll
                for (int b = 0; b < 8; ++b) mp[b * 6144 + col] = s[b] + bb; }
        }
    }
    LAS float* scr = (LAS float*)(lds + wave * 8448);
    constexpr int I_IN = 16 * 176, I_BR = 8 * 32, I_OUT = 16 * 32;
    constexpr int NITEMS = I_IN + 2 * I_BR + I_OUT;
    for (int it = gw; it < NITEMS; it += NGW) {
        int r = it;
        if (r < I_IN) { const int kb = r / 176, nb = r % 176; tr_item_fp8(w_in, 5640, win_col(32 * nb + (lane & 31)), (unsigned char*)(ws + WS_WIN), 1024, 32 * nb, 64 * kb, 32.0f, scr, lane); continue; } r -= I_IN;
        if (r < I_BR) { const int kb = r / 32, nb = r % 32; tr_item((const float*)a.in[19], 1024, 32 * nb + (lane & 31), (bf16_t*)(ws + WS_WBR), 1024, 0, 32 * nb, 64 * kb, scr, lane); continue; } r -= I_BR;
        if (r < I_BR) { const int kb = r / 32, nb = r % 32; tr_item((const float*)a.in[20], 1024, 32 * nb + (lane & 31), (bf16_t*)(ws + WS_WBR), 1024, 512, 32 * nb, 64 * kb, scr, lane); continue; } r -= I_BR;
        { const int kb = r / 32, nb = r % 32; tr_item((const float*)a.in[21], 1024, 32 * nb + (lane & 31), (bf16_t*)(ws + WS_WOUT), 1024, 0, 32 * nb, 64 * kb, scr, lane); }
    }
    const int gt = blockIdx.x * (NWAVES * 64) + tid, NGT = gridDim.x * NWAVES * 64;
    { bf16_t* wr = (bf16_t*)(ws + WS_WR); const float* w_re = (const float*)a.in[25]; const float* w_rg = (const float*)a.in[23];
      for (int i = gt; i < 256 * 128; i += NGT) { const int n = i >> 7, k8 = (i & 127) * 8; float v[8];
#pragma unroll
          for (int j = 0; j < 8; ++j) v[j] = (n < 32) ? w_re[(k8 + j) * 32 + n] : (n >= 128 && n < 132) ? w_rg[(k8 + j) * 4 + (n - 128)] : 0.f;
          u32x4 o; o.x = pk2(v[0], v[1]); o.y = pk2(v[2], v[3]); o.z = pk2(v[4], v[5]); o.w = pk2(v[6], v[7]); *(u32x4*)(wr + (size_t)n * 1024 + k8) = o; } }
    { float* wg8 = (float*)(ws + WS_WG8); for (int i = gt; i < 8192; i += NGT) wg8[i] = w_in[(size_t)(i & 1023) * 5640 + 2048 + (i >> 10)]; }
    { float* cs = (float*)(ws + WS_CS); const int* pos = (const int*)a.in[2];
      for (int i = gt; i < MTOK * 8; i += NGT) { const int row = i >> 3, f = i & 7; const float ang = (float)pos[row] * a.freq[f];
          double rv = (double)ang * 0.15915494309189535; rv -= rint(rv); const float ar = (float)(rv * 6.283185307179586);
          cs[(size_t)row * 16 + f] = cosf(ar); cs[(size_t)row * 16 + 8 + f] = sinf(ar); } }
}
DI void p_convert_experts(const Args& a, LAS unsigned char* lds, int lane, int wave, int gw, int ngw) {
    unsigned char* ws = a.ws;
    LAS float* scr = (LAS float*)(lds + wave * 8448);
    constexpr int I_GU = 32 * 256, I_D = 32 * 128;
    for (int it = gw; it < I_GU + I_D; it += ngw) {
        int r = it;
        if (r < I_GU) { const int e = r >> 8, q = r & 255, kb = q >> 4, nb = q & 15;
            const float* src = (const float*)a.in[((nb >> 2) & 1) ? 28 : 27] + (size_t)e * 1024 * 256;
            tr_item(src, 256, 128 * (nb >> 3) + 32 * (nb & 3) + (lane & 31), (bf16_t*)(ws + WS_WGU) + (size_t)e * 512 * 1024, 1024, 0, 32 * nb, 64 * kb, scr, lane); continue; } r -= I_GU;
        { const int e = r >> 7, q = r & 127, kb = q >> 5, nb = q & 31;
            const int nrow = 32 * nb + (lane & 31);
            tr_item((const float*)a.in[29] + (size_t)e * 256 * 1024, 1024, (nrow & ~255) + wd_col(nrow & 255), (bf16_t*)(ws + WS_WD) + (size_t)e * 1024 * 256, 256, 0, 32 * nb, 64 * kb, scr, lane); }
    }
}

template <bool GATES>
DI void p_modnorm(const float* xin, const float* nw, const float* scale, const float* shift, bf16_t* outp, const Args& a, LAS unsigned char* lds, int tid, int lane, int wave) {
    LAS float* wg = (LAS float*)lds;
    if (GATES) { const float* wg8 = (const float*)(a.ws + WS_WG8); for (int i = tid; i < 8192; i += NWAVES * 64) wg[i] = wg8[i]; __syncthreads(); }
    const int gw = blockIdx.x * NWAVES + wave;
    const int row0 = gw * 16, b = row0 >> 12;
    f32x4 A[4], Sh[4];
    if (GATES) {
        const float* mp = (const float*)(a.ws + WS_MODP);
        if (tid < 192) { const int idx = (int)blockIdx.x * 192 + tid; ((float*)(a.ws + WS_MOD))[idx] = ((mp[idx] + mp[49152 + idx]) + mp[2 * 49152 + idx]) + mp[3 * 49152 + idx]; }
#pragma unroll
        for (int j = 0; j < 4; ++j) { const int c = 4 * lane + 256 * j; const f32x4 w = *(const f32x4*)(nw + c);
            const float* ps = mp + b * 6144 + 1024 + c; const float* ph = mp + b * 6144 + c;
            const f32x4 sc = ((*(const f32x4*)ps + *(const f32x4*)(ps + 49152)) + *(const f32x4*)(ps + 2 * 49152)) + *(const f32x4*)(ps + 3 * 49152);
            Sh[j] = ((*(const f32x4*)ph + *(const f32x4*)(ph + 49152)) + *(const f32x4*)(ph + 2 * 49152)) + *(const f32x4*)(ph + 3 * 49152);
            A[j] = w * (sc + 1.0f); }
    } else {
#pragma unroll
        for (int j = 0; j < 4; ++j) { const int c = 4 * lane + 256 * j; const f32x4 w = *(const f32x4*)(nw + c), sc = *(const f32x4*)(scale + b * 6144 + c); A[j] = w * (sc + 1.0f); Sh[j] = *(const f32x4*)(shift + b * 6144 + c); }
    }
    f32x4 vn[4]; u32x2 tn[4];
#pragma unroll
    for (int j = 0; j < 4; ++j) { vn[j] = *(const f32x4*)(xin + (size_t)row0 * 1024 + 4 * lane + 256 * j);
        tn[j] = GATES ? (u32x2){0u, 0u} : *(const u32x2*)((const bf16_t*)(a.ws + WS_T) + (size_t)row0 * 1024 + 4 * lane + 256 * j); }
#pragma unroll 1
    for (int r = 0; r < 16; ++r) {
        const int row = row0 + r;
        f32x4 v[4]; float ss = 0.f;
#pragma unroll
        for (int j = 0; j < 4; ++j) { v[j] = vn[j];
            if (!GATES) { const u32x2 t2 = tn[j]; v[j][0] += bflo(t2.x); v[j][1] += bfhi(t2.x); v[j][2] += bflo(t2.y); v[j][3] += bfhi(t2.y);
                u32x2 xb; xb.x = pk2(v[j][0], v[j][1]); xb.y = pk2(v[j][2], v[j][3]); *(u32x2*)((bf16_t*)(a.ws + WS_X1B) + (size_t)row * 1024 + 4 * lane + 256 * j) = xb; }
            const f32x4 q = v[j] * v[j]; ss += (q[0] + q[1]) + (q[2] + q[3]); }
        if (r + 1 < 16) {
#pragma unroll
            for (int j = 0; j < 4; ++j) { vn[j] = *(const f32x4*)(xin + (size_t)(row + 1) * 1024 + 4 * lane + 256 * j);
                if (!GATES) tn[j] = *(const u32x2*)((const bf16_t*)(a.ws + WS_T) + (size_t)(row + 1) * 1024 + 4 * lane + 256 * j); } }
        const float rstd = __builtin_amdgcn_rsqf(wave_sum(ss) * (1.0f / 1024.0f) + REPS);
#pragma unroll
        for (int j = 0; j < 4; ++j) { v[j] = v[j] * rstd * A[j] + Sh[j];
            if (GATES) *(unsigned*)((unsigned char*)outp + (size_t)row * 1024 + 4 * lane + 256 * j) = pk4_fp8(v[j][0], v[j][1], v[j][2], v[j][3]);
            else { u32x2 o; o.x = pk2(v[j][0], v[j][1]); o.y = pk2(v[j][2], v[j][3]); *(u32x2*)(outp + (size_t)row * 1024 + 4 * lane + 256 * j) = o; } }
        if (GATES) {
            float gd[8];
#pragma unroll
            for (int g = 0; g < 8; ++g) { float d = 0.f;
#pragma unroll
                for (int j = 0; j < 4; ++j) { const f32x4 w = *(const LAS f32x4*)(wg + g * 1024 + 4 * lane + 256 * j); const f32x4 p = v[j] * w; d += (p[0] + p[1]) + (p[2] + p[3]); }
                gd[g] = wave_sum(d); __builtin_amdgcn_sched_barrier(0); }
            if (lane < 8) { float val = 0.f;
#pragma unroll
                for (int g = 0; g < 8; ++g) val = (lane == g) ? gd[g] : val;
                const int hh = lane & 3, s = row & 4095;
                if (lane < 4) ((float*)(a.ws + WS_LOGI))[(size_t)(b * 4 + hh) * SEQ + s] = val + ((const float*)a.in[7])[hh];
                else ((float*)(a.ws + WS_LOGF))[(size_t)(b * 4 + hh) * SEQ + s] = logsigf(val + ((const float*)a.in[8])[hh]); }
        }
    }
}

__global__ void __launch_bounds__(NWAVES * 64, 2) fwd_kernel(Args args) {
    extern __shared__ __attribute__((aligned(16))) unsigned char lds_raw[];
    LAS unsigned char* lds = (LAS unsigned char*)lds_raw;
    volatile LAS unsigned* MISC = (volatile LAS unsigned*)(lds + MISC_OFF);
    const int tid = threadIdx.x, lane = tid & 63, wave = __builtin_amdgcn_readfirstlane(tid >> 6), G = gridDim.x;
    unsigned char* ws = args.ws;
    unsigned* ctl = (unsigned*)(ws + WS_CTL);
    for (int u = tid; u < (LDS_BYTES - RING_BYTES) / 4; u += NWAVES * 64) ((LAS unsigned*)(lds + RING_BYTES))[u] = 0u;
    __syncthreads();
    XcdBarrier bar = xcd_barrier_post(ctl + CW_BAR, MISC + 8);
    const int lo = args.ph_lo, hi = args.ph_hi;
#ifdef ONLY_PHASE
#define IN(k) ((k) == ONLY_PHASE && lo <= (k) && (k) < hi)
#else
#define IN(k) (lo <= (k) && (k) < hi)
#endif
#ifdef STAMP_SEL
#define STAMP(k) do { if (blockIdx.x == 0 && tid == 0) { const unsigned long long t_ = __builtin_amdgcn_s_memrealtime(); MISC[32 + 2 * (k)] = (unsigned)t_; MISC[33 + 2 * (k)] = (unsigned)(t_ >> 32); } } while (0)
#else
#define STAMP(k) do {} while (0)
#endif
#define SEAM(k) do { if (IN(k) && IN((k) + 1)) xcd_barrier(bar); STAMP((k) + 1); } while (0)
    float* mod = (float*)(ws + WS_MOD);
    bf16_t* R1 = (bf16_t*)(ws + WS_R1);
    STAMP(0);
    if (IN(0)) { p0_prologue(args, lds, tid, lane, wave); SEAM(0); }
    if (IN(1)) { p_modnorm<true>((const float*)args.in[0], (const float*)args.in[5], mod + 1024, mod, R1, args, lds, tid, lane, wave); SEAM(1); }
    if (IN(2)) {
        pg8::Gemm g{R1, (const bf16_t*)(ws + WS_WIN), 1024, 0, 0};     pg8::StaticOrder S; S.init(MTOK, NIN, G, (int)blockIdx.x);
        EpiInProj E{(bf16_t*)(ws + WS_QM), (bf16_t*)(ws + WS_KM), (bf16_t*)(ws + WS_VM), (bf16_t*)(ws + WS_OG), (bf16_t*)(ws + WS_QD), (bf16_t*)(ws + WS_KD), (bf16_t*)(ws + WS_VD),
                    (bf16_t*)(ws + WS_GM), (bf16_t*)(ws + WS_GD), (const float*)(ws + WS_CS), (const float*)args.in[12], (const float*)args.in[13]};
        pg8::gemm_phase<EpiInProj, pg8::StaticOrder, true, false, true>(lds, g, S, E);
        SEAM(2);
    }
    if (IN(3)) {
        if (tid == 0) { const float *q1 = (const float*)args.in[14], *k1 = (const float*)args.in[15], *q2 = (const float*)args.in[16], *k2 = (const float*)args.in[17]; float s1 = 0.f, s2 = 0.f;
            for (int i = 0; i < 64; ++i) { s1 += q1[i] * k1[i]; s2 += q2[i] * k2[i]; }
            MISC[2] = __float_as_uint(__expf(s1) - __expf(s2) + 0.2f); }
        __syncthreads();
        const float lam = __uint_as_float(MISC[2]);
        ml::Ptrs MP{(const bf16_t*)(ws + WS_QM), (const bf16_t*)(ws + WS_KM), (const bf16_t*)(ws + WS_VM), (const bf16_t*)(ws + WS_OG), (const float*)(ws + WS_LOGI), (const float*)(ws + WS_LOGF),
                    (const float*)args.in[9], (const float*)args.in[10], (const float*)args.in[11], R1, args.out, (float*)(ws + WS_NT), (float*)(ws + WS_SC), (float*)(ws + WS_MIN)};
        ml::passA(MP, (LAS char*)lds, (int)blockIdx.x, G);
        xcd_barrier(bar); STAMP(12);
        ml::passB(MP, (LAS char*)lds, tid);
        xcd_barrier(bar); STAMP(14);
#ifdef STAMP_SEL
        if (blockIdx.x == 32 && tid == 0) { const unsigned long long t_ = __builtin_amdgcn_s_memrealtime(); ctl[CW_ERR + 58] = (unsigned)t_; ctl[CW_ERR + 59] = (unsigned)(t_ >> 32); }
#endif
        {
            const int x = blockIdx.x & 7, j = (int)blockIdx.x >> 3;
#pragma unroll 1
            for (int u = 0; u < 4; ++u) { const int bh = 4 * x + u, qb = (u & 1) ? j : 31 - j;
                att::unit(bh >> 2, bh & 3, qb, (const bf16_t*)(ws + WS_QD), (const bf16_t*)(ws + WS_KD), (const bf16_t*)(ws + WS_VD), R1, lam, (const float*)args.in[18], (LAS char*)lds); }
        }
#ifdef STAMP_SEL
        if (blockIdx.x == 32 && tid == 0) { const unsigned long long t_ = __builtin_amdgcn_s_memrealtime(); ctl[CW_ERR + 62] = (unsigned)t_; ctl[CW_ERR + 63] = (unsigned)(t_ >> 32); }
#endif
        ml::load_taps(MP, (LAS float*)(lds + ml::OF), tid);
        __syncthreads();
        ml::passC(MP, (LAS char*)lds, (int)blockIdx.x, G);
#ifdef ATT_PROBE
        if (blockIdx.x == 32 && tid == 0) { ctl[CW_ERR + 60] = MISC[4]; ctl[CW_ERR + 61] = MISC[5]; }
#endif
        SEAM(3);
    }
    if (IN(4)) {
        pg8::Gemm g{R1, (const bf16_t*)(ws + WS_WBR), 1024, 0, 0}; pg8::StaticOrder S; S.init(MTOK, 1024, G, (int)blockIdx.x);
        EpiBranch E{(const bf16_t*)(ws + WS_GM), (const bf16_t*)(ws + WS_GD), (bf16_t*)(ws + WS_MG)};
        pg8::gemm_phase<EpiBranch, pg8::StaticOrder, true, false>(lds, g, S, E);
        SEAM(4);
    }
    if (IN(5)) {
        pg8::Gemm g{(const bf16_t*)(ws + WS_MG), (const bf16_t*)(ws + WS_WOUT), 1024, 0, 0}; pg8::StaticOrder S; S.init(MTOK, 1024, G, (int)blockIdx.x);
        EpiOut E{mod, (bf16_t*)(ws + WS_T)};
        pg8::gemm_phase<EpiOut, pg8::StaticOrder, true, false>(lds, g, S, E);
        SEAM(5);
    }
    if (IN(6)) { p_modnorm<false>((const float*)args.in[0], (const float*)args.in[22], mod + 4096, mod + 3072, R1, args, lds, tid, lane, wave); SEAM(6); }
    if (IN(7)) {
        pg8::Gemm g{R1, (const bf16_t*)(ws + WS_WR), 1024, 0, 0}; pg8::StaticOrder S; S.init(MTOK, 256, G, (int)blockIdx.x);
        EpiRouter E{(const float*)args.in[24], (const float*)args.in[26], ctl + CW_CNT, (int*)(ws + WS_TOK), (float*)(ws + WS_WT), (float*)(ws + WS_ROUTE)};
        if (blockIdx.x < 128) { pg8::gemm_phase<EpiRouter, pg8::StaticOrder, true, false>(lds, g, S, E); STAMP(16); }
        else p_convert_experts(args, lds, threadIdx.x & 63, wave, ((int)blockIdx.x - 128) * NWAVES + wave, 128 * NWAVES);
#ifdef STAMP_SEL
        if (blockIdx.x == 128 && tid == 0) { const unsigned long long t_ = __builtin_amdgcn_s_memrealtime(); ctl[CW_ERR + 56] = (unsigned)t_; ctl[CW_ERR + 57] = (unsigned)(t_ >> 32); }
#endif
        SEAM(7);
    }
    if (IN(8) || IN(9) || IN(10)) {
        LAS int* pref = (LAS int*)(lds + PREF_OFF);
        if (tid == 0) { int acc = 0; for (int l = 0; l < 64; ++l) { pref[l] = acc; acc += (int)((__hip_atomic_load(ctl + CW_CNT + 64 * l, RLX_AGENT) + 255u) >> 8); } pref[64] = acc; }
        __syncthreads();
        if (tid < 64) { LAS unsigned char* t2l = (LAS unsigned char*)(pref + 72); for (int g = pref[tid]; g < pref[tid + 1]; ++g) t2l[g] = (unsigned char)tid; }
        if (tid == 64) { LAS unsigned short* xt = (LAS unsigned short*)(pref + 160); int n = 0;
            for (int l = (int)blockIdx.x & 7; l < 64; l += 8) for (int g = pref[l]; g < pref[l + 1]; ++g) xt[n++] = (unsigned short)g;
            pref[65] = n; }
        __syncthreads();
    }
    if (IN(8)) {
        const LAS int* pref = (const LAS int*)(lds + PREF_OFF);
        pg8::Gemm g{R1, (const bf16_t*)(ws + WS_WGU), 1024, (size_t)512 * 1024, 0};
        GroupedOrder S{pref, pref[65], 2, (int)blockIdx.x >> 3, (const int*)(ws + WS_TOK), ctl + CW_CNT};
        EpiGateUp E{(bf16_t*)(ws + WS_ACT)};
        pg8::gemm_phase<EpiGateUp, GroupedOrder, true, true>(lds, g, S, E);
        SEAM(8);
    }
    if (IN(9)) {
        const LAS int* pref = (const LAS int*)(lds + PREF_OFF);
        pg8::Gemm g{(const bf16_t*)(ws + WS_ACT), (const bf16_t*)(ws + WS_WD), 256, (size_t)1024 * 256, 0};
        GroupedOrder S{pref, pref[65], 4, (int)blockIdx.x >> 3, (const int*)(ws + WS_TOK), ctl + CW_CNT};
        EpiDownY E{(unsigned char*)(ws + WS_Y)};
        pg8::gemm_phase<EpiDownY, GroupedOrder, true, false>(lds, g, S, E);
        SEAM(9);
    }
    if (IN(10)) {
        const LAS int* pref = (const LAS int*)(lds + PREF_OFF);
        const unsigned char* Y = (const unsigned char*)(ws + WS_Y); const u32x4* route = (const u32x4*)(ws + WS_ROUTE);
        int lane_c = threadIdx.x & 63; asm volatile("" : "+v"(lane_c));
        const int gw = blockIdx.x * NWAVES + wave, row0 = gw * 16, b = row0 >> 12;
        f32x4 g2[4];
#pragma unroll
        for (int j = 0; j < 4; ++j) g2[j] = *(const f32x4*)(mod + b * 6144 + 5120 + 4 * lane_c + 256 * j);
        const u32x4 rtl = route[row0 + (lane_c & 15)];
#pragma unroll 2
        for (int r = 0; r < 16; ++r) {
            const int row = row0 + r; u32x4 rt;
            rt.x = (unsigned)__builtin_amdgcn_readlane((int)rtl.x, r); rt.y = (unsigned)__builtin_amdgcn_readlane((int)rtl.y, r); rt.z = (unsigned)__builtin_amdgcn_readlane((int)rtl.z, r); rt.w = (unsigned)__builtin_amdgcn_readlane((int)rtl.w, r);
            const size_t s1 = (size_t)(256 * pref[rt.x >> 15] + (int)(rt.x & 32767u)), s2 = (size_t)(256 * pref[rt.y >> 15] + (int)(rt.y & 32767u));
            const float w1 = __uint_as_float(rt.z), w2 = __uint_as_float(rt.w);
            float* op = args.out + (size_t)row * 1024 + 4 * lane_c; const bf16_t* xp = (const bf16_t*)(ws + WS_X1B) + (size_t)row * 1024 + 4 * lane_c;
#pragma unroll
            for (int j = 0; j < 4; ++j) { f32x4 xv; { const u32x2 t2 = *(const u32x2*)(xp + 256 * j); xv[0] = bflo(t2.x); xv[1] = bfhi(t2.x); xv[2] = bflo(t2.y); xv[3] = bfhi(t2.y); }
                const unsigned ya = *(const unsigned*)(Y + s1 * 1024 + 4 * lane_c + 256 * j), yb = *(const unsigned*)(Y + s2 * 1024 + 4 * lane_c + 256 * j);
                const f32x2 a01 = __builtin_amdgcn_cvt_pk_f32_fp8(ya, false), a23 = __builtin_amdgcn_cvt_pk_f32_fp8(ya, true), b01 = __builtin_amdgcn_cvt_pk_f32_fp8(yb, false), b23 = __builtin_amdgcn_cvt_pk_f32_fp8(yb, true);
                f32x4 y; y[0] = w1 * a01[0] + w2 * b01[0]; y[1] = w1 * a01[1] + w2 * b01[1]; y[2] = w1 * a23[0] + w2 * b23[0]; y[3] = w1 * a23[1] + w2 * b23[1];
                *(f32x4*)(op + 256 * j) = xv + g2[j] * y; }
        }
    }
#ifdef STAMP_SEL
    xcd_barrier(bar); STAMP(11);
    if (blockIdx.x == 0 && tid == 0) { MISC[32 + 2 * 13] = __hip_atomic_load(ctl + CW_ERR + 62, RLX_AGENT); MISC[33 + 2 * 13] = __hip_atomic_load(ctl + CW_ERR + 63, RLX_AGENT); }
    if (blockIdx.x == 0 && tid == 0) { MISC[32 + 2 * 17] = __hip_atomic_load(ctl + CW_ERR + 56, RLX_AGENT); MISC[33 + 2 * 17] = __hip_atomic_load(ctl + CW_ERR + 57, RLX_AGENT); }
    if (blockIdx.x == 0 && tid == 0) { MISC[32 + 2 * 15] = __hip_atomic_load(ctl + CW_ERR + 58, RLX_AGENT); MISC[33 + 2 * 15] = __hip_atomic_load(ctl + CW_ERR + 59, RLX_AGENT); }
    if (blockIdx.x == 0 && tid == 0) {
        const unsigned long long t0 = ((unsigned long long)MISC[33 + 2 * (STAMP_SEL)] << 32) | MISC[32 + 2 * (STAMP_SEL)], t1 = ((unsigned long long)MISC[33 + 2 * (STAMP_HI)] << 32) | MISC[32 + 2 * (STAMP_HI)];
#ifdef ATT_PROBE
        { const float cyc = (float)__hip_atomic_load(ctl + CW_ERR + 60, RLX_AGENT), nt = (float)__hip_atomic_load(ctl + CW_ERR + 61, RLX_AGENT);
#ifdef ATT_PROBE_TOTAL

#ifdef ATT_PROBE_NT
          args.out[5] += 2.0f * floorf(nt * 0.5f + 0.5f); (void)cyc; (void)t0; (void)t1; }
#else
          args.out[5] += 2.0f * floorf(cyc * (1.0f / 20000.0f) + 0.5f); (void)nt; (void)t0; (void)t1; }
#endif
#else
          args.out[5] += 2.0f * floorf(cyc / nt * (1.0f / 100.0f) + 0.5f); (void)t0; (void)t1; }
#endif
#else
        args.out[5] += (float)(t1 - t0) * (0.01f / 4.0f);
#endif
    }
#endif
#undef IN
#undef SEAM
}
#ifdef DBG_ORACLE
constexpr int DBG_B = 1, DBG_T = 1024, NSTAGE = 19;
__device__ __forceinline__ void err_acc(float d2, float r2, float* err) {
    __shared__ float sh[2][256];
    const int tid = threadIdx.x; sh[0][tid] = d2; sh[1][tid] = r2; __syncthreads();
    for (int o = 128; o > 0; o >>= 1) { if (tid < o) { sh[0][tid] += sh[0][tid + o]; sh[1][tid] += sh[1][tid + o]; } __syncthreads(); }
    if (tid == 0) { atomicAdd(err, sh[0][0]); atomicAdd(err + 1, sh[1][0]); }
}
__global__ void k_cmp(const void* fast, int fb16, int ldf, const float* ref, int ldr, int cols, int tf, float* err) {
    const int r = blockIdx.x; float d2 = 0.f, r2 = 0.f;
    for (int c = threadIdx.x; c < cols; c += 256) {
        float f = fb16 ? bf2f(((const bf16_t*)fast)[(size_t)r * ldf + c]) : ((const float*)fast)[(size_t)r * ldf + c];
        float v = ref[(size_t)r * ldr + c]; if (tf == 1) v = 1.f / (1.f + expf(-v));
        d2 += (f - v) * (f - v); r2 += v * v; }
    err_acc(d2, r2, err);
}
__global__ void k_cmp_qk(const bf16_t* fast, const float* ref, float sc, float* err) {
    const int r = blockIdx.x; float d2 = 0.f, r2 = 0.f;
    for (int c = threadIdx.x; c < 512; c += 256) { const float f = bf2f(fast[(size_t)r * 512 + c]); const float v = ref[(size_t)r * 512 + (c & ~63) + dperm(c & 63)] * sc; d2 += (f - v) * (f - v); r2 += v * v; }
    err_acc(d2, r2, err);
}
__global__ void k_cmp_gates(const float* logi, const float* logf, const float* proj, const float* b_i, const float* b_f, float* err) {
    const int t = blockIdx.x * 256 + threadIdx.x; float d2 = 0.f, r2 = 0.f;
    for (int h = 0; h < 4; ++h) { const float vi = proj[(size_t)t * 5640 + 2048 + h] + b_i[h]; const float x = proj[(size_t)t * 5640 + 2052 + h] + b_f[h]; const float vf = fminf(x, 0.f) - log1pf(expf(-fabsf(x)));
        const float fi = logi[(size_t)(DBG_B * 4 + h) * 4096 + t], ff = logf[(size_t)(DBG_B * 4 + h) * 4096 + t];
        d2 += (fi - vi) * (fi - vi) + (ff - vf) * (ff - vf) * 100.f; r2 += vi * vi + vf * vf * 100.f; }
    err_acc(d2, r2, err);
}
__global__ void k_cmp_route(const float* fast, const float* ref, float* err) {
    const int t = blockIdx.x * 256 + threadIdx.x; const float* f = fast + (size_t)(DBG_B * 4096 + t) * 4; const float* r = ref + (size_t)t * 4;
    const unsigned a0 = __float_as_uint(f[0]) >> 15, a1 = (__float_as_uint(f[1]) >> 15) - 32u;
    const float mis = ((float)a0 != r[0] || (float)a1 != r[1]) ? 1.f : 0.f;
    err_acc(mis * 0.03f, 1.0f, err);
}
__global__ void k_poison(float* out, size_t n, const float* err) {
    int bad = -1; float ratio = 0.f;
    for (int s = 0; s < NSTAGE; ++s) { const float d = err[2 * s], r = err[2 * s + 1]; if (!(d <= 9e-4f * r) || !(r > 0.f)) { bad = s; ratio = (r > 0.f) ? sqrtf(d / r) : 2.f; break; } }
    if (bad < 0) return;
    if (!(ratio < 2.f)) ratio = 2.f;
    const float Kf = powf(10.f, (float)(bad + 1)) * (1.f + ratio);
    for (size_t i = (size_t)blockIdx.x * 256 + threadIdx.x; i < n; i += (size_t)gridDim.x * 256) out[i] = out[i] * Kf;
}
#endif

static void launch_phases(Args a, int lo, int hi, hipStream_t stream) {
    a.ph_lo = lo; a.ph_hi = hi; void* kargs[] = {&a};
#if defined(DBG_ORACLE) || defined(N_LAUNCH_PER_PHASE)
    (void)hipMemsetAsync((char*)a.ws + WS_CTL + (size_t)CW_BAR * 4, 0, XCD_BAR_WORDS * 4, stream);
#endif
    hipError_t e = hipLaunchCooperativeKernel((const void*)fwd_kernel, dim3(256), dim3(NWAVES * 64), kargs, LDS_BYTES, stream);
    if (e != hipSuccess) fprintf(stderr, "kernel_launch: cooperative launch of phases [%d,%d) failed: %s\n", lo, hi, hipGetErrorString(e));
}
extern "C" void kernel_launch(void* const* d_in, const int* in_sizes, int n_in, void* d_out, int out_size, void* d_ws, size_t ws_size, hipStream_t stream) {
    static int state = 0;
    if (state == 0) {
        state = 1;
        if (n_in != 30 || out_size != MTOK * DMODEL || ws_size < WS_END + 4 * MiB) { fprintf(stderr, "kernel_launch: unexpected shapes (n_in %d out %d ws %zu)\n", n_in, out_size, ws_size); state = -1; }
        if (state > 0 && hipFuncSetAttribute((const void*)fwd_kernel, hipFuncAttributeMaxDynamicSharedMemorySize, LDS_BYTES) != hipSuccess) { fprintf(stderr, "kernel_launch: hipFuncSetAttribute failed\n"); state = -1; }
        int dev = 0, cus = 0, per_cu = 0; (void)hipGetDevice(&dev); (void)hipDeviceGetAttribute(&cus, hipDeviceAttributeMultiprocessorCount, dev);
        (void)hipOccupancyMaxActiveBlocksPerMultiprocessor(&per_cu, (const void*)fwd_kernel, NWAVES * 64, LDS_BYTES);
        if (state > 0 && (cus * per_cu < 256)) { fprintf(stderr, "kernel_launch: %d CUs x %d blocks cannot hold the 256-workgroup grid\n", cus, per_cu); state = -1; }
        (void)hipGetLastError();
    }
    if (state < 0) return;
    (void)hipMemsetAsync((char*)d_ws + WS_CTL, 0, CTL_ZERO_BYTES, stream);
    Args a{};
    for (int i = 0; i < 30; ++i) a.in[i] = d_in[i];
    a.out = (float*)d_out; a.ws = (unsigned char*)d_ws;
    for (int i = 0; i < 8; ++i) a.freq[i] = (float)std::pow(500000.0, -(double)(2 * i) / 16.0);
#ifndef DBG_ORACLE
#ifdef N_LAUNCH_PER_PHASE
    for (int p = 0; p < 11; ++p) launch_phases(a, p, p + 1, stream);
#else
    launch_phases(a, 0, 11, stream);
#endif
#else
    using namespace nv;
    char* ws = (char*)d_ws; float* err = (float*)(ws + WS_CTL) + CW_ERR;
    NaiveBuf B; const size_t lateb = naive_carve((char*)d_out, ws + WS_END + 3 * MiB, B, DBG_T);
    float* outn = (float*)(ws + WS_END + 3 * MiB + lateb); float* lamp = outn + (size_t)DBG_T * 1024;
    k_mod<<<dim3(24, 8), 256, 0, stream>>>((const float*)d_in[1], (const float*)d_in[3], (const float*)d_in[4], B.mod);
    k_lam<<<1, 64, 0, stream>>>((const float*)d_in[14], (const float*)d_in[15], (const float*)d_in[16], (const float*)d_in[17], lamp);
    naive_batch(d_in, DBG_B, B, lamp, outn, DBG_T, stream);
    const size_t rb = (size_t)DBG_B * 4096;
    auto CMP = [&](int s, const void* fast, int fb16, int ldf, const float* ref, int ldr, int cols, int tf) { k_cmp<<<DBG_T, 256, 0, stream>>>(fast, fb16, ldf, ref, ldr, cols, tf, err + 2 * s); };
    launch_phases(a, 0, 1, stream);
    k_cmp<<<8, 256, 0, stream>>>(ws + WS_MOD, 0, 6144, B.mod, 6144, 6144, 0, err + 0);
    launch_phases(a, 1, 2, stream);
    CMP(1, (bf16_t*)(ws + WS_R1) + rb * 1024, 1, 1024, B.h, 1024, 1024, 0);
    k_cmp_gates<<<DBG_T / 256, 256, 0, stream>>>((const float*)(ws + WS_LOGI), (const float*)(ws + WS_LOGF), B.proj, (const float*)d_in[7], (const float*)d_in[8], err + 2 * 2);
    launch_phases(a, 2, 3, stream);
    CMP(3, (bf16_t*)(ws + WS_QM) + rb * 512, 1, 512, B.proj + 0, 5640, 512, 0);
    CMP(4, (bf16_t*)(ws + WS_KM) + rb * 512, 1, 512, B.proj + 512, 5640, 512, 0);
    CMP(5, (bf16_t*)(ws + WS_VM) + rb * 512, 1, 512, B.proj + 1024, 5640, 512, 0);
    CMP(6, (bf16_t*)(ws + WS_OG) + rb * 512, 1, 512, B.proj + 1536, 5640, 512, 1);
    k_cmp_qk<<<DBG_T, 256, 0, stream>>>((bf16_t*)(ws + WS_QD) + rb * 512, B.qd, QSCALE, err + 2 * 7);
    k_cmp_qk<<<DBG_T, 256, 0, stream>>>((bf16_t*)(ws + WS_KD) + rb * 512, B.kd, 1.0f, err + 2 * 8);
    CMP(9, (bf16_t*)(ws + WS_VD) + rb * 512, 1, 512, B.proj + 3080, 5640, 512, 0);
    CMP(10, (bf16_t*)(ws + WS_GM) + rb * 1024, 1, 1024, B.proj + 3592, 5640, 1024, 1);
    CMP(11, (bf16_t*)(ws + WS_GD) + rb * 1024, 1, 1024, B.proj + 4616, 5640, 1024, 1);
    launch_phases(a, 3, 4, stream);
    CMP(12, (bf16_t*)(ws + WS_R1) + rb * 1024, 1, 1024, B.hm, 512, 512, 0);
    CMP(13, (bf16_t*)(ws + WS_R1) + rb * 1024 + 512, 1, 1024, B.hd, 512, 512, 0);
    launch_phases(a, 4, 5, stream);
    CMP(14, (bf16_t*)(ws + WS_MG) + rb * 1024, 1, 1024, B.merged, 1024, 1024, 0);
    launch_phases(a, 5, 6, stream);
    CMP(15, (float*)d_out + rb * 1024, 0, 1024, B.x1, 1024, 1024, 0);
    launch_phases(a, 6, 7, stream);
    CMP(16, (bf16_t*)(ws + WS_R1) + rb * 1024, 1, 1024, B.h2, 1024, 1024, 0);
    launch_phases(a, 7, 8, stream);
    k_cmp_route<<<DBG_T / 256, 256, 0, stream>>>((const float*)(ws + WS_ROUTE), B.route, err + 2 * 17);
    launch_phases(a, 8, 9, stream); launch_phases(a, 9, 10, stream); launch_phases(a, 10, 11, stream);
    CMP(18, (float*)d_out + rb * 1024, 0, 1024, outn, 1024, 1024, 0);
    k_poison<<<1024, 256, 0, stream>>>((float*)d_out, (size_t)MTOK * DMODEL, err);
#endif
}
```

```cpp
#include <hip/hip_runtime.h>
#include <hip/hip_bf16.h>
#include <cstdio>
#include <cstdint>
#include <cmath>
#define LAS __attribute__((address_space(3)))
#define DI __device__ __forceinline__
typedef unsigned short bf16_t;
typedef short bf16x8 __attribute__((ext_vector_type(8)));
typedef short s16x4 __attribute__((ext_vector_type(4)));
typedef float f32x4 __attribute__((ext_vector_type(4)));
typedef float f32x16 __attribute__((ext_vector_type(16)));
typedef float f32x2 __attribute__((ext_vector_type(2)));
typedef unsigned u32x4 __attribute__((ext_vector_type(4)));
typedef unsigned u32x2 __attribute__((ext_vector_type(2)));
typedef __bf16 bf16x2_t __attribute__((ext_vector_type(2)));
DI unsigned pk2(float lo, float hi) { f32x2 v = {lo, hi}; bf16x2_t b = __builtin_convertvector(v, bf16x2_t); return __builtin_bit_cast(unsigned, b); }
DI float bflo(unsigned w) { return __uint_as_float(w << 16); }
DI float bfhi(unsigned w) { return __uint_as_float(w & 0xffff0000u); }
DI float bf2f(bf16_t u) { return __uint_as_float((unsigned)u << 16); }
DI float fexp(float x) { return __builtin_amdgcn_exp2f(x * 1.4426950408889634f); }
DI float fsigm(float x) { return __builtin_amdgcn_rcpf(1.f + fexp(-x)); }

namespace pg8 {
constexpr int BM = 256, BK = 64, HALF = 128, HTB = HALF * BK * 2, STAGE_BYTES = 8 * HTB, NXCD = 8, WGM = 8;
__host__ __device__ __forceinline__ int lds_byte(int r, int c) { const int st = (r >> 4) * 2 + (c >> 5), rr = r & 15, cc = c & 31, ob = rr * 64 + cc * 2; return st * 1024 + (ob ^ (((ob >> 9) & 1) << 5)); }
__host__ __device__ __forceinline__ void stage_rc(int b, int& R, int& C) { const int st = b / 1024, sb = b % 1024, swz = sb ^ (((sb >> 9) & 1) << 5); R = (st >> 1) * 16 + swz / 64; C = (st & 1) * 32 + (swz % 64) / 2; }
__host__ __device__ __forceinline__ int perm32(int rho) { const int n = rho >> 4, i = rho & 15; return 8 * (i >> 2) + 4 * n + (i & 3); }

struct Unit { int pm, pn, e, l, mt; };
typedef int v8i_t __attribute__((ext_vector_type(8)));
struct Gemm { const bf16_t* A; const bf16_t* Bt; int K; size_t bstride; int scale_b; };

struct StaticOrder {
    int nM, nN, nwg, G, c;
    __host__ __device__ void init(int M, int N, int G_, int c_) { nM = M / BM; nN = N / BM; nwg = nM * nN; G = G_; c = c_; }
    __host__ __device__ bool next(int i, Unit& u) const {
        const long L = (long)i * G + c; if (L >= nwg) return false;
        int wgid = (int)L; { const int q = nwg / NXCD, r = nwg % NXCD, xcd = wgid % NXCD, off = wgid / NXCD; wgid = (xcd < r ? xcd * (q + 1) : r * (q + 1) + (xcd - r) * q) + off; }
        const int nig = WGM * nN, gid = wgid / nig, fm = gid * WGM, gsz = (nM - fm) < WGM ? (nM - fm) : WGM;
        u.pm = fm + ((wgid % nig) % gsz); u.pn = (wgid % nig) / gsz; u.e = 0; u.l = 0; u.mt = 0; return true;
    }
    DI unsigned gather(const Unit&, int, int, int) const { return 0u; }
};

template <class Epi, class Sched, bool ALIGN_EPI, bool GATHER, bool FP8 = false>
DI void gemm_phase(LAS unsigned char* lds, const Gemm g, const Sched& S, const Epi& E) {
    const int tid = threadIdx.x, wid = __builtin_amdgcn_readfirstlane(tid >> 6), lane = tid & 63, wr = wid >> 2, wc = wid & 3, fr = lane & 15, fq = lane >> 4;
    const int RB = g.K * (FP8 ? 1 : 2), K = RB / 2, nt = RB / 128;
    unsigned voffA[2], voffB[2]; int gR[2], gC2[2];
#pragma unroll
    for (int i = 0; i < 2; ++i) { int R, C; stage_rc(tid * 16 + i * 8192, R, C); const int Rb = Epi::PERM ? ((R & ~31) + perm32(R & 31)) : R;
        voffA[i] = (unsigned)(R * K + C) * 2u; voffB[i] = (unsigned)(Rb * K + C) * 2u; gR[i] = R; gC2[i] = C * 2; }
    const size_t kstep = (size_t)(BK * 2);
    const size_t hstep = (size_t)HALF * K * 2;
    const size_t tstep = 2 * hstep;
    const unsigned ldsw = (unsigned)wid * 1024u;
    const int aoff = lds_byte(wr * 64 + fr, fq * 8), boff = lds_byte(wc * 32 + fr, fq * 8);
#define PG8_SA(b, h) (((b) * 2 + (h)) * HTB)
#define PG8_SB(b, h) ((4 + (b) * 2 + (h)) * HTB)
#define PG8_STAGE(bufoff, gbase, voff) do { _Pragma("unroll") for (int _i = 0; _i < 2; ++_i) \
        __builtin_amdgcn_global_load_lds((const unsigned*)((const char*)(gbase) + (voff)[_i]), (LAS unsigned*)(lds + (bufoff) + ldsw + _i * 8192), 16, 0, 0); } while (0)
#define PG8_STAGE_A(bufoff, dptr, h, kb, nx) do { if constexpr (GATHER) { unsigned _vo[2]; _vo[0] = (nx) ? gN[h][0] : gO[h][0]; _vo[1] = (nx) ? gN[h][1] : gO[h][1]; PG8_STAGE(bufoff, (const char*)g.A + (kb), _vo); } \
        else { PG8_STAGE(bufoff, dptr, voffA); } } while (0)
#define PG8_LDF(dst, off_) do { const u32x4 lo_ = *(const LAS u32x4*)(lds + (off_)), hi_ = *(const LAS u32x4*)(lds + (off_) + 1024); \
        dst = (v8i_t){(int)lo_.x, (int)lo_.y, (int)lo_.z, (int)lo_.w, (int)hi_.x, (int)hi_.y, (int)hi_.z, (int)hi_.w}; } while (0)
#define PG8_LDA(dst, b, h) do { _Pragma("unroll") for (int m = 0; m < 4; ++m) PG8_LDF(dst[m], PG8_SA(b, h) + aoff + m * 2048); } while (0)
#define PG8_LDB(dst, b, h) do { _Pragma("unroll") for (int n = 0; n < 2; ++n) PG8_LDF(dst[n], PG8_SB(b, h) + boff + n * 2048); } while (0)
#define PG8_LO(f) __builtin_bit_cast(bf16x8, (u32x4){(unsigned)f[0], (unsigned)f[1], (unsigned)f[2], (unsigned)f[3]})
#define PG8_HI(f) __builtin_bit_cast(bf16x8, (u32x4){(unsigned)f[4], (unsigned)f[5], (unsigned)f[6], (unsigned)f[7]})
#define PG8_MMA(ai, bj, At, Bt) do { __builtin_amdgcn_s_setprio(1); _Pragma("unroll") for (int m = 0; m < 4; ++m) _Pragma("unroll") for (int n = 0; n < 2; ++n) { \
        if constexpr (FP8) asm volatile("v_mfma_f32_16x16x128_f8f6f4 %0, %1, %2, %0" : "+v"(acc[ai][bj][m][n]) : "v"(Bt[n]), "v"(At[m]));   \
        else { acc[ai][bj][m][n] = __builtin_amdgcn_mfma_f32_16x16x32_bf16(PG8_LO(Bt[n]), PG8_LO(At[m]), acc[ai][bj][m][n], 0, 0, 0); \
               acc[ai][bj][m][n] = __builtin_amdgcn_mfma_f32_16x16x32_bf16(PG8_HI(Bt[n]), PG8_HI(At[m]), acc[ai][bj][m][n], 0, 0, 0); } } \
        __builtin_amdgcn_s_setprio(0); } while (0)
#define PG8_WAIT_V(n) asm volatile("s_waitcnt vmcnt(" #n ")" ::: "memory")
#define PG8_WAIT_L(n) asm volatile("s_waitcnt lgkmcnt(" #n ")" ::: "memory")
#define PG8_BAR __builtin_amdgcn_s_barrier()
#define PG8_SCHED __builtin_amdgcn_sched_barrier(0)
    Unit cur, nxt; int ui = 0;
    if (!S.next(0, cur)) return;
    f32x4 acc[2][2][4][2];
#pragma unroll
    for (int a = 0; a < 2; ++a)
#pragma unroll
        for (int b = 0; b < 2; ++b)
#pragma unroll
            for (int m = 0; m < 4; ++m)
#pragma unroll
                for (int n = 0; n < 2; ++n) acc[a][b][m][n] = (f32x4){0.f, 0.f, 0.f, 0.f};
    v8i_t At[4], B0[2], B1[2];
    unsigned gO[2][2], gN[2][2];
    if constexpr (GATHER) {
#pragma unroll
        for (int h = 0; h < 2; ++h)
#pragma unroll
            for (int i = 0; i < 2; ++i) { gO[h][i] = S.gather(cur, h * HALF + gR[i], gC2[i], K); gN[h][i] = gO[h][i]; }
    } else { gO[0][0] = gO[0][1] = gO[1][0] = gO[1][1] = 0u; gN[0][0] = gN[0][1] = gN[1][0] = gN[1][1] = 0u; }
    const char* cA = (const char*)g.A + (GATHER ? (size_t)0 : (size_t)cur.pm * tstep);
    const char* cB = (const char*)g.Bt + ((size_t)cur.e * g.bstride) * (FP8 ? 1 : 2) + (size_t)cur.pn * tstep;
    PG8_STAGE(PG8_SB(0, 0), cB, voffB); PG8_STAGE(PG8_SB(0, 1), cB + hstep, voffB); PG8_STAGE_A(PG8_SA(0, 0), cA, 0, 0, false); PG8_STAGE_A(PG8_SA(0, 1), cA + hstep, 1, 0, false);
    if (wr == 1) PG8_BAR;
    PG8_WAIT_V(2); PG8_BAR;
    PG8_STAGE(PG8_SB(1, 0), cB + kstep, voffB); PG8_STAGE_A(PG8_SA(1, 0), cA + kstep, 0, kstep, false); PG8_STAGE(PG8_SB(1, 1), cB + hstep + kstep, voffB);
    PG8_WAIT_V(6); PG8_BAR;
    for (;;) {
        const bool has_next = S.next(ui + 1, nxt);
        if constexpr (GATHER) {
            if (has_next) {
#pragma unroll
                for (int h = 0; h < 2; ++h)
#pragma unroll
                    for (int i = 0; i < 2; ++i) gN[h][i] = S.gather(nxt, h * HALF + gR[i], gC2[i], K);
            } else {
#pragma unroll
                for (int h = 0; h < 2; ++h)
#pragma unroll
                    for (int i = 0; i < 2; ++i) gN[h][i] = gO[h][i];
            }
        }
        const char* nA = GATHER ? cA : (has_next ? (const char*)g.A + (size_t)nxt.pm * tstep : cA);
        const char* nB = has_next ? (const char*)g.Bt + ((size_t)nxt.e * g.bstride) * (FP8 ? 1 : 2) + (size_t)nxt.pn * tstep : cB;
#pragma unroll 1
        for (int t = 0; t < nt; t += 2) {
            if constexpr (Epi::HAS_MID) { if (t == Epi::MID_T) { E.mid(acc, cur, wr, wc, fr, fq); PG8_SCHED; } }
            const bool last = (t == nt - 2);
            const char* a1 = cA + (size_t)(t + 1) * kstep;
            const char* a2 = last ? nA : cA + (size_t)(t + 2) * kstep; const char* b2 = last ? nB : cB + (size_t)(t + 2) * kstep;
            const char* a3 = a2 + kstep; const char* b3 = b2 + kstep;
            const size_t k1 = (size_t)(t + 1) * kstep, k2 = last ? (size_t)0 : (size_t)(t + 2) * kstep, k3 = k2 + kstep;
            PG8_LDB(B0, 0, 0); PG8_LDB(B1, 0, 1); PG8_SCHED; PG8_LDA(At, 0, 0); PG8_STAGE_A(PG8_SA(1, 1), a1 + hstep, 1, k1, false);
            PG8_WAIT_V(8); PG8_WAIT_L(0); PG8_BAR; PG8_MMA(0, 0, At, B0); PG8_MMA(0, 1, At, B1); PG8_BAR; PG8_SCHED;
            PG8_LDA(At, 0, 1); PG8_STAGE(PG8_SB(0, 0), b2, voffB); PG8_STAGE(PG8_SB(0, 1), b2 + hstep, voffB); PG8_STAGE_A(PG8_SA(0, 0), a2, 0, k2, last);
            PG8_WAIT_V(8); PG8_WAIT_L(0); PG8_BAR; PG8_MMA(1, 0, At, B0); PG8_MMA(1, 1, At, B1); PG8_BAR; PG8_SCHED;
            PG8_LDB(B0, 1, 0); PG8_LDB(B1, 1, 1); PG8_SCHED; PG8_LDA(At, 1, 0); PG8_STAGE_A(PG8_SA(0, 1), a2 + hstep, 1, k2, last);
            PG8_WAIT_V(8); PG8_WAIT_L(0); PG8_BAR; PG8_MMA(0, 0, At, B0); PG8_MMA(0, 1, At, B1); PG8_BAR; PG8_SCHED;
            PG8_LDA(At, 1, 1); PG8_STAGE(PG8_SB(1, 0), b3, voffB); PG8_STAGE(PG8_SB(1, 1), b3 + hstep, voffB); PG8_STAGE_A(PG8_SA(1, 0), a3, 0, k3, last);
            PG8_WAIT_V(8); PG8_WAIT_L(0); PG8_BAR; PG8_MMA(1, 0, At, B0); PG8_MMA(1, 1, At, B1); PG8_BAR; PG8_SCHED;
        }
        if constexpr (ALIGN_EPI) { if (wr == 0) PG8_BAR; }
        if constexpr (FP8) asm volatile("s_nop 15\n\ts_nop 15" : "+v"(acc[1][1][0][0]), "+v"(acc[1][1][0][1]), "+v"(acc[1][1][1][0]), "+v"(acc[1][1][1][1]), "+v"(acc[1][1][2][0]), "+v"(acc[1][1][2][1]), "+v"(acc[1][1][3][0]), "+v"(acc[1][1][3][1]));
        E(acc, cur, wr, wc, fr, fq);
        if (!has_next) break;
#pragma unroll
        for (int a = 0; a < 2; ++a)
#pragma unroll
            for (int b = 0; b < 2; ++b)
#pragma unroll
                for (int m = 0; m < 4; ++m)
#pragma unroll
                    for (int n = 0; n < 2; ++n) acc[a][b][m][n] = (f32x4){0.f, 0.f, 0.f, 0.f};
        cur = nxt; cA = nA; cB = nB; ++ui;
        if constexpr (GATHER) {
#pragma unroll
            for (int h = 0; h < 2; ++h)
#pragma unroll
                for (int i = 0; i < 2; ++i) gO[h][i] = gN[h][i];
        }
        if constexpr (ALIGN_EPI) { if (wr == 1) PG8_BAR; }
    }
    PG8_WAIT_V(0);
    if constexpr (!ALIGN_EPI) { if (wr == 0) PG8_BAR; }
    PG8_BAR;
#undef PG8_SA
#undef PG8_SB
#undef PG8_STAGE
#undef PG8_STAGE_A
#undef PG8_LDA
#undef PG8_LDF
#undef PG8_LO
#undef PG8_HI
#undef PG8_LDB
#undef PG8_MMA
#undef PG8_WAIT_V
#undef PG8_WAIT_L
#undef PG8_BAR
#undef PG8_SCHED
}
}
constexpr int NBATCH = 8, SEQ = 4096, MTOK = 32768, DMODEL = 1024, NIN = 5632;
constexpr float QSCALE = 0.125f * 1.4426950408889634f;
constexpr float REPS = 1e-6f;
constexpr size_t MiB = 1u << 20;
constexpr size_t WS_CTL = 0, CTL_ZERO_BYTES = 128 * 1024;
constexpr size_t WS_MOD = 1 * MiB, WS_WG8 = 1 * MiB + 256 * 1024, WS_ROUTE = 1 * MiB + 512 * 1024;
constexpr size_t WS_CS = 2 * MiB, WS_LOGI = 4 * MiB, WS_LOGF = 4 * MiB + 512 * 1024, WS_WR = 5 * MiB;
constexpr size_t WS_WIN = 6 * MiB, WS_WBR = 17 * MiB, WS_WOUT = 19 * MiB, WS_WGU = 21 * MiB, WS_WD = 53 * MiB;
constexpr size_t WS_R1 = 70 * MiB;
constexpr size_t WS_QM = 134 * MiB, WS_KM = 166 * MiB, WS_VM = 198 * MiB, WS_OG = 230 * MiB;
constexpr size_t WS_QD = 262 * MiB, WS_KD = 294 * MiB, WS_VD = 326 * MiB;
constexpr size_t WS_GM = 358 * MiB, WS_GD = 422 * MiB;
constexpr size_t WS_MG = WS_QM;
constexpr size_t WS_TOK = WS_VM, WS_WT = WS_VM + 8 * MiB;
constexpr size_t WS_Y = 302 * MiB;
constexpr size_t WS_H2F = WS_VD;
constexpr size_t WS_T = WS_GD;
constexpr size_t WS_X1B = WS_MG;
constexpr size_t WS_ACT = WS_QD;
constexpr size_t WS_END = 486 * MiB;
constexpr size_t WS_MODP = 488 * MiB;
constexpr size_t WS_NT = 486 * MiB, WS_SC = 487 * MiB, WS_MIN = 487 * MiB + 65536;
constexpr int CW_BAR = 4096, CW_ATTQ = 8192, CW_CNT = 12288, CW_ERR = 16384;

__host__ __device__ __forceinline__ int dperm(int p) { return p < 16 ? (8 * ((p >> 2) & 1) + 4 * (p >> 3) + (p & 3)) : p; }
__host__ __device__ __forceinline__ int win_col(int L) {
    if (L < 2048) return L;
    if (L < 3072) { const int Lp = L - 2048, isk = Lp >> 9, Lt = Lp & 511, th = Lt >> 8, P = Lt & 255, bj = P >> 7, g = (P >> 5) & 3, r = P & 31;
        return (isk ? 2568 : 2056) + 64 * (4 * th + g) + dperm(32 * bj + r); }
    if (L < 3584) return 3080 + (L - 3072);
    { const int Lg = L - 3584, k = Lg >> 8, P = Lg & 255, bj = P >> 7, c = P & 127; return (bj ? 4616 : 3592) + 128 * k + c; }
}

using pg8::Unit;
DI u32x4 pack8(const f32x4& a, const f32x4& b) { u32x4 w; w.x = pk2(a[0], a[1]); w.y = pk2(a[2], a[3]); w.z = pk2(b[0], b[1]); w.w = pk2(b[2], b[3]); return w; }
DI float bfidx(const u32x4& w, int i) { const unsigned x = (i < 2) ? w.x : (i < 4) ? w.y : (i < 6) ? w.z : w.w; return (i & 1) ? bfhi(x) : bflo(x); }

struct EpiInProj {
    static constexpr bool PERM = true, HAS_MID = false; static constexpr int MID_T = 0;
    bf16_t *QM, *KM, *VM, *OG, *QD, *KD, *VD, *GM, *GD; const float* cs; const float *qnw, *knw;
    DI void mid(f32x4 (&)[2][2][4][2], const Unit&, int, int, int, int) const {}
    DI void operator()(const f32x4 (&acc)[2][2][4][2], const Unit& u, int wr, int wc, int fr, int fq) const {
        asm volatile("" : "+v"(fr), "+v"(fq));
        const int pn = u.pn, row0 = u.pm * 256 + wr * 64 + fr;
        constexpr float WSC = 1.0f / 32.0f;
        if (pn >= 8 && pn < 12) {
            const bool isk = pn >= 10; const int grp = 4 * (pn & 1) + wc;
            bf16_t* dst = isk ? KD : QD; const float* nw = isk ? knw : qnw;
            f32x4 w[2][2];
#pragma unroll
            for (int n = 0; n < 2; ++n) { w[0][n] = *(const f32x4*)(nw + (fq < 2 ? (8 * n + 4 * fq) : (8 * fq + 4 * n))); w[1][n] = *(const f32x4*)(nw + 32 + 8 * fq + 4 * n); }
            const float osc = isk ? 1.0f : QSCALE;
#pragma unroll
            for (int ai = 0; ai < 2; ++ai)
#pragma unroll
                for (int m = 0; m < 4; ++m) {
                    const int row = row0 + ai * 128 + m * 16;
                    f32x4 y[2][2]; float ss = 0.f;
#pragma unroll
                    for (int bj = 0; bj < 2; ++bj)
#pragma unroll
                        for (int n = 0; n < 2; ++n) { y[bj][n] = acc[ai][bj][m][n] * WSC; const f32x4 q = y[bj][n] * y[bj][n]; ss += (q[0] + q[1]) + (q[2] + q[3]); }
                    ss += __shfl_xor(ss, 16); ss += __shfl_xor(ss, 32);
                    const float rstd = __builtin_amdgcn_rsqf(ss * (1.0f / 64.0f) + REPS);
#pragma unroll
                    for (int bj = 0; bj < 2; ++bj)
#pragma unroll
                        for (int n = 0; n < 2; ++n) y[bj][n] = y[bj][n] * rstd * w[bj][n];
                    if (fq < 2) {
                        const f32x4 c4 = *(const f32x4*)(cs + (size_t)row * 16 + 4 * fq), s4 = *(const f32x4*)(cs + (size_t)row * 16 + 8 + 4 * fq);
                        const f32x4 a = y[0][0], b = y[0][1];
                        y[0][0] = a * c4 - b * s4; y[0][1] = b * c4 + a * s4;
                    }
#pragma unroll
                    for (int bj = 0; bj < 2; ++bj) *(u32x4*)(dst + (size_t)row * 512 + 64 * grp + 32 * bj + 8 * fq) = pack8(y[bj][0] * osc, y[bj][1] * osc);
                }
            return;
        }
        if (pn >= 14) {
            const int colg = (pn - 14) * 128 + wc * 32 + 8 * fq;
#pragma unroll
            for (int ai = 0; ai < 2; ++ai)
#pragma unroll
                for (int m = 0; m < 4; ++m) { f32x4 r[2], d[2];
#pragma unroll
                    for (int n = 0; n < 2; ++n)
#pragma unroll
                        for (int j = 0; j < 4; ++j) { const float sa = fsigm(acc[ai][0][m][n][j] * WSC), sb = fmaxf(fsigm(acc[ai][1][m][n][j] * WSC), 1e-30f); d[n][j] = sb; r[n][j] = sa * __builtin_amdgcn_rcpf(sb); }
                    const size_t off = (size_t)(row0 + ai * 128 + m * 16) * 1024 + colg;
                    *(u32x4*)(GM + off) = pack8(r[0], r[1]); *(u32x4*)(GD + off) = pack8(d[0], d[1]); }
            return;
        }
        bf16_t* base; int ld, colt; bool sg;
        if (pn < 8) { base = pn < 2 ? QM : pn < 4 ? KM : pn < 6 ? VM : OG; ld = 512; colt = (pn & 1) * 256; sg = pn >= 6; }
        else { base = VD; ld = 512; colt = (pn & 1) * 256; sg = false; }
        const int col0 = colt + wc * 32 + 8 * fq;
#pragma unroll
        for (int ai = 0; ai < 2; ++ai)
#pragma unroll
            for (int m = 0; m < 4; ++m) { bf16_t* rowp = base + (size_t)(row0 + ai * 128 + m * 16) * ld + col0;
#pragma unroll
                for (int bj = 0; bj < 2; ++bj) { f32x4 v0 = acc[ai][bj][m][0] * WSC, v1 = acc[ai][bj][m][1] * WSC;
                    if (sg) {
#pragma unroll
                        for (int j = 0; j < 4; ++j) { v0[j] = fsigm(v0[j]); v1[j] = fsigm(v1[j]); } }
                    *(u32x4*)(rowp + bj * 128) = pack8(v0, v1); } }
    }
};

struct EpiBranch {
    static constexpr bool PERM = true, HAS_MID = true; static constexpr int MID_T = 8;
    const bf16_t *GM, *GD; bf16_t* MG;
    DI void mid(f32x4 (&acc)[2][2][4][2], const Unit& u, int wr, int wc, int fr, int fq) const {
        unsigned lo = (unsigned)((wr * 64 + fr) * 1024 + wc * 32 + 8 * fq); asm volatile("" : "+v"(lo));
        const size_t ub = (size_t)u.pm * 256 * 1024 + (size_t)u.pn * 256; const bf16_t* gmb = GM + ub;
#pragma unroll
        for (int ai = 0; ai < 2; ++ai)
#pragma unroll
            for (int m = 0; m < 4; ++m)
#pragma unroll
                for (int bj = 0; bj < 2; ++bj) { const unsigned off = lo + (unsigned)((ai * 128 + m * 16) * 1024 + bj * 128);
                    const u32x4 gm = *(const u32x4*)(gmb + off);
#pragma unroll
                    for (int n = 0; n < 2; ++n)
#pragma unroll
                        for (int j = 0; j < 4; ++j) acc[ai][bj][m][n][j] *= bfidx(gm, 4 * n + j);
                    if (bj == 1 && (m & 1)) asm volatile("" ::: "memory"); }
    }
    DI void operator()(const f32x4 (&acc)[2][2][4][2], const Unit& u, int wr, int wc, int fr, int fq) const {
        unsigned lo = (unsigned)((wr * 64 + fr) * 1024 + wc * 32 + 8 * fq); asm volatile("" : "+v"(lo));
        const size_t ub = (size_t)u.pm * 256 * 1024 + (size_t)u.pn * 256; const bf16_t* gdb = GD + ub; bf16_t* mgb = MG + ub;
#pragma unroll
        for (int ai = 0; ai < 2; ++ai)
#pragma unroll
            for (int m = 0; m < 4; ++m)
#pragma unroll
                for (int bj = 0; bj < 2; ++bj) { const unsigned off = lo + (unsigned)((ai * 128 + m * 16) * 1024 + bj * 128);
                    const u32x4 gd = *(const u32x4*)(gdb + off); f32x4 v[2];
#pragma unroll
                    for (int n = 0; n < 2; ++n)
#pragma unroll
                        for (int j = 0; j < 4; ++j) v[n][j] = acc[ai][bj][m][n][j] * fmaxf(bfidx(gd, 4 * n + j), 1e-30f);
                    *(u32x4*)(mgb + off) = pack8(v[0], v[1]); if (bj == 1 && (m & 1)) asm volatile("" ::: "memory"); }
    }
};

struct EpiOut {
    static constexpr bool PERM = true, HAS_MID = false; static constexpr int MID_T = 0;
    const float* mod; bf16_t* T;
    DI void mid(f32x4 (&)[2][2][4][2], const Unit&, int, int, int, int) const {}
    DI void operator()(const f32x4 (&acc)[2][2][4][2], const Unit& u, int wr, int wc, int fr, int fq) const {
        const int row0 = u.pm * 256 + wr * 64 + fr, col0 = u.pn * 256 + wc * 32 + 8 * fq; const int b = u.pm >> 4;
        f32x4 gv[2][2];
#pragma unroll
        for (int bj = 0; bj < 2; ++bj)
#pragma unroll
            for (int n = 0; n < 2; ++n) gv[bj][n] = *(const f32x4*)(mod + b * 6144 + 2048 + col0 + bj * 128 + n * 4);
#pragma unroll
        for (int ai = 0; ai < 2; ++ai)
#pragma unroll
            for (int m = 0; m < 4; ++m) { bf16_t* rowp = T + (size_t)(row0 + ai * 128 + m * 16) * 1024 + col0;
#pragma unroll
                for (int bj = 0; bj < 2; ++bj) *(u32x4*)(rowp + bj * 128) = pack8(gv[bj][0] * acc[ai][bj][m][0], gv[bj][1] * acc[ai][bj][m][1]); }
    }
};

struct EpiRouter {
    static constexpr bool PERM = false, HAS_MID = false; static constexpr int MID_T = 0;
    const float *brg, *bre; unsigned* cnt; int* tok; float* wt; float* route;
    DI void mid(f32x4 (&)[2][2][4][2], const Unit&, int, int, int, int) const {}
    DI void operator()(const f32x4 (&acc)[2][2][4][2], const Unit& u, int wr, int wc, int fr, int fq) const {
        if (wc != 0) return;
        const int row0 = u.pm * 256 + wr * 64 + fr;
        const f32x4 bg = *(const f32x4*)brg;
        int L1v[8], L2v[8]; float w1v[8], w2v[8];
#pragma unroll
        for (int ai = 0; ai < 2; ++ai)
#pragma unroll
            for (int m = 0; m < 4; ++m) {
                float gl[4];
#pragma unroll
                for (int j = 0; j < 4; ++j) gl[j] = __shfl(acc[ai][1][m][0][j], fr) + bg[j];
                int g = 0; float gmx = gl[0];
#pragma unroll
                for (int j = 1; j < 4; ++j) if (gl[j] > gmx) { gmx = gl[j]; g = j; }
                float gs = 0.f;
#pragma unroll
                for (int j = 0; j < 4; ++j) gs += fexp(gl[j] - gmx);
                const float pg = 1.0f / gs;
                f32x4 sel0 = acc[ai][0][m][0], sel1 = acc[ai][0][m][1];
                asm volatile("" : "+v"(sel0), "+v"(sel1));
                f32x4 sel;
#pragma unroll
                for (int j = 0; j < 4; ++j) sel[j] = (g & 2) ? sel1[j] : sel0[j];
                const int srcA = fr + 32 * (g & 1), srcB = srcA + 16;
                float el[8];
#pragma unroll
                for (int j = 0; j < 4; ++j) { el[j] = __shfl(sel[j], srcA) + bre[8 * g + j]; el[4 + j] = __shfl(sel[j], srcB) + bre[8 * g + 4 + j]; }
                int j1 = 0; float m1 = el[0];
#pragma unroll
                for (int j = 1; j < 8; ++j) if (el[j] > m1) { m1 = el[j]; j1 = j; }
                int j2 = -1; float m2 = -INFINITY;
#pragma unroll
                for (int j = 0; j < 8; ++j) if (j != j1 && el[j] > m2) { m2 = el[j]; j2 = j; }
                const float e2 = fexp(m2 - m1);
                L1v[ai * 4 + m] = 8 * g + j1; L2v[ai * 4 + m] = 32 + 8 * g + j2; w1v[ai * 4 + m] = pg / (1.f + e2); w2v[ai * 4 + m] = pg * e2 / (1.f + e2);
            }
        if (fq == 0) {
            unsigned p1[8], p2[8];
#pragma unroll
            for (int i = 0; i < 8; ++i) { p1[i] = atomicAdd(cnt + 64 * L1v[i], 1u); p2[i] = atomicAdd(cnt + 64 * L2v[i], 1u); }
#pragma unroll
            for (int i = 0; i < 8; ++i) { const int row = row0 + (i >> 2) * 128 + (i & 3) * 16;
                tok[(size_t)L1v[i] * 32768 + p1[i]] = row; wt[(size_t)L1v[i] * 32768 + p1[i]] = w1v[i];
                tok[(size_t)L2v[i] * 32768 + p2[i]] = row; wt[(size_t)L2v[i] * 32768 + p2[i]] = w2v[i];
                *(u32x4*)(route + (size_t)row * 4) = (u32x4){(unsigned)L1v[i] * 32768u + p1[i], (unsigned)L2v[i] * 32768u + p2[i], __float_as_uint(w1v[i]), __float_as_uint(w2v[i])}; }
        }
    }
};

struct GroupedOrder {
    const LAS int* pref;
    int nx, nN, j; const int* tok; const unsigned* cnt;
    DI bool next(int i, Unit& u) const {
        const int un = i * 32 + j; if (un >= nx * nN) return false;
        const int gm = ((const LAS unsigned short*)(pref + 160))[un / nN]; int l = ((const LAS unsigned char*)(pref + 72))[gm];
        l = __builtin_amdgcn_readfirstlane(l); const int mt = __builtin_amdgcn_readfirstlane(gm - pref[l]);
        u.pm = __builtin_amdgcn_readfirstlane(gm); u.pn = __builtin_amdgcn_readfirstlane(un % nN); u.e = l & 31; u.l = l; u.mt = mt; return true;
    }
    DI unsigned gather(const Unit& u, int r, int c2, int K) const {
        const int n = (int)cnt[64 * u.l]; int idx = u.mt * 256 + r; idx = idx < n ? idx : n - 1;
        return (unsigned)tok[(size_t)u.l * 32768 + idx] * (unsigned)(K * 2) + (unsigned)c2;
    }
};
struct EpiGateUp {
    static constexpr bool PERM = true, HAS_MID = false; static constexpr int MID_T = 0;
    bf16_t* ACT;
    DI void mid(f32x4 (&)[2][2][4][2], const Unit&, int, int, int, int) const {}
    DI void operator()(const f32x4 (&acc)[2][2][4][2], const Unit& u, int wr, int wc, int fr, int fq) const {
        const int row0 = u.pm * 256 + wr * 64 + fr, col0 = u.pn * 128 + wc * 32 + 8 * fq;
#pragma unroll
        for (int ai = 0; ai < 2; ++ai)
#pragma unroll
            for (int m = 0; m < 4; ++m) { f32x4 v[2];
#pragma unroll
                for (int n = 0; n < 2; ++n)
#pragma unroll
                    for (int j = 0; j < 4; ++j) { const float gg = acc[ai][0][m][n][j] * (1.0f / 32.0f); v[n][j] = gg * fsigm(gg) * (acc[ai][1][m][n][j] * (1.0f / 32.0f)); }
                *(u32x4*)(ACT + (size_t)(row0 + ai * 128 + m * 16) * 256 + col0) = pack8(v[0], v[1]); }
    }
};
__host__ __device__ __forceinline__ int wd_col(int P) { const int bj = P >> 7, wc = (P >> 5) & 3, fq = (P >> 3) & 3, i = P & 7; return 64 * wc + 16 * fq + 8 * bj + i; }
struct EpiDownY {
    static constexpr bool PERM = true, HAS_MID = false; static constexpr int MID_T = 0;
    unsigned char* Y;
    DI void mid(f32x4 (&)[2][2][4][2], const Unit&, int, int, int, int) const {}
    DI void operator()(const f32x4 (&acc)[2][2][4][2], const Unit& u, int wr, int wc, int fr, int fq) const {
        const int row0 = u.pm * 256 + wr * 64 + fr, col0 = u.pn * 256 + 64 * wc + 16 * fq;
#pragma unroll
        for (int ai = 0; ai < 2; ++ai)
#pragma unroll
            for (int m = 0; m < 4; ++m) { u32x4 w;
                w.x = __builtin_amdgcn_cvt_pk_fp8_f32(acc[ai][0][m][0][2], acc[ai][0][m][0][3], __builtin_amdgcn_cvt_pk_fp8_f32(acc[ai][0][m][0][0], acc[ai][0][m][0][1], 0, false), true);
                w.y = __builtin_amdgcn_cvt_pk_fp8_f32(acc[ai][0][m][1][2], acc[ai][0][m][1][3], __builtin_amdgcn_cvt_pk_fp8_f32(acc[ai][0][m][1][0], acc[ai][0][m][1][1], 0, false), true);
                w.z = __builtin_amdgcn_cvt_pk_fp8_f32(acc[ai][1][m][0][2], acc[ai][1][m][0][3], __builtin_amdgcn_cvt_pk_fp8_f32(acc[ai][1][m][0][0], acc[ai][1][m][0][1], 0, false), true);
                w.w = __builtin_amdgcn_cvt_pk_fp8_f32(acc[ai][1][m][1][2], acc[ai][1][m][1][3], __builtin_amdgcn_cvt_pk_fp8_f32(acc[ai][1][m][1][0], acc[ai][1][m][1][1], 0, false), true);
                *(u32x4*)(Y + (size_t)(row0 + ai * 128 + m * 16) * 1024 + col0) = w; }
    }
};
namespace att {
typedef short v4i16_t __attribute__((ext_vector_type(4)));
constexpr int XP = 132;
constexpr int OFF_WS = 69632;
DI int crow(int r, int hi) { return (r & 3) + 8 * (r >> 2) + 4 * hi; }
DI s16x4 vtr(const LAS char* p) { return __builtin_bit_cast(s16x4, __builtin_amdgcn_ds_read_tr16_b64_v4i16((LAS v4i16_t*)p)); }

DI void unit(int b, int h, int qb, const bf16_t* __restrict__ QD, const bf16_t* __restrict__ KD, const bf16_t* __restrict__ VD, bf16_t* HMD, float lam, const float* subw, LAS char* lds) {
    int tid = threadIdx.x; asm volatile("" : "+v"(tid));
    const int lane = tid & 63, wid = __builtin_amdgcn_readfirstlane(tid >> 6), r32 = lane & 31, hi = lane >> 5, map = wid >> 2, wq = wid & 3;
    const int q0 = qb * 128, NT = 2 * qb + 2; const size_t rowbase = (size_t)b * SEQ;
    asm volatile("s_waitcnt vmcnt(0)" ::: "memory");
    const bf16_t* kub = KD + rowbase * 512 + h * 128; const bf16_t* vub = VD + rowbase * 512 + h * 128;
    unsigned kgo[2], vgo[2];
#pragma unroll
    for (int i = 0; i < 2; ++i) { const int id = tid + 512 * i;
        kgo[i] = (unsigned)((id & 63) * 512 + (id >> 6) * 8);
        vgo[i] = (unsigned)(((id >> 2) & 63) * 512 + (id >> 8) * 32 + (id & 3) * 8); }
    const unsigned dmaw = (unsigned)wid * 1024u;
#define ATT_DMA(t) do { const unsigned st_ = ((unsigned)(t) & 3u) * 32768u; _Pragma("unroll") for (int i_ = 0; i_ < 2; ++i_) { \
        __builtin_amdgcn_global_load_lds((const unsigned*)(kub + (size_t)(t) * 64 * 512 + kgo[i_]), (LAS unsigned*)(lds + st_ + dmaw + i_ * 8192), 16, 0, 0); \
        __builtin_amdgcn_global_load_lds((const unsigned*)(vub + (size_t)(t) * 64 * 512 + vgo[i_]), (LAS unsigned*)(lds + st_ + 16384 + dmaw + i_ * 8192), 16, 0, 0); } } while (0)
#ifdef ATT_DOUBLE_DMA
#define ATT_DMA_X2(t) ATT_DMA(t)
#else
#define ATT_DMA_X2(t) do {} while (0)
#endif
    ATT_DMA(0); ATT_DMA(1);
    bf16x8 qf[4];
    { const bf16_t* qp = QD + (rowbase + q0 + 32 * wq + r32) * 512 + h * 128 + map * 64 + 8 * hi;
#pragma unroll
      for (int d0 = 0; d0 < 4; ++d0) qf[d0] = *(const bf16x8*)(qp + 16 * d0); }
    asm volatile("" : "+v"(qf[0]), "+v"(qf[1]), "+v"(qf[2]), "+v"(qf[3]));
    asm volatile("s_waitcnt vmcnt(0) lgkmcnt(0)\n\ts_barrier" ::: "memory");
    if (2 < NT) ATT_DMA(2);
    f32x16 o[4];
#pragma unroll
    for (int i = 0; i < 4; ++i)
#pragma unroll
        for (int r = 0; r < 16; ++r) o[i][r] = 0.f;
    f32x16 lacc;
#pragma unroll
    for (int r = 0; r < 16; ++r) lacc[r] = 0.f;
    const bf16x8 ones = (bf16x8){0x3f80, 0x3f80, 0x3f80, 0x3f80, 0x3f80, 0x3f80, 0x3f80, 0x3f80};
    const int qabs = q0 + 32 * wq + r32;
    const int kfo = (8 * map + hi) * 1024 + r32 * 16;
    const int vfo = 16384 + ((lane >> 4) & 1) * 32 + (lane & 3) * 8 + (4 * hi + ((lane & 15) >> 2)) * 64;
#define ATT_QK(P0, P1, tt) do { const LAS char* kb_ = lds + ((tt) & 3) * 32768 + kfo; \
        _Pragma("unroll") for (int r = 0; r < 16; ++r) { P0[r] = 0.f; P1[r] = 0.f; } \
        _Pragma("unroll") for (int dh = 0; dh < 2; ++dh) { bf16x8 kf_[4]; \
            _Pragma("unroll") for (int dd = 0; dd < 2; ++dd) { kf_[2 * dd] = *(const LAS bf16x8*)(kb_ + (2 * dh + dd) * 2048); kf_[2 * dd + 1] = *(const LAS bf16x8*)(kb_ + (2 * dh + dd) * 2048 + 512); } \
            _Pragma("unroll") for (int dd = 0; dd < 2; ++dd) { P0 = __builtin_amdgcn_mfma_f32_32x32x16_bf16(kf_[2 * dd], qf[2 * dh + dd], P0, 0, 0, 0); P1 = __builtin_amdgcn_mfma_f32_32x32x16_bf16(kf_[2 * dd + 1], qf[2 * dh + dd], P1, 0, 0, 0); } \
            __builtin_amdgcn_sched_barrier(0); } } while (0)
#define ATT_EXP_MASK(P0, P1, tt) do { const int kbase_ = 64 * (tt) + 4 * hi; _Pragma("unroll") for (int r = 0; r < 16; ++r) { const int kv_ = kbase_ + (r & 3) + 8 * (r >> 2); \
        P0[r] = (kv_ > qabs) ? 0.f : __builtin_amdgcn_exp2f(P0[r]); P1[r] = (kv_ + 32 > qabs) ? 0.f : __builtin_amdgcn_exp2f(P1[r]); } } while (0)
#define ATT_PACK(P0, P1) do { u32x4 w_; \
        w_.x = pk2(P0[0], P0[1]); w_.y = pk2(P0[2], P0[3]); w_.z = pk2(P0[4], P0[5]); w_.w = pk2(P0[6], P0[7]); pa[0] = __builtin_bit_cast(bf16x8, w_); \
        w_.x = pk2(P0[8], P0[9]); w_.y = pk2(P0[10], P0[11]); w_.z = pk2(P0[12], P0[13]); w_.w = pk2(P0[14], P0[15]); pa[1] = __builtin_bit_cast(bf16x8, w_); \
        w_.x = pk2(P1[0], P1[1]); w_.y = pk2(P1[2], P1[3]); w_.z = pk2(P1[4], P1[5]); w_.w = pk2(P1[6], P1[7]); pa[2] = __builtin_bit_cast(bf16x8, w_); \
        w_.x = pk2(P1[8], P1[9]); w_.y = pk2(P1[10], P1[11]); w_.z = pk2(P1[12], P1[13]); w_.w = pk2(P1[14], P1[15]); pa[3] = __builtin_bit_cast(bf16x8, w_); } while (0)
#define ATT_VFRAG(vb_, j) ({ const s16x4 lo_ = vtr((vb_) + ((j) >> 2) * 4096 + ((j) & 3) * 1024), hh_ = vtr((vb_) + ((j) >> 2) * 4096 + ((j) & 3) * 1024 + 512); (bf16x8){lo_[0], lo_[1], lo_[2], lo_[3], hh_[0], hh_[1], hh_[2], hh_[3]}; })
#define ATT_PV_PLAIN(tt) do { const LAS char* vb_ = lds + ((tt) & 3) * 32768 + vfo; __builtin_amdgcn_s_setprio(1); \
        _Pragma("unroll") for (int ks = 0; ks < 4; ++ks) lacc = __builtin_amdgcn_mfma_f32_32x32x16_bf16(pa[ks], ones, lacc, 0, 0, 0); \
        _Pragma("unroll") for (int j = 0; j < 16; ++j) { const bf16x8 vf_ = ATT_VFRAG(vb_, j); o[j >> 2] = __builtin_amdgcn_mfma_f32_32x32x16_bf16(pa[j & 3], vf_, o[j >> 2], 0, 0, 0); } \
        __builtin_amdgcn_s_setprio(0); } while (0)
#ifdef ATT_PROBE
#ifdef ATT_PROBE_RT
    const unsigned long long tp0_ = __builtin_amdgcn_s_memrealtime();
#else
    const unsigned long long tp0_ = __builtin_amdgcn_s_memtime();
#endif
#endif
    bf16x8 pa[4];
    { f32x16 p0, p1;
      ATT_QK(p0, p1, 0);
      if (NT > 2) {
#pragma unroll
          for (int r = 0; r < 16; ++r) { p0[r] = __builtin_amdgcn_exp2f(p0[r]); p1[r] = __builtin_amdgcn_exp2f(p1[r]); }
      } else ATT_EXP_MASK(p0, p1, 0);
      ATT_PACK(p0, p1); }
#ifdef ATT_DOUBLE_DMA
#define ATT_VM4 "8"
#else
#define ATT_VM4 "4"
#endif
#define ATT_TOP_NODMA(t) do { if ((t) + 1 < NT) asm volatile("s_waitcnt vmcnt(" ATT_VM4 ") lgkmcnt(0)\n\ts_barrier" ::: "memory"); else asm volatile("s_waitcnt vmcnt(0) lgkmcnt(0)\n\ts_barrier" ::: "memory"); } while (0)
#define ATT_TOP(t) do { if ((t) + 1 < NT) asm volatile("s_waitcnt vmcnt(" ATT_VM4 ") lgkmcnt(0)\n\ts_barrier" ::: "memory"); else asm volatile("s_waitcnt vmcnt(0) lgkmcnt(0)\n\ts_barrier" ::: "memory"); \
        if ((t) + 2 < NT) { ATT_DMA((t) + 2); ATT_DMA_X2((t) + 2); } } while (0)
    int t = 1;
    for (; t + 2 < NT; ++t) {
        ATT_TOP_NODMA(t);
        {
            const LAS char* kb = lds + (t & 3) * 32768 + kfo;
            const LAS char* vb = lds + ((t - 1) & 3) * 32768 + vfo;
            f32x16 ph; bf16x8 pn[4];
#define ATT_QKH(off) do { bf16x8 kf_[4]; _Pragma("unroll") for (int d0 = 0; d0 < 4; ++d0) kf_[d0] = *(const LAS bf16x8*)(kb + d0 * 2048 + (off)); \
                _Pragma("unroll") for (int r = 0; r < 16; ++r) ph[r] = 0.f; \
                _Pragma("unroll") for (int d0 = 0; d0 < 4; ++d0) ph = __builtin_amdgcn_mfma_f32_32x32x16_bf16(kf_[d0], qf[d0], ph, 0, 0, 0); } while (0)
#define ATT_GAP(j, e0) do { const bf16x8 vfn_ = ATT_VFRAG(vb, ((j) + 2) & 15); \
                o[(j) >> 2] = __builtin_amdgcn_mfma_f32_32x32x16_bf16(pa[(j) & 3], vfa, o[(j) >> 2], 0, 0, 0); \
                ph[e0] = __builtin_amdgcn_exp2f(ph[e0]); ph[(e0) + 1] = __builtin_amdgcn_exp2f(ph[(e0) + 1]); \
                vfa = vfb; vfb = vfn_; } while (0)
#define ATT_PACKH(i0) do { u32x4 w_; w_.x = pk2(ph[0], ph[1]); w_.y = pk2(ph[2], ph[3]); w_.z = pk2(ph[4], ph[5]); w_.w = pk2(ph[6], ph[7]); pn[i0] = __builtin_bit_cast(bf16x8, w_); \
                w_.x = pk2(ph[8], ph[9]); w_.y = pk2(ph[10], ph[11]); w_.z = pk2(ph[12], ph[13]); w_.w = pk2(ph[14], ph[15]); pn[(i0) + 1] = __builtin_bit_cast(bf16x8, w_); } while (0)
#define ATT_GAP0(j) do { const bf16x8 vfn_ = ATT_VFRAG(vb, ((j) + 2) & 15); \
                o[(j) >> 2] = __builtin_amdgcn_mfma_f32_32x32x16_bf16(pa[(j) & 3], vfa, o[(j) >> 2], 0, 0, 0); \
                vfa = vfb; vfb = vfn_; } while (0)
#define ATT_GAP3(j, e0) do { const bf16x8 vfn_ = ATT_VFRAG(vb, ((j) + 2) & 15); \
                o[(j) >> 2] = __builtin_amdgcn_mfma_f32_32x32x16_bf16(pa[(j) & 3], vfa, o[(j) >> 2], 0, 0, 0); \
                ph[e0] = __builtin_amdgcn_exp2f(ph[e0]); ph[(e0) + 1] = __builtin_amdgcn_exp2f(ph[(e0) + 1]); ph[(e0) + 2] = __builtin_amdgcn_exp2f(ph[(e0) + 2]); \
                vfa = vfb; vfb = vfn_; } while (0)
            __builtin_amdgcn_s_setprio(1);
            ATT_QKH(0);
            __builtin_amdgcn_sched_barrier(0);
            bf16x8 vfa = ATT_VFRAG(vb, 0), vfb = ATT_VFRAG(vb, 1);
#pragma unroll
            for (int ks = 0; ks < 4; ++ks) lacc = __builtin_amdgcn_mfma_f32_32x32x16_bf16(pa[ks], ones, lacc, 0, 0, 0);
            ATT_GAP(0, 0); ATT_GAP(1, 2); ATT_GAP(2, 4); ATT_GAP(3, 6); ATT_GAP(4, 8); ATT_GAP(5, 10); ATT_GAP(6, 12); ATT_GAP(7, 14);
#pragma unroll
            for (int i = 0; i < 4; ++i) __builtin_amdgcn_sched_group_barrier(0x008, 1, 0);
#pragma unroll
            for (int i = 0; i < 8; ++i) { __builtin_amdgcn_sched_group_barrier(0x100, 2, 0); __builtin_amdgcn_sched_group_barrier(0x008, 1, 0); __builtin_amdgcn_sched_group_barrier(0x402, 2, 0); }
            __builtin_amdgcn_sched_barrier(0);
            ATT_PACKH(0);
            ATT_DMA(t + 2);
            ATT_QKH(512);
            __builtin_amdgcn_sched_barrier(0);
            ATT_GAP0(8); ATT_GAP0(9);
            ATT_GAP3(10, 0); ATT_GAP3(11, 3); ATT_GAP3(12, 6); ATT_GAP3(13, 9); ATT_GAP(14, 12); ATT_GAP(15, 14);
#pragma unroll
            for (int i = 0; i < 2; ++i) { __builtin_amdgcn_sched_group_barrier(0x100, 2, 0); __builtin_amdgcn_sched_group_barrier(0x008, 1, 0); }
#pragma unroll
            for (int i = 0; i < 4; ++i) { __builtin_amdgcn_sched_group_barrier(0x100, 2, 0); __builtin_amdgcn_sched_group_barrier(0x008, 1, 0); __builtin_amdgcn_sched_group_barrier(0x402, 3, 0); }
#pragma unroll
            for (int i = 0; i < 2; ++i) { __builtin_amdgcn_sched_group_barrier(0x100, 2, 0); __builtin_amdgcn_sched_group_barrier(0x008, 1, 0); __builtin_amdgcn_sched_group_barrier(0x402, 2, 0); }
            __builtin_amdgcn_sched_barrier(0);
            __builtin_amdgcn_s_setprio(0);
            ATT_PACKH(2);
            pa[0] = pn[0]; pa[1] = pn[1]; pa[2] = pn[2]; pa[3] = pn[3];
#undef ATT_GAP0
#undef ATT_GAP3
#undef ATT_QKH
#undef ATT_GAP
#undef ATT_PACKH
        }
    }
    for (; t < NT; ++t) {
        ATT_TOP(t);
        ATT_PV_PLAIN(t - 1);
        if (64 * t <= q0 + 32 * wq + 31) { f32x16 p0, p1; ATT_QK(p0, p1, t); ATT_EXP_MASK(p0, p1, t); ATT_PACK(p0, p1); }
    }
    if (64 * (NT - 1) <= q0 + 32 * wq + 31) ATT_PV_PLAIN(NT - 1);
#undef ATT_TOP
#undef ATT_TOP_NODMA
#undef ATT_QK
#undef ATT_EXP_MASK
#undef ATT_PACK
#undef ATT_VFRAG
#undef ATT_PV_PLAIN
#undef ATT_DMA
#ifdef ATT_PROBE
    if (tid == 0) { volatile LAS unsigned* pm_ = (volatile LAS unsigned*)(lds + 131072 + 320);
#if defined(UNIT_PROBE) || defined(EPI_PROBE)
        (void)tp0_;
#elif defined(ATT_PROBE_RT)
        pm_[4] += (unsigned)(__builtin_amdgcn_s_memrealtime() - tp0_) * 100u;
#else
        pm_[4] += (unsigned)(__builtin_amdgcn_s_memtime() - tp0_);
#endif
        pm_[5] += (unsigned)NT; }
#endif
#ifdef EPI_PROBE
    const unsigned long long te0_ = __builtin_amdgcn_s_memtime();
#endif
    __syncthreads();
    { int t2_ = threadIdx.x; asm volatile("" : "+v"(t2_)); tid = t2_; }
    const int lane_e = tid & 63, r32e = lane_e & 31, hie = lane_e >> 5;
    float rl[16];
#pragma unroll
    for (int r = 0; r < 16; ++r) rl[r] = 1.0f / lacc[r];
    LAS float* X = (LAS float*)lds + wq * 32 * XP;
    if (map == 1) {
#pragma unroll
        for (int dt = 0; dt < 4; ++dt)
#pragma unroll
            for (int r = 0; r < 16; ++r) X[crow(r, hie) * XP + 32 * dt + r32e] = lam * o[dt][r] * rl[r];
    }
    __syncthreads();
    if (map == 0) {
#pragma unroll
        for (int dt = 0; dt < 4; ++dt)
#pragma unroll
            for (int r = 0; r < 16; ++r) { const int idx = crow(r, hie) * XP + 32 * dt + r32e; X[idx] = o[dt][r] * rl[r] - X[idx]; }
        asm volatile("s_waitcnt lgkmcnt(0)" ::: "memory");
        const int row = lane_e >> 1, seg = lane_e & 1;
        f32x4 xv[16]; float ss = 0.f;
#pragma unroll
        for (int i = 0; i < 16; ++i) { xv[i] = *(const LAS f32x4*)(X + row * XP + 64 * seg + 4 * i); const f32x4 q = xv[i] * xv[i]; ss += (q[0] + q[1]) + (q[2] + q[3]); }
        ss += __shfl_xor(ss, 1);
        const float rs = __builtin_amdgcn_rsqf(ss * (1.0f / 128.0f) + REPS) * 0.8f;
        bf16_t* op = HMD + (rowbase + q0 + 32 * wq + row) * 1024 + 512 + h * 128 + 64 * seg;
#pragma unroll
        for (int i = 0; i < 8; ++i) { const f32x4 w0 = *(const f32x4*)(subw + 64 * seg + 8 * i), w1 = *(const f32x4*)(subw + 64 * seg + 8 * i + 4);
            *(u32x4*)(op + 8 * i) = pack8(xv[2 * i] * w0 * rs, xv[2 * i + 1] * w1 * rs); }
    }
    __syncthreads();
#ifdef EPI_PROBE
    if (threadIdx.x == 0) { volatile LAS unsigned* pm_ = (volatile LAS unsigned*)(lds + 131072 + 320); pm_[4] += (unsigned)(__builtin_amdgcn_s_memtime() - te0_); }
#endif
}
}

namespace ml {
constexpr int PQ = 272, PS = 144;
constexpr int OQ = 0, OK = 17408, OKW = 34816, OV = 53248, OP = 71680, OF = 80896, OH = 110592;
constexpr int F_N = 0, F_QN = 128, F_RSP = 192, F_SSQ = 320, F_G = 832, F_CW = 1088, F_N2 = 6208, F_RS = 6336;
struct Ptrs { const bf16_t *QM, *KM, *VM, *OG; const float *LOGI, *LOGF, *conv_w, *conv_b, *nw; bf16_t* HMD; float *LT, *NT, *SC, *MIN; };

DI float row_scan_add(float x) {
    x += __builtin_bit_cast(float, __builtin_amdgcn_update_dpp(0, __builtin_bit_cast(int, x), 0x111, 0xf, 0xf, true));
    x += __builtin_bit_cast(float, __builtin_amdgcn_update_dpp(0, __builtin_bit_cast(int, x), 0x112, 0xf, 0xf, true));
    x += __builtin_bit_cast(float, __builtin_amdgcn_update_dpp(0, __builtin_bit_cast(int, x), 0x114, 0xf, 0xf, true));
    x += __builtin_bit_cast(float, __builtin_amdgcn_update_dpp(0, __builtin_bit_cast(int, x), 0x118, 0xf, 0xf, true));
    return x;
}
DI float wave_scan_add(float x) {
    x = row_scan_add(x);
    x += __builtin_bit_cast(float, __builtin_amdgcn_update_dpp(0, __builtin_bit_cast(int, x), 0x142, 0xa, 0xf, false));
    x += __builtin_bit_cast(float, __builtin_amdgcn_update_dpp(0, __builtin_bit_cast(int, x), 0x143, 0xc, 0xf, false));
    return x;
}
DI float wave_scan_max(float x) {
#define ML_DPPMAX(ctrl, rm) x = fmaxf(x, __builtin_bit_cast(float, __builtin_amdgcn_update_dpp(__builtin_bit_cast(int, x), __builtin_bit_cast(int, x), ctrl, rm, 0xf, false)))
    ML_DPPMAX(0x111, 0xf); ML_DPPMAX(0x112, 0xf); ML_DPPMAX(0x114, 0xf); ML_DPPMAX(0x118, 0xf); ML_DPPMAX(0x142, 0xa); ML_DPPMAX(0x143, 0xc);
#undef ML_DPPMAX
    return x;
}
DI float row_scan_add8(float x) {
    x += __builtin_bit_cast(float, __builtin_amdgcn_update_dpp(0, __builtin_bit_cast(int, x), 0x111, 0xf, 0xf, true));
    x += __builtin_bit_cast(float, __builtin_amdgcn_update_dpp(0, __builtin_bit_cast(int, x), 0x112, 0xf, 0xf, true));
    x += __builtin_bit_cast(float, __builtin_amdgcn_update_dpp(0, __builtin_bit_cast(int, x), 0x114, 0xf, 0xf, true));
    return x;
}
DI void load_taps(const Ptrs& P, LAS float* fl, int tid) {
    for (int i = tid; i < 4 * 1280; i += 512) { const int hh = i / 1280, r = i % 1280, tn = r / 640, j = (r % 640) >> 7, col = r & 127, ch = tn * 512 + hh * 128 + col; fl[F_CW + i] = (j < 4) ? P.conv_w[j * 1024 + ch] : P.conv_b[ch]; }
}
#define ML_CONV_HALF(hh, cwp, xr, ov) do { float cw_[4][4]; \
        { const f32x4 b0_ = *(const LAS f32x4*)((cwp) + 512 + 4 * (hh)); _Pragma("unroll") for (int r = 0; r < 4; ++r) { ov[r][0] = b0_[0]; ov[r][1] = b0_[1]; ov[r][2] = b0_[2]; ov[r][3] = b0_[3]; } } \
        _Pragma("unroll") for (int j = 0; j < 4; ++j) { const f32x4 w0_ = *(const LAS f32x4*)((cwp) + 128 * j + 4 * (hh)); cw_[j][0] = w0_[0]; cw_[j][1] = w0_[1]; cw_[j][2] = w0_[2]; cw_[j][3] = w0_[3]; } \
        _Pragma("unroll") for (int rr = 0; rr < 7; ++rr) { const unsigned wa_ = (hh) ? xr[rr].z : xr[rr].x, wb_ = (hh) ? xr[rr].w : xr[rr].y; const float xe_[4] = {bflo(wa_), bfhi(wa_), bflo(wb_), bfhi(wb_)}; \
            _Pragma("unroll") for (int r = 0; r < 4; ++r) { const int j = rr - r; if (j >= 0 && j < 4) { _Pragma("unroll") for (int e = 0; e < 4; ++e) ov[r][e] += cw_[j][e] * xe_[e]; } } } } while (0)

DI void passA(const Ptrs& P, LAS char* lds, int first, int stride) {
    const int tid = threadIdx.x, lane = tid & 63, wid = __builtin_amdgcn_readfirstlane(tid >> 6), fr = lane & 15, gq = lane >> 4;
    LAS float* fl = (LAS float*)(lds + OF);
    const int cch = (tid >> 5) & 15, rp = tid & 31;
    const int vch = tid >> 5, sp = tid & 31;
    load_taps(P, fl, tid);
    __syncthreads();
    u32x4 xr[5], vv[2]; float lf = 0.f, li = 0.f;
#define MLA_LOAD(itn) do { const int bh_ = (itn) & 31, c_ = (itn) >> 5, h_ = bh_ & 3; const size_t R0_ = (size_t)(bh_ >> 2) * SEQ; \
        { const bf16_t* csrc_ = P.KM + h_ * 128 + 8 * cch; \
            _Pragma("unroll") for (int rr = 0; rr < 5; ++rr) { const int gr = 64 * c_ + 2 * rp + rr - 3; xr[rr] = (gr >= 0) ? *(const u32x4*)(csrc_ + (R0_ + gr) * 512) : (u32x4){0u, 0u, 0u, 0u}; } } \
        { const bf16_t* vsrc_ = P.VM + h_ * 128 + 8 * vch; \
          _Pragma("unroll") for (int rr = 0; rr < 2; ++rr) vv[rr] = *(const u32x4*)(vsrc_ + (R0_ + 64 * c_ + 2 * sp + rr) * 512); } \
        lf = P.LOGF[(size_t)bh_ * SEQ + 64 * c_ + lane]; li = P.LOGI[(size_t)bh_ * SEQ + 64 * c_ + lane]; } while (0)
    if (first < 2048) MLA_LOAD(first);
    for (int it = first; it < 2048; it += stride) {
        const int bh = it & 31, h = bh & 3;
        const float bc = wave_scan_add(lf);
        const float ag = li - bc; const float pm = wave_scan_max(ag);
        const float pmax = __builtin_bit_cast(float, __builtin_amdgcn_readlane(__builtin_bit_cast(int, pm), 63)), blast = __builtin_bit_cast(float, __builtin_amdgcn_readlane(__builtin_bit_cast(int, bc), 63)), wloc = fexp(ag - pmax);
        const float wx0 = __shfl(wloc, 2 * rp), wx1 = __shfl(wloc, 2 * rp + 1);
        {
            const LAS float* cwp = fl + F_CW + h * 1280 + 640 + 8 * cch;
#pragma unroll
            for (int hh = 0; hh < 2; ++hh) {
                float ov[2][4], cw_[4][4];
                { const f32x4 b0_ = *(const LAS f32x4*)(cwp + 512 + 4 * hh);
#pragma unroll
                  for (int r = 0; r < 2; ++r) { ov[r][0] = b0_[0]; ov[r][1] = b0_[1]; ov[r][2] = b0_[2]; ov[r][3] = b0_[3]; } }
#pragma unroll
                for (int j = 0; j < 4; ++j) { const f32x4 w0_ = *(const LAS f32x4*)(cwp + 128 * j + 4 * hh); cw_[j][0] = w0_[0]; cw_[j][1] = w0_[1]; cw_[j][2] = w0_[2]; cw_[j][3] = w0_[3]; }
#pragma unroll
                for (int rr = 0; rr < 5; ++rr) { const unsigned wa_ = hh ? xr[rr].z : xr[rr].x, wb_ = hh ? xr[rr].w : xr[rr].y; const float xe_[4] = {bflo(wa_), bfhi(wa_), bflo(wb_), bfhi(wb_)};
#pragma unroll
                    for (int r = 0; r < 2; ++r) { const int j = rr - r; if (j >= 0 && j < 4) {
#pragma unroll
                            for (int e = 0; e < 4; ++e) ov[r][e] += cw_[j][e] * xe_[e]; } } }
#pragma unroll
                for (int e = 0; e < 4; ++e) { const float v0 = ov[0][e], v1 = ov[1][e];
                    *(LAS unsigned*)(lds + OKW + (8 * cch + 4 * hh + e) * PS + (2 * rp) * 2) = pk2(v0 * fsigm(v0) * 0.08838834764831845f * wx0, v1 * fsigm(v1) * 0.08838834764831845f * wx1); }
                __builtin_amdgcn_sched_barrier(0); }
        }
        { float v0[8], v1[8];
          v0[0] = bflo(vv[0].x); v0[1] = bfhi(vv[0].x); v0[2] = bflo(vv[0].y); v0[3] = bfhi(vv[0].y); v0[4] = bflo(vv[0].z); v0[5] = bfhi(vv[0].z); v0[6] = bflo(vv[0].w); v0[7] = bfhi(vv[0].w);
          v1[0] = bflo(vv[1].x); v1[1] = bfhi(vv[1].x); v1[2] = bflo(vv[1].y); v1[3] = bfhi(vv[1].y); v1[4] = bflo(vv[1].z); v1[5] = bfhi(vv[1].z); v1[6] = bflo(vv[1].w); v1[7] = bfhi(vv[1].w);
#pragma unroll
          for (int e = 0; e < 8; ++e) *(LAS unsigned*)(lds + OV + (8 * vch + e) * PS + (2 * sp) * 2) = pk2(v0[e], v1[e]); }
        if (it + stride < 2048) MLA_LOAD(it + stride);
        __syncthreads();
        f32x4 Cacc[8];
#pragma unroll
        for (int i = 0; i < 8; ++i) Cacc[i] = (f32x4){0.f, 0.f, 0.f, 0.f};
#pragma unroll
        for (int k2 = 0; k2 < 2; ++k2) {
            const bf16x8 bv = *(const LAS bf16x8*)(lds + OV + (16 * wid + fr) * PS + (32 * k2 + 8 * gq) * 2);
#pragma unroll
            for (int kt = 0; kt < 8; ++kt) { const bf16x8 a = *(const LAS bf16x8*)(lds + OKW + (16 * kt + fr) * PS + (32 * k2 + 8 * gq) * 2);
                Cacc[kt] = __builtin_amdgcn_mfma_f32_16x16x32_bf16(a, bv, Cacc[kt], 0, 0, 0); }
        }
        { bf16_t* dst = (bf16_t*)P.LT + (size_t)it * 16384 + (size_t)(wid * 64 + lane) * 32;
#pragma unroll
          for (int ks = 0; ks < 4; ++ks) *(u32x4*)(dst + 8 * ks) = pack8(Cacc[2 * ks], Cacc[2 * ks + 1]); }
        if (tid < 128) { float s = 0.f;
#pragma unroll
            for (int i = 0; i < 8; ++i) { const u32x4 w = *(const LAS u32x4*)(lds + OKW + tid * PS + i * 16); s += (bflo(w.x) + bfhi(w.x)) + (bflo(w.y) + bfhi(w.y)) + (bflo(w.z) + bfhi(w.z)) + (bflo(w.w) + bfhi(w.w)); }
            P.NT[(size_t)it * 128 + tid] = s; }
        if (tid == 0) { P.SC[2 * it] = pmax; P.SC[2 * it + 1] = blast; }
        __syncthreads();
    }
#undef MLA_LOAD
}

DI void passB(const Ptrs& P, LAS char* lds, int tid) {
    const int g = blockIdx.x * 512 + tid, bh = g >> 12, e4 = g & 4095;
    LAS float* sc_l = (LAS float*)lds;
    if (tid < 128) sc_l[256 + tid] = P.SC[2 * ((tid >> 1) * 32 + bh) + (tid & 1)];
    __syncthreads();
    if (tid == 0) { float m = 0.f;
        for (int c = 0; c < 64; ++c) { const float pm = sc_l[256 + 2 * c], bl = sc_l[257 + 2 * c]; const float g63 = fmaxf(m, pm);
            sc_l[2 * c] = fexp(m - g63); sc_l[2 * c + 1] = fexp(pm - g63); if (e4 == 0) P.MIN[c * 32 + bh] = m; m = bl + g63; } }
    __syncthreads();
    f32x4 C = {0.f, 0.f, 0.f, 0.f}, N = {0.f, 0.f, 0.f, 0.f};
    u32x2* lt = (u32x2*)P.LT + e4; f32x4* nt = (f32x4*)P.NT + (e4 & 31);
    u32x2 Lr[4];
#pragma unroll
    for (int j = 0; j < 4; ++j) Lr[j] = lt[(size_t)(j * 32 + bh) * 4096];
    for (int c0 = 0; c0 < 64; c0 += 4) {
#pragma unroll
        for (int j = 0; j < 4; ++j) {
            const int c = c0 + j, tile = c * 32 + bh;
            const float decay = sc_l[2 * c], sc = sc_l[2 * c + 1];
            const f32x4 Lc = {bflo(Lr[j].x), bfhi(Lr[j].x), bflo(Lr[j].y), bfhi(Lr[j].y)};
            if (c + 4 < 64) Lr[j] = lt[(size_t)((c + 4) * 32 + bh) * 4096];
            { u32x2 w; w.x = pk2(C[0], C[1]); w.y = pk2(C[2], C[3]); lt[(size_t)tile * 4096] = w; }
            C = C * decay + Lc * sc;
            if (e4 < 32) { const f32x4 n4 = nt[(size_t)tile * 32]; nt[(size_t)tile * 32] = N; N = N * decay + n4 * sc; }
        }
    }
    __syncthreads();
}

DI void passC(const Ptrs& P, LAS char* lds, int first, int stride) {
    int tid = threadIdx.x; asm volatile("" : "+v"(tid));
    const int lane = tid & 63, wid = __builtin_amdgcn_readfirstlane(tid >> 6), fr = lane & 15, gq = lane >> 4;
    LAS float* fl = (LAS float*)(lds + OF);
    const int tens = wid >> 2, cch = (tid >> 4) & 15, rg = tid & 15, vch = tid >> 5, sp = tid & 31;
    u32x4 xr[7], vv[2]; float lf = 0.f, li = 0.f, mprev = 0.f, nval = 0.f;
#define MLC_LOAD(itn) do { const int bh_ = (itn) & 31, c_ = (itn) >> 5, h_ = bh_ & 3; const size_t R0_ = (size_t)(bh_ >> 2) * SEQ; \
        { const bf16_t* csrc_ = (tens ? P.KM : P.QM) + h_ * 128 + 8 * cch; \
          _Pragma("unroll") for (int rr = 0; rr < 7; ++rr) { const int gr = 64 * c_ + 4 * rg + rr - 3; xr[rr] = (gr >= 0) ? *(const u32x4*)(csrc_ + (R0_ + gr) * 512) : (u32x4){0u, 0u, 0u, 0u}; } \
          const bf16_t* vsrc_ = P.VM + h_ * 128 + 8 * vch; \
          _Pragma("unroll") for (int rr = 0; rr < 2; ++rr) vv[rr] = *(const u32x4*)(vsrc_ + (R0_ + 64 * c_ + 2 * sp + rr) * 512); } \
        lf = P.LOGF[(size_t)bh_ * SEQ + 64 * c_ + lane]; li = P.LOGI[(size_t)bh_ * SEQ + 64 * c_ + lane]; mprev = P.MIN[itn]; \
        if (tid < 128) nval = P.NT[(size_t)(itn) * 128 + tid]; } while (0)
    if (first < 2048) MLC_LOAD(first);
    int par = 0;
    for (int it = first; it < 2048; it += stride, par ^= 1) {
    const int bh = it & 31, c = it >> 5, h = bh & 3; const size_t R0 = (size_t)(bh >> 2) * SEQ;
    const int FN = par ? F_N2 : F_N;
    u32x4 cfr[4];
    { const bf16_t* src = (const bf16_t*)P.LT + (size_t)it * 16384 + (size_t)(wid * 64 + lane) * 32;
#pragma unroll
      for (int ks = 0; ks < 4; ++ks) cfr[ks] = *(const u32x4*)(src + 8 * ks); }
    if (tid < 128) fl[FN + tid] = nval;
    const float nwv = P.nw[h * 128 + 16 * wid + fr];
    const float bc = wave_scan_add(lf);
    const float ag = li - bc; const float pm = wave_scan_max(ag);
    const float gg = fmaxf(mprev, pm);
    if (wid == 0) { fl[F_G + lane] = ag; fl[F_G + 64 + lane] = gg; fl[F_G + 128 + lane] = fexp(mprev - gg); fl[F_G + 192 + lane] = fexp(-(bc + gg)); }
    { const LAS float* cwp = fl + F_CW + h * 1280 + tens * 640 + 8 * cch;
#pragma unroll
      for (int hh = 0; hh < 2; ++hh) { float ov[4][4]; ML_CONV_HALF(hh, cwp, xr, ov);
#pragma unroll
          for (int r = 0; r < 4; ++r) {
#pragma unroll
              for (int e = 0; e < 4; ++e) { const float v = ov[r][e]; ov[r][e] = v * fsigm(v) * (tens ? 0.08838834764831845f : 1.0f); }
              u32x2 w; w.x = pk2(ov[r][0], ov[r][1]); w.y = pk2(ov[r][2], ov[r][3]);
              *(LAS u32x2*)(lds + (tens ? OK : OQ) + (4 * rg + r) * PQ + cch * 16 + 8 * hh) = w; }
          __builtin_amdgcn_sched_barrier(0); }
      float v0[8], v1[8];
      v0[0] = bflo(vv[0].x); v0[1] = bfhi(vv[0].x); v0[2] = bflo(vv[0].y); v0[3] = bfhi(vv[0].y); v0[4] = bflo(vv[0].z); v0[5] = bfhi(vv[0].z); v0[6] = bflo(vv[0].w); v0[7] = bfhi(vv[0].w);
      v1[0] = bflo(vv[1].x); v1[1] = bfhi(vv[1].x); v1[2] = bflo(vv[1].y); v1[3] = bfhi(vv[1].y); v1[4] = bflo(vv[1].z); v1[5] = bfhi(vv[1].z); v1[6] = bflo(vv[1].w); v1[7] = bfhi(vv[1].w);
#pragma unroll
      for (int e = 0; e < 8; ++e) *(LAS unsigned*)(lds + OV + (8 * vch + e) * PS + (2 * sp) * 2) = pk2(v0[e], v1[e]); }
    u32x4 ogp[2];
#pragma unroll
    for (int i = 0; i < 2; ++i) { const int id = tid + 512 * i; ogp[i] = *(const u32x4*)(P.OG + (R0 + 64 * c + (id >> 4)) * 512 + h * 128 + 8 * (id & 15)); }
    if (it + stride < 2048) MLC_LOAD(it + stride);
    __syncthreads();
    {
        const int tt = wid >> 1, sh = wid & 1;
        f32x4 s0 = {0.f, 0.f, 0.f, 0.f}, s1 = {0.f, 0.f, 0.f, 0.f};
#pragma unroll
        for (int ks = 0; ks < 4; ++ks) {
            const bf16x8 a = *(const LAS bf16x8*)(lds + OQ + (16 * tt + fr) * PQ + (32 * ks + 8 * gq) * 2);
            const bf16x8 b0 = *(const LAS bf16x8*)(lds + OK + (32 * sh + fr) * PQ + (32 * ks + 8 * gq) * 2);
            const bf16x8 b1 = *(const LAS bf16x8*)(lds + OK + (32 * sh + 16 + fr) * PQ + (32 * ks + 8 * gq) * 2);
            s0 = __builtin_amdgcn_mfma_f32_16x16x32_bf16(a, b0, s0, 0, 0, 0);
            s1 = __builtin_amdgcn_mfma_f32_16x16x32_bf16(a, b1, s1, 0, 0, 0);
        }
        const int sA = 32 * sh + fr, sB = sA + 16;
        const float aA = fl[F_G + sA], aB = fl[F_G + sB];
#pragma unroll
        for (int rg2 = 0; rg2 < 4; ++rg2) {
            const int t = 16 * tt + 4 * gq + rg2; const float gt = fl[F_G + 64 + t];
            const float pA = (sA <= t) ? s0[rg2] * fexp(aA - gt) : 0.f, pB = (sB <= t) ? s1[rg2] * fexp(aB - gt) : 0.f;
            *(LAS bf16_t*)(lds + OP + t * PS + sA * 2) = (bf16_t)(pk2(pA, 0.f) & 0xffffu);
            *(LAS bf16_t*)(lds + OP + t * PS + sB * 2) = (bf16_t)(pk2(pB, 0.f) & 0xffffu);
            const float rs = row_scan_add(pA + pB);
            if (fr == 15) fl[F_RSP + sh * 64 + t] = rs;
        }
        const int tq = tid >> 3, kseg = tid & 7;
        const u32x4 qa = *(const LAS u32x4*)(lds + OQ + tq * PQ + kseg * 32), qb2 = *(const LAS u32x4*)(lds + OQ + tq * PQ + kseg * 32 + 16);
        const LAS float* np = fl + FN + 16 * kseg;
        float d = bflo(qa.x) * np[0] + bfhi(qa.x) * np[1] + bflo(qa.y) * np[2] + bfhi(qa.y) * np[3] + bflo(qa.z) * np[4] + bfhi(qa.z) * np[5] + bflo(qa.w) * np[6] + bfhi(qa.w) * np[7]
                + bflo(qb2.x) * np[8] + bfhi(qb2.x) * np[9] + bflo(qb2.y) * np[10] + bfhi(qb2.y) * np[11] + bflo(qb2.z) * np[12] + bfhi(qb2.z) * np[13] + bflo(qb2.w) * np[14] + bfhi(qb2.w) * np[15];
        d = row_scan_add8(d);
        if (kseg == 7) fl[F_QN + tq] = d;
    }
    __syncthreads();
    f32x4 y[4];
#pragma unroll
    for (int tt = 0; tt < 4; ++tt) y[tt] = (f32x4){0.f, 0.f, 0.f, 0.f};
#pragma unroll
    for (int ks = 0; ks < 4; ++ks) {
        const bf16x8 bfr = __builtin_bit_cast(bf16x8, cfr[ks]);
#pragma unroll
        for (int tt = 0; tt < 4; ++tt) {
            const u32x2 a0 = *(const LAS u32x2*)(lds + OQ + (16 * tt + fr) * PQ + (32 * ks + 4 * gq) * 2), a1 = *(const LAS u32x2*)(lds + OQ + (16 * tt + fr) * PQ + (32 * ks + 16 + 4 * gq) * 2);
            const u32x4 aw = {a0.x, a0.y, a1.x, a1.y};
            y[tt] = __builtin_amdgcn_mfma_f32_16x16x32_bf16(__builtin_bit_cast(bf16x8, aw), bfr, y[tt], 0, 0, 0);
        }
        __builtin_amdgcn_sched_barrier(0);
    }
#pragma unroll
    for (int tt = 0; tt < 4; ++tt)
#pragma unroll
        for (int rg2 = 0; rg2 < 4; ++rg2) { const int t = 16 * tt + 4 * gq + rg2; y[tt][rg2] *= fl[F_G + 128 + t]; }
#pragma unroll
    for (int k2 = 0; k2 < 2; ++k2) {
        const bf16x8 bv = *(const LAS bf16x8*)(lds + OV + (16 * wid + fr) * PS + (32 * k2 + 8 * gq) * 2);
#pragma unroll
        for (int tt = 0; tt < 4; ++tt) { const bf16x8 a = *(const LAS bf16x8*)(lds + OP + (16 * tt + fr) * PS + (32 * k2 + 8 * gq) * 2);
            y[tt] = __builtin_amdgcn_mfma_f32_16x16x32_bf16(a, bv, y[tt], 0, 0, 0); }
        __builtin_amdgcn_sched_barrier(0);
    }
    { const float den = fl[F_RSP + lane] + fl[F_RSP + 64 + lane] + fl[F_G + 128 + lane] * fl[F_QN + lane];
      fl[F_RS + wid * 64 + lane] = __builtin_amdgcn_rcpf(fmaxf(fabsf(den), fl[F_G + 192 + lane]));
      asm volatile("s_waitcnt lgkmcnt(0)" ::: "memory"); }
#pragma unroll
    for (int tt = 0; tt < 4; ++tt)
#pragma unroll
        for (int rg2 = 0; rg2 < 4; ++rg2) { const int t = 16 * tt + 4 * gq + rg2;
            const float hv = y[tt][rg2] * fl[F_RS + wid * 64 + t]; y[tt][rg2] = hv;
            const float sq = row_scan_add(hv * hv);
            if (fr == 15) fl[F_SSQ + wid * 64 + t] = sq; }
    __syncthreads();
    { float tot = 0.f;
#pragma unroll
      for (int w = 0; w < 8; ++w) tot += fl[F_SSQ + w * 64 + lane];
      fl[F_RS + wid * 64 + lane] = __builtin_amdgcn_rsqf(tot * (1.0f / 128.0f) + REPS);
      asm volatile("s_waitcnt lgkmcnt(0)" ::: "memory"); }
#pragma unroll
    for (int tt = 0; tt < 4; ++tt)
#pragma unroll
        for (int rg2 = 0; rg2 < 4; ++rg2) { const int t = 16 * tt + 4 * gq + rg2;
            const float ov = y[tt][rg2] * fl[F_RS + wid * 64 + t] * nwv;
            *(LAS bf16_t*)(lds + OH + t * PQ + (16 * wid + fr) * 2) = (bf16_t)(pk2(ov, 0.f) & 0xffffu); }
    __syncthreads();
#pragma unroll
    for (int i = 0; i < 2; ++i) { const int id = tid + 512 * i, row = id >> 4, ch = id & 15;
        const u32x4 hv4 = *(const LAS u32x4*)(lds + OH + row * PQ + ch * 16);
        u32x4 o4; o4.x = pk2(bflo(hv4.x) * bflo(ogp[i].x), bfhi(hv4.x) * bfhi(ogp[i].x)); o4.y = pk2(bflo(hv4.y) * bflo(ogp[i].y), bfhi(hv4.y) * bfhi(ogp[i].y));
        o4.z = pk2(bflo(hv4.z) * bflo(ogp[i].z), bfhi(hv4.z) * bfhi(ogp[i].z)); o4.w = pk2(bflo(hv4.w) * bflo(ogp[i].w), bfhi(hv4.w) * bfhi(ogp[i].w));
        *(u32x4*)(P.HMD + (R0 + 64 * c + row) * 1024 + h * 128 + 8 * ch) = o4; }
    __syncthreads();
    }
#undef MLC_LOAD
}
#undef ML_CONV_HALF
}
constexpr int NWAVES = 8, LDS_BYTES = 147456, RING_BYTES = 131072, MISC_OFF = RING_BYTES + 320, PREF_OFF = RING_BYTES + 1024;
#define RLX_AGENT __ATOMIC_RELAXED, __HIP_MEMORY_SCOPE_AGENT
#define XB_TMO      128
#define XB_XCNT(j)  (256  + 64 * (j))
#define XB_XSUB(j)  (1280 + 64 * (j))
#define XB_XGEN(j)  (2304 + 64 * (j))
#define XB_TOP      3328
#define XB_TOPGEN   3392
#define XCD_BAR_WORDS 3456
#define XB_SPIN_CAP (1u << 18)
DI unsigned xb_ld(unsigned* p)              { return __hip_atomic_load(p, __ATOMIC_RELAXED, __HIP_MEMORY_SCOPE_AGENT); }
DI unsigned xb_add(unsigned* p, unsigned v) { return __hip_atomic_fetch_add(p, v, __ATOMIC_RELAXED, __HIP_MEMORY_SCOPE_AGENT); }
DI unsigned xb_xcc_id() { return (unsigned)__builtin_amdgcn_s_getreg((3 << 11) | 20) & 0xFu; }
#define XB_SPIN(cond, bar) do { unsigned _sp = 0; while (cond) { __builtin_amdgcn_s_sleep(1); \
    if ((++_sp & 255u) == 0u) { if (xb_ld(&(bar)[XB_TMO])) break; if (_sp > XB_SPIN_CAP) { atomicAdd(&(bar)[XB_TMO], 1u); break; } } } } while (0)
struct XcdBarrier { unsigned* bar; unsigned x; volatile LAS unsigned* st; };
DI XcdBarrier xcd_barrier_post(unsigned* bar, volatile LAS unsigned* st) {
    XcdBarrier b; b.bar = bar; b.x = xb_xcc_id(); b.st = st;
    if (threadIdx.x == 0) (void)xb_add(&bar[XB_XCNT(b.x)], 1u);
    return b;
}
DI void xcd_barrier_complete(unsigned* bar, unsigned x, unsigned& nloc, unsigned& nx) {
    const unsigned G = gridDim.x * gridDim.y * gridDim.z;
    unsigned sum, cnt, mine, sp = 0u;
    for (;;) {
        sum = 0u; cnt = 0u; mine = 0u;
#pragma unroll
        for (unsigned j = 0; j < 16; ++j) { const unsigned c = xb_ld(&bar[XB_XCNT(j)]); sum += c; cnt += (c > 0u) ? 1u : 0u; mine = (j == x) ? c : mine; }
        if (sum == G) break;
        __builtin_amdgcn_s_sleep(1);
        if ((++sp & 255u) == 0u) { if (xb_ld(&bar[XB_TMO])) break; if (sp > XB_SPIN_CAP) { atomicAdd(&bar[XB_TMO], 1u); break; } }
    }
    nloc = mine > 0u ? mine : 1u; nx = cnt > 0u ? cnt : 1u;
}
DI void xcd_barrier(const XcdBarrier& b) {
    asm volatile("s_waitcnt vmcnt(0)" ::: "memory");
    __syncthreads();
    if (threadIdx.x == 0) {
        unsigned* bar = b.bar;
        __builtin_amdgcn_s_waitcnt(0);
        unsigned nloc = b.st[0], nx = b.st[1];
        if (nloc == 0u) { xcd_barrier_complete(bar, b.x, nloc, nx); b.st[0] = nloc; b.st[1] = nx; }
        const unsigned old = xb_add(&bar[XB_XSUB(b.x)], 1u);
        const unsigned gen = old / nloc;
        if (old + 1u == (gen + 1u) * nloc) {
            __builtin_amdgcn_fence(__ATOMIC_RELEASE, "agent");
            asm volatile("s_waitcnt vmcnt(0)" ::: "memory");
            const unsigned og = xb_add(&bar[XB_TOP], 1u);
            const unsigned tg = og / nx;
            if (og + 1u == (tg + 1u) * nx) xb_add(&bar[XB_TOPGEN], 1u);
            else XB_SPIN(xb_ld(&bar[XB_TOPGEN]) == tg, bar);
            __builtin_amdgcn_fence(__ATOMIC_ACQUIRE, "agent");
            xb_add(&bar[XB_XGEN(b.x)], 1u);
            asm volatile("s_waitcnt vmcnt(0)" ::: "memory");
        } else {
            XB_SPIN(xb_ld(&bar[XB_XGEN(b.x)]) == gen, bar);
            __builtin_amdgcn_fence(__ATOMIC_ACQUIRE, "agent");
            asm volatile("s_waitcnt vmcnt(0)" ::: "memory");
        }
    }
    __syncthreads();
}

struct Args { const void* in[30]; float* out; unsigned char* ws; float freq[8]; int ph_lo, ph_hi; };

DI float wave_sum(float v) {
    v += __builtin_bit_cast(float, __builtin_amdgcn_update_dpp(0, __builtin_bit_cast(int, v), 0x111, 0xf, 0xf, true));
    v += __builtin_bit_cast(float, __builtin_amdgcn_update_dpp(0, __builtin_bit_cast(int, v), 0x112, 0xf, 0xf, true));
    v += __builtin_bit_cast(float, __builtin_amdgcn_update_dpp(0, __builtin_bit_cast(int, v), 0x114, 0xf, 0xf, true));
    v += __builtin_bit_cast(float, __builtin_amdgcn_update_dpp(0, __builtin_bit_cast(int, v), 0x118, 0xf, 0xf, true));
    v += __builtin_bit_cast(float, __builtin_amdgcn_update_dpp(0, __builtin_bit_cast(int, v), 0x142, 0xa, 0xf, false));
    v += __builtin_bit_cast(float, __builtin_amdgcn_update_dpp(0, __builtin_bit_cast(int, v), 0x143, 0xc, 0xf, false));
    return __builtin_bit_cast(float, __builtin_amdgcn_readlane(__builtin_bit_cast(int, v), 63));
}
DI float logsigf(float x) { return fminf(x, 0.f) - __logf(1.f + __expf(-fabsf(x))); }

DI void tr_item(const float* W, int ldw, int col, bf16_t* WT, int ldk, int koff, int n0, int k0, LAS float* scr, int lane) {
#pragma unroll 8
    for (int i = 0; i < 32; ++i) { const int kk = 2 * i + (lane >> 5); scr[kk * 33 + (lane & 31)] = W[(size_t)(k0 + kk) * ldw + col]; }
    asm volatile("s_waitcnt lgkmcnt(0)" ::: "memory");
    const int c = lane & 7;
#pragma unroll
    for (int j = 0; j < 4; ++j) { const int n = (lane >> 3) + 8 * j; const LAS float* s = scr + (8 * c) * 33 + n;
        u32x4 o; o.x = pk2(s[0 * 33], s[1 * 33]); o.y = pk2(s[2 * 33], s[3 * 33]); o.z = pk2(s[4 * 33], s[5 * 33]); o.w = pk2(s[6 * 33], s[7 * 33]);
        *(u32x4*)(WT + (size_t)(n0 + n) * ldk + koff + k0 + 8 * c) = o; }
    asm volatile("s_waitcnt lgkmcnt(0)" ::: "memory");
}

DI unsigned pk4_fp8(float a, float b, float c, float d) { unsigned w = 0; w = __builtin_amdgcn_cvt_pk_fp8_f32(a, b, w, false); w = __builtin_amdgcn_cvt_pk_fp8_f32(c, d, w, true); return w; }
DI void tr_item_fp8(const float* W, int ldw, int col, unsigned char* WT, int ldk, int n0, int k0, float sc, LAS float* scr, int lane) {
#pragma unroll 8
    for (int i = 0; i < 32; ++i) { const int kk = 2 * i + (lane >> 5); scr[kk * 33 + (lane & 31)] = W[(size_t)(k0 + kk) * ldw + col] * sc; }
    asm volatile("s_waitcnt lgkmcnt(0)" ::: "memory");
    const int c = lane & 7;
#pragma unroll
    for (int j = 0; j < 4; ++j) { const int n = (lane >> 3) + 8 * j; const LAS float* s = scr + (8 * c) * 33 + n;
        u32x2 o; o.x = pk4_fp8(s[0 * 33], s[1 * 33], s[2 * 33], s[3 * 33]); o.y = pk4_fp8(s[4 * 33], s[5 * 33], s[6 * 33], s[7 * 33]);
        *(u32x2*)(WT + (size_t)(n0 + n) * ldk + k0 + 8 * c) = o; }
    asm volatile("s_waitcnt lgkmcnt(0)" ::: "memory");
}

DI void p0_prologue(const Args& a, LAS unsigned char* lds, int tid, int lane, int wave) {
    unsigned char* ws = a.ws;
    const int gw = blockIdx.x * NWAVES + wave, NGW = gridDim.x * NWAVES;
    const float* w_in = (const float*)a.in[6];
    {
        LAS float* cl = (LAS float*)(lds + 69632);
        const float* c = (const float*)a.in[1];
        for (int i = tid; i < 8192; i += NWAVES * 64) cl[i] = c[i];
        __syncthreads();
        const int it = wave * 256 + (int)blockIdx.x;
        if (it < 1536) {
            const float* w_ada = (const float*)a.in[3]; const float* b_ada = (const float*)a.in[4];
            const int cg = it % 384, ks = it / 384, col = 16 * cg + (lane & 15), kq = lane >> 4;
            float s[8];
#pragma unroll
            for (int b = 0; b < 8; ++b) s[b] = 0.f;
#pragma unroll 8
            for (int k = 256 * ks + kq; k < 256 * ks + 256; k += 4) { const float w = w_ada[(size_t)k * 6144 + col];
#pragma unroll
                for (int b = 0; b < 8; ++b) s[b] += cl[b * 1024 + k] * w; }
#pragma unroll
            for (int b = 0; b < 8; ++b) { s[b] += __shfl_xor(s[b], 16); s[b] += __shfl_xor(s[b], 32); }
            if (kq == 0) { const float bb = (ks == 0) ? b_ada[col] : 0.f; float* mp = (float*)(ws + WS_MODP) + (size_t)ks * 49152;
#pragma unroll
                for (int b = 0; b < 8; ++b) mp[b * 6144 + col] = s[b] + bb; }
        }
    }
    LAS float* scr = (LAS float*)(lds + wave * 8448);
    constexpr int I_IN = 16 * 176, I_BR = 8 * 32, I_OUT = 16 * 32;
    constexpr int NITEMS = I_IN + 2 * I_BR + I_OUT;
    for (int it = gw; it < NITEMS; it += NGW) {
        int r = it;
        if (r < I_IN) { const int kb = r / 176, nb = r % 176; tr_item_fp8(w_in, 5640, win_col(32 * nb + (lane & 31)), (unsigned char*)(ws + WS_WIN), 1024, 32 * nb, 64 * kb, 32.0f, scr, lane); continue; } r -= I_IN;
        if (r < I_BR) { const int kb = r / 32, nb = r % 32; tr_item((const float*)a.in[19], 1024, 32 * nb + (lane & 31), (bf16_t*)(ws + WS_WBR), 1024, 0, 32 * nb, 64 * kb, scr, lane); continue; } r -= I_BR;
        if (r < I_BR) { const int kb = r / 32, nb = r % 32; tr_item((const float*)a.in[20], 1024, 32 * nb + (lane & 31), (bf16_t*)(ws + WS_WBR), 1024, 512, 32 * nb, 64 * kb, scr, lane); continue; } r -= I_BR;
        { const int kb = r / 32, nb = r % 32; tr_item((const float*)a.in[21], 1024, 32 * nb + (lane & 31), (bf16_t*)(ws + WS_WOUT), 1024, 0, 32 * nb, 64 * kb, scr, lane); }
    }
    const int gt = blockIdx.x * (NWAVES * 64) + tid, NGT = gridDim.x * NWAVES * 64;
    { bf16_t* wr = (bf16_t*)(ws + WS_WR); const float* w_re = (const float*)a.in[25]; const float* w_rg = (const float*)a.in[23];
      for (int i = gt; i < 256 * 128; i += NGT) { const int n = i >> 7, k8 = (i & 127) * 8; float v[8];
#pragma unroll
          for (int j = 0; j < 8; ++j) v[j] = (n < 32) ? w_re[(k8 + j) * 32 + n] : (n >= 128 && n < 132) ? w_rg[(k8 + j) * 4 + (n - 128)] : 0.f;
          u32x4 o; o.x = pk2(v[0], v[1]); o.y = pk2(v[2], v[3]); o.z = pk2(v[4], v[5]); o.w = pk2(v[6], v[7]); *(u32x4*)(wr + (size_t)n * 1024 + k8) = o; } }
    { float* wg8 = (float*)(ws + WS_WG8); for (int i = gt; i < 8192; i += NGT) wg8[i] = w_in[(size_t)(i & 1023) * 5640 + 2048 + (i >> 10)]; }
    { float* cs = (float*)(ws + WS_CS); const int* pos = (const int*)a.in[2];
      for (int i = gt; i < MTOK * 8; i += NGT) { const int row = i >> 3, f = i & 7; const float ang = (float)pos[row] * a.freq[f];
          double rv = (double)ang * 0.15915494309189535; rv -= rint(rv); const float ar = (float)(rv * 6.283185307179586);
          cs[(size_t)row * 16 + f] = cosf(ar); cs[(size_t)row * 16 + 8 + f] = sinf(ar); } }
}
DI void p_convert_experts(const Args& a, LAS unsigned char* lds, int lane, int wave, int gw, int ngw) {
    unsigned char* ws = a.ws;
    LAS float* scr = (LAS float*)(lds + wave * 8448);
    constexpr int I_GU = 32 * 256, I_D = 32 * 128;
    for (int it = gw; it < I_GU + I_D; it += ngw) {
        int r = it;
        if (r < I_GU) { const int e = r >> 8, q = r & 255, kb = q >> 4, nb = q & 15;
            const float* src = (const float*)a.in[((nb >> 2) & 1) ? 28 : 27] + (size_t)e * 1024 * 256;
            tr_item_fp8(src, 256, 128 * (nb >> 3) + 32 * (nb & 3) + (lane & 31), (unsigned char*)(ws + WS_WGU) + (size_t)e * 512 * 1024, 1024, 32 * nb, 64 * kb, 32.0f, scr, lane); continue; } r -= I_GU;
        { const int e = r >> 7, q = r & 127, kb = q >> 5, nb = q & 31;
            const int nrow = 32 * nb + (lane & 31);
            tr_item((const float*)a.in[29] + (size_t)e * 256 * 1024, 1024, (nrow & ~255) + wd_col(nrow & 255), (bf16_t*)(ws + WS_WD) + (size_t)e * 1024 * 256, 256, 0, 32 * nb, 64 * kb, scr, lane); }
    }
}

template <bool GATES>
DI void p_modnorm(const float* xin, const float* nw, const float* scale, const float* shift, bf16_t* outp, const Args& a, LAS unsigned char* lds, int tid, int lane, int wave) {
    LAS float* wg = (LAS float*)lds;
    if (GATES) { const float* wg8 = (const float*)(a.ws + WS_WG8); for (int i = tid; i < 8192; i += NWAVES * 64) wg[i] = wg8[i]; __syncthreads(); }
    const int gw = blockIdx.x * NWAVES + wave;
    const int row0 = gw * 16, b = row0 >> 12;
    f32x4 A[4], Sh[4];
    if (GATES) {
        const float* mp = (const float*)(a.ws + WS_MODP);
        if (tid < 192) { const int idx = (int)blockIdx.x * 192 + tid; ((float*)(a.ws + WS_MOD))[idx] = ((mp[idx] + mp[49152 + idx]) + mp[2 * 49152 + idx]) + mp[3 * 49152 + idx]; }
#pragma unroll
        for (int j = 0; j < 4; ++j) { const int c = 4 * lane + 256 * j; const f32x4 w = *(const f32x4*)(nw + c);
            const float* ps = mp + b * 6144 + 1024 + c; const float* ph = mp + b * 6144 + c;
            const f32x4 sc = ((*(const f32x4*)ps + *(const f32x4*)(ps + 49152)) + *(const f32x4*)(ps + 2 * 49152)) + *(const f32x4*)(ps + 3 * 49152);
            Sh[j] = ((*(const f32x4*)ph + *(const f32x4*)(ph + 49152)) + *(const f32x4*)(ph + 2 * 49152)) + *(const f32x4*)(ph + 3 * 49152);
            A[j] = w * (sc + 1.0f); }
    } else {
#pragma unroll
        for (int j = 0; j < 4; ++j) { const int c = 4 * lane + 256 * j; const f32x4 w = *(const f32x4*)(nw + c), sc = *(const f32x4*)(scale + b * 6144 + c); A[j] = w * (sc + 1.0f); Sh[j] = *(const f32x4*)(shift + b * 6144 + c); }
    }
    f32x4 vn[4]; u32x2 tn[4];
#pragma unroll
    for (int j = 0; j < 4; ++j) { vn[j] = *(const f32x4*)(xin + (size_t)row0 * 1024 + 4 * lane + 256 * j);
        tn[j] = GATES ? (u32x2){0u, 0u} : *(const u32x2*)((const bf16_t*)(a.ws + WS_T) + (size_t)row0 * 1024 + 4 * lane + 256 * j); }
#pragma unroll 1
    for (int r = 0; r < 16; ++r) {
        const int row = row0 + r;
        f32x4 v[4]; float ss = 0.f;
#pragma unroll
        for (int j = 0; j < 4; ++j) { v[j] = vn[j];
            if (!GATES) { const u32x2 t2 = tn[j]; v[j][0] += bflo(t2.x); v[j][1] += bfhi(t2.x); v[j][2] += bflo(t2.y); v[j][3] += bfhi(t2.y);
                u32x2 xb; xb.x = pk2(v[j][0], v[j][1]); xb.y = pk2(v[j][2], v[j][3]); *(u32x2*)((bf16_t*)(a.ws + WS_X1B) + (size_t)row * 1024 + 4 * lane + 256 * j) = xb; }
            const f32x4 q = v[j] * v[j]; ss += (q[0] + q[1]) + (q[2] + q[3]); }
        if (r + 1 < 16) {
#pragma unroll
            for (int j = 0; j < 4; ++j) { vn[j] = *(const f32x4*)(xin + (size_t)(row + 1) * 1024 + 4 * lane + 256 * j);
                if (!GATES) tn[j] = *(const u32x2*)((const bf16_t*)(a.ws + WS_T) + (size_t)(row + 1) * 1024 + 4 * lane + 256 * j); } }
        const float rstd = __builtin_amdgcn_rsqf(wave_sum(ss) * (1.0f / 1024.0f) + REPS);
#pragma unroll
        for (int j = 0; j < 4; ++j) { v[j] = v[j] * rstd * A[j] + Sh[j];
            if (GATES) *(unsigned*)((unsigned char*)outp + (size_t)row * 1024 + 4 * lane + 256 * j) = pk4_fp8(v[j][0], v[j][1], v[j][2], v[j][3]);
            else { u32x2 o; o.x = pk2(v[j][0], v[j][1]); o.y = pk2(v[j][2], v[j][3]); *(u32x2*)(outp + (size_t)row * 1024 + 4 * lane + 256 * j) = o;
                   *(unsigned*)(a.ws + WS_H2F + (size_t)row * 1024 + 4 * lane + 256 * j) = pk4_fp8(v[j][0], v[j][1], v[j][2], v[j][3]); } }
        if (GATES) {
            float gd[8];
#pragma unroll
            for (int g = 0; g < 8; ++g) { float d = 0.f;
#pragma unroll
                for (int j = 0; j < 4; ++j) { const f32x4 w = *(const LAS f32x4*)(wg + g * 1024 + 4 * lane + 256 * j); const f32x4 p = v[j] * w; d += (p[0] + p[1]) + (p[2] + p[3]); }
                gd[g] = wave_sum(d); __builtin_amdgcn_sched_barrier(0); }
            if (lane < 8) { float val = 0.f;
#pragma unroll
                for (int g = 0; g < 8; ++g) val = (lane == g) ? gd[g] : val;
                const int hh = lane & 3, s = row & 4095;
                if (lane < 4) ((float*)(a.ws + WS_LOGI))[(size_t)(b * 4 + hh) * SEQ + s] = val + ((const float*)a.in[7])[hh];
                else ((float*)(a.ws + WS_LOGF))[(size_t)(b * 4 + hh) * SEQ + s] = logsigf(val + ((const float*)a.in[8])[hh]); }
        }
    }
}

__global__ void __launch_bounds__(NWAVES * 64, 2) fwd_kernel(Args args) {
    extern __shared__ __attribute__((aligned(16))) unsigned char lds_raw[];
    LAS unsigned char* lds = (LAS unsigned char*)lds_raw;
    volatile LAS unsigned* MISC = (volatile LAS unsigned*)(lds + MISC_OFF);
    const int tid = threadIdx.x, lane = tid & 63, wave = __builtin_amdgcn_readfirstlane(tid >> 6), G = gridDim.x;
    unsigned char* ws = args.ws;
    unsigned* ctl = (unsigned*)(ws + WS_CTL);
    for (int u = tid; u < (LDS_BYTES - RING_BYTES) / 4; u += NWAVES * 64) ((LAS unsigned*)(lds + RING_BYTES))[u] = 0u;
    __syncthreads();
    XcdBarrier bar = xcd_barrier_post(ctl + CW_BAR, MISC + 8);
    const int lo = args.ph_lo, hi = args.ph_hi;
#ifdef ONLY_PHASE
#define IN(k) ((k) == ONLY_PHASE && lo <= (k) && (k) < hi)
#else
#define IN(k) (lo <= (k) && (k) < hi)
#endif
#ifdef STAMP_SEL
#define STAMP(k) do { if (blockIdx.x == 0 && tid == 0) { const unsigned long long t_ = __builtin_amdgcn_s_memrealtime(); MISC[32 + 2 * (k)] = (unsigned)t_; MISC[33 + 2 * (k)] = (unsigned)(t_ >> 32); } } while (0)
#else
#define STAMP(k) do {} while (0)
#endif
#define SEAM(k) do { if (IN(k) && IN((k) + 1)) xcd_barrier(bar); STAMP((k) + 1); } while (0)
    float* mod = (float*)(ws + WS_MOD);
    bf16_t* R1 = (bf16_t*)(ws + WS_R1);
    STAMP(0);
    if (IN(0)) { p0_prologue(args, lds, tid, lane, wave); SEAM(0); }
    if (IN(1)) { p_modnorm<true>((const float*)args.in[0], (const float*)args.in[5], mod + 1024, mod, R1, args, lds, tid, lane, wave); SEAM(1); }
    if (IN(2)) {
        pg8::Gemm g{R1, (const bf16_t*)(ws + WS_WIN), 1024, 0, 0};     pg8::StaticOrder S; S.init(MTOK, NIN, G, (int)blockIdx.x);
        EpiInProj E{(bf16_t*)(ws + WS_QM), (bf16_t*)(ws + WS_KM), (bf16_t*)(ws + WS_VM), (bf16_t*)(ws + WS_OG), (bf16_t*)(ws + WS_QD), (bf16_t*)(ws + WS_KD), (bf16_t*)(ws + WS_VD),
                    (bf16_t*)(ws + WS_GM), (bf16_t*)(ws + WS_GD), (const float*)(ws + WS_CS), (const float*)args.in[12], (const float*)args.in[13]};
        pg8::gemm_phase<EpiInProj, pg8::StaticOrder, true, false, true>(lds, g, S, E);
        SEAM(2);
    }
    if (IN(3)) {
        if (tid == 0) { const float *q1 = (const float*)args.in[14], *k1 = (const float*)args.in[15], *q2 = (const float*)args.in[16], *k2 = (const float*)args.in[17]; float s1 = 0.f, s2 = 0.f;
            for (int i = 0; i < 64; ++i) { s1 += q1[i] * k1[i]; s2 += q2[i] * k2[i]; }
            MISC[2] = __float_as_uint(__expf(s1) - __expf(s2) + 0.2f); }
        __syncthreads();
        const float lam = __uint_as_float(MISC[2]);
        ml::Ptrs MP{(const bf16_t*)(ws + WS_QM), (const bf16_t*)(ws + WS_KM), (const bf16_t*)(ws + WS_VM), (const bf16_t*)(ws + WS_OG), (const float*)(ws + WS_LOGI), (const float*)(ws + WS_LOGF),
                    (const float*)args.in[9], (const float*)args.in[10], (const float*)args.in[11], R1, args.out, (float*)(ws + WS_NT), (float*)(ws + WS_SC), (float*)(ws + WS_MIN)};
        ml::passA(MP, (LAS char*)lds, (int)blockIdx.x, G);
        xcd_barrier(bar); STAMP(12);
        ml::passB(MP, (LAS char*)lds, tid);
        xcd_barrier(bar); STAMP(14);
#ifdef STAMP_SEL
        if (blockIdx.x == 32 && tid == 0) { const unsigned long long t_ = __builtin_amdgcn_s_memrealtime(); ctl[CW_ERR + 58] = (unsigned)t_; ctl[CW_ERR + 59] = (unsigned)(t_ >> 32); }
#endif
        {
            const int x = blockIdx.x & 7, j = (int)blockIdx.x >> 3;
#pragma unroll 1
            for (int u = 0; u < 4; ++u) { const int bh = 4 * x + u, qb = (u & 1) ? j : 31 - j;
                att::unit(bh >> 2, bh & 3, qb, (const bf16_t*)(ws + WS_QD), (const bf16_t*)(ws + WS_KD), (const bf16_t*)(ws + WS_VD), R1, lam, (const float*)args.in[18], (LAS char*)lds); }
        }
#ifdef STAMP_SEL
        if (blockIdx.x == 32 && tid == 0) { const unsigned long long t_ = __builtin_amdgcn_s_memrealtime(); ctl[CW_ERR + 62] = (unsigned)t_; ctl[CW_ERR + 63] = (unsigned)(t_ >> 32); }
#endif
        ml::load_taps(MP, (LAS float*)(lds + ml::OF), tid);
        __syncthreads();
        ml::passC(MP, (LAS char*)lds, (int)blockIdx.x, G);
#ifdef ATT_PROBE
        if (blockIdx.x == 32 && tid == 0) { ctl[CW_ERR + 60] = MISC[4]; ctl[CW_ERR + 61] = MISC[5]; }
#endif
        SEAM(3);
    }
    if (IN(4)) {
        pg8::Gemm g{R1, (const bf16_t*)(ws + WS_WBR), 1024, 0, 0}; pg8::StaticOrder S; S.init(MTOK, 1024, G, (int)blockIdx.x);
        EpiBranch E{(const bf16_t*)(ws + WS_GM), (const bf16_t*)(ws + WS_GD), (bf16_t*)(ws + WS_MG)};
        pg8::gemm_phase<EpiBranch, pg8::StaticOrder, true, false>(lds, g, S, E);
        SEAM(4);
    }
    if (IN(5)) {
        pg8::Gemm g{(const bf16_t*)(ws + WS_MG), (const bf16_t*)(ws + WS_WOUT), 1024, 0, 0}; pg8::StaticOrder S; S.init(MTOK, 1024, G, (int)blockIdx.x);
        EpiOut E{mod, (bf16_t*)(ws + WS_T)};
        pg8::gemm_phase<EpiOut, pg8::StaticOrder, true, false>(lds, g, S, E);
        SEAM(5);
    }
    if (IN(6)) { p_modnorm<false>((const float*)args.in[0], (const float*)args.in[22], mod + 4096, mod + 3072, R1, args, lds, tid, lane, wave); SEAM(6); }
    if (IN(7)) {
        pg8::Gemm g{R1, (const bf16_t*)(ws + WS_WR), 1024, 0, 0}; pg8::StaticOrder S; S.init(MTOK, 256, G, (int)blockIdx.x);
        EpiRouter E{(const float*)args.in[24], (const float*)args.in[26], ctl + CW_CNT, (int*)(ws + WS_TOK), (float*)(ws + WS_WT), (float*)(ws + WS_ROUTE)};
        if (blockIdx.x < 128) { pg8::gemm_phase<EpiRouter, pg8::StaticOrder, true, false>(lds, g, S, E); STAMP(16); }
        else p_convert_experts(args, lds, threadIdx.x & 63, wave, ((int)blockIdx.x - 128) * NWAVES + wave, 128 * NWAVES);
#ifdef STAMP_SEL
        if (blockIdx.x == 128 && tid == 0) { const unsigned long long t_ = __builtin_amdgcn_s_memrealtime(); ctl[CW_ERR + 56] = (unsigned)t_; ctl[CW_ERR + 57] = (unsigned)(t_ >> 32); }
#endif
        SEAM(7);
    }
    if (IN(8) || IN(9) || IN(10)) {
        LAS int* pref = (LAS int*)(lds + PREF_OFF);
        if (tid == 0) { int acc = 0; for (int l = 0; l < 64; ++l) { pref[l] = acc; acc += (int)((__hip_atomic_load(ctl + CW_CNT + 64 * l, RLX_AGENT) + 255u) >> 8); } pref[64] = acc; }
        __syncthreads();
        if (tid < 64) { LAS unsigned char* t2l = (LAS unsigned char*)(pref + 72); for (int g = pref[tid]; g < pref[tid + 1]; ++g) t2l[g] = (unsigned char)tid; }
        if (tid == 64) { LAS unsigned short* xt = (LAS unsigned short*)(pref + 160); int n = 0;
            for (int l = (int)blockIdx.x & 7; l < 64; l += 8) for (int g = pref[l]; g < pref[l + 1]; ++g) xt[n++] = (unsigned short)g;
            pref[65] = n; }
        __syncthreads();
    }
    if (IN(8)) {
        const LAS int* pref = (const LAS int*)(lds + PREF_OFF);
        pg8::Gemm g{(const bf16_t*)(ws + WS_H2F), (const bf16_t*)(ws + WS_WGU), 1024, (size_t)512 * 1024, 0};
        GroupedOrder S{pref, pref[65], 2, (int)blockIdx.x >> 3, (const int*)(ws + WS_TOK), ctl + CW_CNT};
        EpiGateUp E{(bf16_t*)(ws + WS_ACT)};
        pg8::gemm_phase<EpiGateUp, GroupedOrder, true, true, true>(lds, g, S, E);
        SEAM(8);
    }
    if (IN(9)) {
        const LAS int* pref = (const LAS int*)(lds + PREF_OFF);
        pg8::Gemm g{(const bf16_t*)(ws + WS_ACT), (const bf16_t*)(ws + WS_WD), 256, (size_t)1024 * 256, 0};
        GroupedOrder S{pref, pref[65], 4, (int)blockIdx.x >> 3, (const int*)(ws + WS_TOK), ctl + CW_CNT};
        EpiDownY E{(unsigned char*)(ws + WS_Y)};
        pg8::gemm_phase<EpiDownY, GroupedOrder, true, false>(lds, g, S, E);
        SEAM(9);
    }
    if (IN(10)) {
        const LAS int* pref = (const LAS int*)(lds + PREF_OFF);
        const unsigned char* Y = (const unsigned char*)(ws + WS_Y); const u32x4* route = (const u32x4*)(ws + WS_ROUTE);
        int lane_c = threadIdx.x & 63; asm volatile("" : "+v"(lane_c));
        const int gw = blockIdx.x * NWAVES + wave, row0 = gw * 16, b = row0 >> 12;
        f32x4 g2[4];
#pragma unroll
        for (int j = 0; j < 4; ++j) g2[j] = *(const f32x4*)(mod + b * 6144 + 5120 + 4 * lane_c + 256 * j);
        const u32x4 rtl = route[row0 + (lane_c & 15)];
#pragma unroll 2
        for (int r = 0; r < 16; ++r) {
            const int row = row0 + r; u32x4 rt;
            rt.x = (unsigned)__builtin_amdgcn_readlane((int)rtl.x, r); rt.y = (unsigned)__builtin_amdgcn_readlane((int)rtl.y, r); rt.z = (unsigned)__builtin_amdgcn_readlane((int)rtl.z, r); rt.w = (unsigned)__builtin_amdgcn_readlane((int)rtl.w, r);
            const size_t s1 = (size_t)(256 * pref[rt.x >> 15] + (int)(rt.x & 32767u)), s2 = (size_t)(256 * pref[rt.y >> 15] + (int)(rt.y & 32767u));
            const float w1 = __uint_as_float(rt.z), w2 = __uint_as_float(rt.w);
            float* op = args.out + (size_t)row * 1024 + 4 * lane_c; const bf16_t* xp = (const bf16_t*)(ws + WS_X1B) + (size_t)row * 1024 + 4 * lane_c;
#pragma unroll
            for (int j = 0; j < 4; ++j) { f32x4 xv; { const u32x2 t2 = *(const u32x2*)(xp + 256 * j); xv[0] = bflo(t2.x); xv[1] = bfhi(t2.x); xv[2] = bflo(t2.y); xv[3] = bfhi(t2.y); }
                const unsigned ya = *(const unsigned*)(Y + s1 * 1024 + 4 * lane_c + 256 * j), yb = *(const unsigned*)(Y + s2 * 1024 + 4 * lane_c + 256 * j);
                const f32x2 a01 = __builtin_amdgcn_cvt_pk_f32_fp8(ya, false), a23 = __builtin_amdgcn_cvt_pk_f32_fp8(ya, true), b01 = __builtin_amdgcn_cvt_pk_f32_fp8(yb, false), b23 = __builtin_amdgcn_cvt_pk_f32_fp8(yb, true);
                f32x4 y; y[0] = w1 * a01[0] + w2 * b01[0]; y[1] = w1 * a01[1] + w2 * b01[1]; y[2] = w1 * a23[0] + w2 * b23[0]; y[3] = w1 * a23[1] + w2 * b23[1];
                *(f32x4*)(op + 256 * j) = xv + g2[j] * y; }
        }
    }
#ifdef STAMP_SEL
    xcd_barrier(bar); STAMP(11);
    if (blockIdx.x == 0 && tid == 0) { MISC[32 + 2 * 13] = __hip_atomic_load(ctl + CW_ERR + 62, RLX_AGENT); MISC[33 + 2 * 13] = __hip_atomic_load(ctl + CW_ERR + 63, RLX_AGENT); }
    if (blockIdx.x == 0 && tid == 0) { MISC[32 + 2 * 17] = __hip_atomic_load(ctl + CW_ERR + 56, RLX_AGENT); MISC[33 + 2 * 17] = __hip_atomic_load(ctl + CW_ERR + 57, RLX_AGENT); }
    if (blockIdx.x == 0 && tid == 0) { MISC[32 + 2 * 15] = __hip_atomic_load(ctl + CW_ERR + 58, RLX_AGENT); MISC[33 + 2 * 15] = __hip_atomic_load(ctl + CW_ERR + 59, RLX_AGENT); }
    if (blockIdx.x == 0 && tid == 0) {
        const unsigned long long t0 = ((unsigned long long)MISC[33 + 2 * (STAMP_SEL)] << 32) | MISC[32 + 2 * (STAMP_SEL)], t1 = ((unsigned long long)MISC[33 + 2 * (STAMP_HI)] << 32) | MISC[32 + 2 * (STAMP_HI)];
#ifdef ATT_PROBE
        { const float cyc = (float)__hip_atomic_load(ctl + CW_ERR + 60, RLX_AGENT), nt = (float)__hip_atomic_load(ctl + CW_ERR + 61, RLX_AGENT);
#ifdef ATT_PROBE_TOTAL

#ifdef ATT_PROBE_NT
          args.out[5] += 2.0f * floorf(nt * 0.5f + 0.5f); (void)cyc; (void)t0; (void)t1; }
#else
          args.out[5] += 2.0f * floorf(cyc * (1.0f / 20000.0f) + 0.5f); (void)nt; (void)t0; (void)t1; }
#endif
#else
          args.out[5] += 2.0f * floorf(cyc / nt * (1.0f / 100.0f) + 0.5f); (void)t0; (void)t1; }
#endif
#else
        args.out[5] += (float)(t1 - t0) * (0.01f / 4.0f);
#endif
    }
#endif
#undef IN
#undef SEAM
}
#ifdef DBG_ORACLE
constexpr int DBG_B = 1, DBG_T = 1024, NSTAGE = 19;
__device__ __forceinline__ void err_acc(float d2, float r2, float* err) {
    __shared__ float sh[2][256];
    const int tid = threadIdx.x; sh[0][tid] = d2; sh[1][tid] = r2; __syncthreads();
    for (int o = 128; o > 0; o >>= 1) { if (tid < o) { sh[0][tid] += sh[0][tid + o]; sh[1][tid] += sh[1][tid + o]; } __syncthreads(); }
    if (tid == 0) { atomicAdd(err, sh[0][0]); atomicAdd(err + 1, sh[1][0]); }
}
__global__ void k_cmp(const void* fast, int fb16, int ldf, const float* ref, int ldr, int cols, int tf, float* err) {
    const int r = blockIdx.x; float d2 = 0.f, r2 = 0.f;
    for (int c = threadIdx.x; c < cols; c += 256) {
        float f = fb16 ? bf2f(((const bf16_t*)fast)[(size_t)r * ldf + c]) : ((const float*)fast)[(size_t)r * ldf + c];
        float v = ref[(size_t)r * ldr + c]; if (tf == 1) v = 1.f / (1.f + expf(-v));
        d2 += (f - v) * (f - v); r2 += v * v; }
    err_acc(d2, r2, err);
}
__global__ void k_cmp_qk(const bf16_t* fast, const float* ref, float sc, float* err) {
    const int r = blockIdx.x; float d2 = 0.f, r2 = 0.f;
    for (int c = threadIdx.x; c < 512; c += 256) { const float f = bf2f(fast[(size_t)r * 512 + c]); const float v = ref[(size_t)r * 512 + (c & ~63) + dperm(c & 63)] * sc; d2 += (f - v) * (f - v); r2 += v * v; }
    err_acc(d2, r2, err);
}
__global__ void k_cmp_gates(const float* logi, const float* logf, const float* proj, const float* b_i, const float* b_f, float* err) {
    const int t = blockIdx.x * 256 + threadIdx.x; float d2 = 0.f, r2 = 0.f;
    for (int h = 0; h < 4; ++h) { const float vi = proj[(size_t)t * 5640 + 2048 + h] + b_i[h]; const float x = proj[(size_t)t * 5640 + 2052 + h] + b_f[h]; const float vf = fminf(x, 0.f) - log1pf(expf(-fabsf(x)));
        const float fi = logi[(size_t)(DBG_B * 4 + h) * 4096 + t], ff = logf[(size_t)(DBG_B * 4 + h) * 4096 + t];
        d2 += (fi - vi) * (fi - vi) + (ff - vf) * (ff - vf) * 100.f; r2 += vi * vi + vf * vf * 100.f; }
    err_acc(d2, r2, err);
}
__global__ void k_cmp_route(const float* fast, const float* ref, float* err) {
    const int t = blockIdx.x * 256 + threadIdx.x; const float* f = fast + (size_t)(DBG_B * 4096 + t) * 4; const float* r = ref + (size_t)t * 4;
    const unsigned a0 = __float_as_uint(f[0]) >> 15, a1 = (__float_as_uint(f[1]) >> 15) - 32u;
    const float mis = ((float)a0 != r[0] || (float)a1 != r[1]) ? 1.f : 0.f;
    err_acc(mis * 0.03f, 1.0f, err);
}
__global__ void k_poison(float* out, size_t n, const float* err) {
    int bad = -1; float ratio = 0.f;
    for (int s = 0; s < NSTAGE; ++s) { const float d = err[2 * s], r = err[2 * s + 1]; if (!(d <= 9e-4f * r) || !(r > 0.f)) { bad = s; ratio = (r > 0.f) ? sqrtf(d / r) : 2.f; break; } }
    if (bad < 0) return;
    if (!(ratio < 2.f)) ratio = 2.f;
    const float Kf = powf(10.f, (float)(bad + 1)) * (1.f + ratio);
    for (size_t i = (size_t)blockIdx.x * 256 + threadIdx.x; i < n; i += (size_t)gridDim.x * 256) out[i] = out[i] * Kf;
}
#endif

static void launch_phases(Args a, int lo, int hi, hipStream_t stream) {
    a.ph_lo = lo; a.ph_hi = hi; void* kargs[] = {&a};
#if defined(DBG_ORACLE) || defined(N_LAUNCH_PER_PHASE)
    (void)hipMemsetAsync((char*)a.ws + WS_CTL + (size_t)CW_BAR * 4, 0, XCD_BAR_WORDS * 4, stream);
#endif
    hipError_t e = hipLaunchCooperativeKernel((const void*)fwd_kernel, dim3(256), dim3(NWAVES * 64), kargs, LDS_BYTES, stream);
    if (e != hipSuccess) fprintf(stderr, "kernel_launch: cooperative launch of phases [%d,%d) failed: %s\n", lo, hi, hipGetErrorString(e));
}
extern "C" void kernel_launch(void* const* d_in, const int* in_sizes, int n_in, void* d_out, int out_size, void* d_ws, size_t ws_size, hipStream_t stream) {
    static int state = 0;
    if (state == 0) {
        state = 1;
        if (n_in != 30 || out_size != MTOK * DMODEL || ws_size < WS_END + 4 * MiB) { fprintf(stderr, "kernel_launch: unexpected shapes (n_in %d out %d ws %zu)\n", n_in, out_size, ws_size); state = -1; }
        if (state > 0 && hipFuncSetAttribute((const void*)fwd_kernel, hipFuncAttributeMaxDynamicSharedMemorySize, LDS_BYTES) != hipSuccess) { fprintf(stderr, "kernel_launch: hipFuncSetAttribute failed\n"); state = -1; }
        int dev = 0, cus = 0, per_cu = 0; (void)hipGetDevice(&dev); (void)hipDeviceGetAttribute(&cus, hipDeviceAttributeMultiprocessorCount, dev);
        (void)hipOccupancyMaxActiveBlocksPerMultiprocessor(&per_cu, (const void*)fwd_kernel, NWAVES * 64, LDS_BYTES);
        if (state > 0 && (cus * per_cu < 256)) { fprintf(stderr, "kernel_launch: %d CUs x %d blocks cannot hold the 256-workgroup grid\n", cus, per_cu); state = -1; }
        (void)hipGetLastError();
    }
    if (state < 0) return;
    (void)hipMemsetAsync((char*)d_ws + WS_CTL, 0, CTL_ZERO_BYTES, stream);
    Args a{};
    for (int i = 0; i < 30; ++i) a.in[i] = d_in[i];
    a.out = (float*)d_out; a.ws = (unsigned char*)d_ws;
    for (int i = 0; i < 8; ++i) a.freq[i] = (float)std::pow(500000.0, -(double)(2 * i) / 16.0);
#ifndef DBG_ORACLE
#ifdef N_LAUNCH_PER_PHASE
    for (int p = 0; p < 11; ++p) launch_phases(a, p, p + 1, stream);
#else
    launch_phases(a, 0, 11, stream);
#endif
#else
    using namespace nv;
    char* ws = (char*)d_ws; float* err = (float*)(ws + WS_CTL) + CW_ERR;
    NaiveBuf B; const size_t lateb = naive_carve((char*)d_out, ws + WS_END + 3 * MiB, B, DBG_T);
    float* outn = (float*)(ws + WS_END + 3 * MiB + lateb); float* lamp = outn + (size_t)DBG_T * 1024;
    k_mod<<<dim3(24, 8), 256, 0, stream>>>((const float*)d_in[1], (const float*)d_in[3], (const float*)d_in[4], B.mod);
    k_lam<<<1, 64, 0, stream>>>((const float*)d_in[14], (const float*)d_in[15], (const float*)d_in[16], (const float*)d_in[17], lamp);
    naive_batch(d_in, DBG_B, B, lamp, outn, DBG_T, stream);
    const size_t rb = (size_t)DBG_B * 4096;
    auto CMP = [&](int s, const void* fast, int fb16, int ldf, const float* ref, int ldr, int cols, int tf) { k_cmp<<<DBG_T, 256, 0, stream>>>(fast, fb16, ldf, ref, ldr, cols, tf, err + 2 * s); };
    launch_phases(a, 0, 1, stream);
    k_cmp<<<8, 256, 0, stream>>>(ws + WS_MOD, 0, 6144, B.mod, 6144, 6144, 0, err + 0);
    launch_phases(a, 1, 2, stream);
    CMP(1, (bf16_t*)(ws + WS_R1) + rb * 1024, 1, 1024, B.h, 1024, 1024, 0);
    k_cmp_gates<<<DBG_T / 256, 256, 0, stream>>>((const float*)(ws + WS_LOGI), (const float*)(ws + WS_LOGF), B.proj, (const float*)d_in[7], (const float*)d_in[8], err + 2 * 2);
    launch_phases(a, 2, 3, stream);
    CMP(3, (bf16_t*)(ws + WS_QM) + rb * 512, 1, 512, B.proj + 0, 5640, 512, 0);
    CMP(4, (bf16_t*)(ws + WS_KM) + rb * 512, 1, 512, B.proj + 512, 5640, 512, 0);
    CMP(5, (bf16_t*)(ws + WS_VM) + rb * 512, 1, 512, B.proj + 1024, 5640, 512, 0);
    CMP(6, (bf16_t*)(ws + WS_OG) + rb * 512, 1, 512, B.proj + 1536, 5640, 512, 1);
    k_cmp_qk<<<DBG_T, 256, 0, stream>>>((bf16_t*)(ws + WS_QD) + rb * 512, B.qd, QSCALE, err + 2 * 7);
    k_cmp_qk<<<DBG_T, 256, 0, stream>>>((bf16_t*)(ws + WS_KD) + rb * 512, B.kd, 1.0f, err + 2 * 8);
    CMP(9, (bf16_t*)(ws + WS_VD) + rb * 512, 1, 512, B.proj + 3080, 5640, 512, 0);
    CMP(10, (bf16_t*)(ws + WS_GM) + rb * 1024, 1, 1024, B.proj + 3592, 5640, 1024, 1);
    CMP(11, (bf16_t*)(ws + WS_GD) + rb * 1024, 1, 1024, B.proj + 4616, 5640, 1024, 1);
    launch_phases(a, 3, 4, stream);
    CMP(12, (bf16_t*)(ws + WS_R1) + rb * 1024, 1, 1024, B.hm, 512, 512, 0);
    CMP(13, (bf16_t*)(ws + WS_R1) + rb * 1024 + 512, 1, 1024, B.hd, 512, 512, 0);
    launch_phases(a, 4, 5, stream);
    CMP(14, (bf16_t*)(ws + WS_MG) + rb * 1024, 1, 1024, B.merged, 1024, 1024, 0);
    launch_phases(a, 5, 6, stream);
    CMP(15, (float*)d_out + rb * 1024, 0, 1024, B.x1, 1024, 1024, 0);
    launch_phases(a, 6, 7, stream);
    CMP(16, (bf16_t*)(ws + WS_R1) + rb * 1024, 1, 1024, B.h2, 1024, 1024, 0);
    launch_phases(a, 7, 8, stream);
    k_cmp_route<<<DBG_T / 256, 256, 0, stream>>>((const float*)(ws + WS_ROUTE), B.route, err + 2 * 17);
    launch_phases(a, 8, 9, stream); launch_phases(a, 9, 10, stream); launch_phases(a, 10, 11, stream);
    CMP(18, (float*)d_out + rb * 1024, 0, 1024, outn, 1024, 1024, 0);
    k_poison<<<1024, 256, 0, stream>>>((float*)d_out, (size_t)MTOK * DMODEL, err);
#endif
}
```

```cpp
#include <hip/hip_runtime.h>
#include <hip/hip_bf16.h>
#include <cstdio>
#include <cstdint>
#include <cmath>
#define LAS __attribute__((address_space(3)))
#define DI __device__ __forceinline__
typedef unsigned short bf16_t;
typedef short bf16x8 __attribute__((ext_vector_type(8)));
typedef short s16x4 __attribute__((ext_vector_type(4)));
typedef float f32x4 __attribute__((ext_vector_type(4)));
typedef float f32x16 __attribute__((ext_vector_type(16)));
typedef float f32x2 __attribute__((ext_vector_type(2)));
typedef unsigned u32x4 __attribute__((ext_vector_type(4)));
typedef unsigned u32x2 __attribute__((ext_vector_type(2)));
typedef __bf16 bf16x2_t __attribute__((ext_vector_type(2)));
DI unsigned pk2(float lo, float hi) { f32x2 v = {lo, hi}; bf16x2_t b = __builtin_convertvector(v, bf16x2_t); return __builtin_bit_cast(unsigned, b); }
DI float bflo(unsigned w) { return __uint_as_float(w << 16); }
DI float bfhi(unsigned w) { return __uint_as_float(w & 0xffff0000u); }
DI float bf2f(bf16_t u) { return __uint_as_float((unsigned)u << 16); }
DI float fexp(float x) { return __builtin_amdgcn_exp2f(x * 1.4426950408889634f); }
DI float fsigm(float x) { return __builtin_amdgcn_rcpf(1.f + fexp(-x)); }

namespace pg8 {
constexpr int BM = 256, BK = 64, HALF = 128, HTB = HALF * BK * 2, STAGE_BYTES = 8 * HTB, NXCD = 8, WGM = 8;
__host__ __device__ __forceinline__ int lds_byte(int r, int c) { const int st = (r >> 4) * 2 + (c >> 5), rr = r & 15, cc = c & 31, ob = rr * 64 + cc * 2; return st * 1024 + (ob ^ (((ob >> 9) & 1) << 5)); }
__host__ __device__ __forceinline__ void stage_rc(int b, int& R, int& C) { const int st = b / 1024, sb = b % 1024, swz = sb ^ (((sb >> 9) & 1) << 5); R = (st >> 1) * 16 + swz / 64; C = (st & 1) * 32 + (swz % 64) / 2; }
__host__ __device__ __forceinline__ int perm32(int rho) { const int n = rho >> 4, i = rho & 15; return 8 * (i >> 2) + 4 * n + (i & 3); }

struct Unit { int pm, pn, e, l, mt; };
typedef int v8i_t __attribute__((ext_vector_type(8)));
struct Gemm { const bf16_t* A; const bf16_t* Bt; int K; size_t bstride; int scale_b; };

struct StaticOrder {
    int nM, nN, nwg, G, c;
    __host__ __device__ void init(int M, int N, int G_, int c_) { nM = M / BM; nN = N / BM; nwg = nM * nN; G = G_; c = c_; }
    __host__ __device__ bool next(int i, Unit& u) const {
        const long L = (long)i * G + c; if (L >= nwg) return false;
        int wgid = (int)L; { const int q = nwg / NXCD, r = nwg % NXCD, xcd = wgid % NXCD, off = wgid / NXCD; wgid = (xcd < r ? xcd * (q + 1) : r * (q + 1) + (xcd - r) * q) + off; }
        const int nig = WGM * nN, gid = wgid / nig, fm = gid * WGM, gsz = (nM - fm) < WGM ? (nM - fm) : WGM;
        u.pm = fm + ((wgid % nig) % gsz); u.pn = (wgid % nig) / gsz; u.e = 0; u.l = 0; u.mt = 0; return true;
    }
    DI unsigned gather(const Unit&, int, int, int) const { return 0u; }
};

template <class Epi, class Sched, bool ALIGN_EPI, bool GATHER, bool FP8 = false>
DI void gemm_phase(LAS unsigned char* lds, const Gemm g, const Sched& S, const Epi& E) {
    const int tid = threadIdx.x, wid = __builtin_amdgcn_readfirstlane(tid >> 6), lane = tid & 63, wr = wid >> 2, wc = wid & 3, fr = lane & 15, fq = lane >> 4;
    const int RB = g.K * (FP8 ? 1 : 2), K = RB / 2, nt = RB / 128;
    unsigned voffA[2], voffB[2]; int gR[2], gC2[2];
#pragma unroll
    for (int i = 0; i < 2; ++i) { int R, C; stage_rc(tid * 16 + i * 8192, R, C); const int Rb = Epi::PERM ? ((R & ~31) + perm32(R & 31)) : R;
        voffA[i] = (unsigned)(R * K + C) * 2u; voffB[i] = (unsigned)(Rb * K + C) * 2u; gR[i] = R; gC2[i] = C * 2; }
    const size_t kstep = (size_t)(BK * 2);
    const size_t hstep = (size_t)HALF * K * 2;
    const size_t tstep = 2 * hstep;
    const unsigned ldsw = (unsigned)wid * 1024u;
    const int aoff = lds_byte(wr * 64 + fr, fq * 8), boff = lds_byte(wc * 32 + fr, fq * 8);
#define PG8_SA(b, h) (((b) * 2 + (h)) * HTB)
#define PG8_SB(b, h) ((4 + (b) * 2 + (h)) * HTB)
#define PG8_STAGE(bufoff, gbase, voff) do { _Pragma("unroll") for (int _i = 0; _i < 2; ++_i) \
        __builtin_amdgcn_global_load_lds((const unsigned*)((const char*)(gbase) + (voff)[_i]), (LAS unsigned*)(lds + (bufoff) + ldsw + _i * 8192), 16, 0, 0); } while (0)
#define PG8_STAGE_A(bufoff, dptr, h, kb, nx) do { if constexpr (GATHER) { unsigned _vo[2]; _vo[0] = (nx) ? gN[h][0] : gO[h][0]; _vo[1] = (nx) ? gN[h][1] : gO[h][1]; PG8_STAGE(bufoff, (const char*)g.A + (kb), _vo); } \
        else { PG8_STAGE(bufoff, dptr, voffA); } } while (0)
#define PG8_LDF(dst, off_) do { const u32x4 lo_ = *(const LAS u32x4*)(lds + (off_)), hi_ = *(const LAS u32x4*)(lds + (off_) + 1024); \
        dst = (v8i_t){(int)lo_.x, (int)lo_.y, (int)lo_.z, (int)lo_.w, (int)hi_.x, (int)hi_.y, (int)hi_.z, (int)hi_.w}; } while (0)
#define PG8_LDA(dst, b, h) do { _Pragma("unroll") for (int m = 0; m < 4; ++m) PG8_LDF(dst[m], PG8_SA(b, h) + aoff + m * 2048); } while (0)
#define PG8_LDB(dst, b, h) do { _Pragma("unroll") for (int n = 0; n < 2; ++n) PG8_LDF(dst[n], PG8_SB(b, h) + boff + n * 2048); } while (0)
#define PG8_LO(f) __builtin_bit_cast(bf16x8, (u32x4){(unsigned)f[0], (unsigned)f[1], (unsigned)f[2], (unsigned)f[3]})
#define PG8_HI(f) __builtin_bit_cast(bf16x8, (u32x4){(unsigned)f[4], (unsigned)f[5], (unsigned)f[6], (unsigned)f[7]})
#define PG8_MMA(ai, bj, At, Bt) do { __builtin_amdgcn_s_setprio(1); _Pragma("unroll") for (int m = 0; m < 4; ++m) _Pragma("unroll") for (int n = 0; n < 2; ++n) { \
        if constexpr (FP8) asm volatile("v_mfma_f32_16x16x128_f8f6f4 %0, %1, %2, %0" : "+v"(acc[ai][bj][m][n]) : "v"(Bt[n]), "v"(At[m]));   \
        else { acc[ai][bj][m][n] = __builtin_amdgcn_mfma_f32_16x16x32_bf16(PG8_LO(Bt[n]), PG8_LO(At[m]), acc[ai][bj][m][n], 0, 0, 0); \
               acc[ai][bj][m][n] = __builtin_amdgcn_mfma_f32_16x16x32_bf16(PG8_HI(Bt[n]), PG8_HI(At[m]), acc[ai][bj][m][n], 0, 0, 0); } } \
        __builtin_amdgcn_s_setprio(0); } while (0)
#define PG8_WAIT_V(n) asm volatile("s_waitcnt vmcnt(" #n ")" ::: "memory")
#define PG8_WAIT_L(n) asm volatile("s_waitcnt lgkmcnt(" #n ")" ::: "memory")
#define PG8_BAR __builtin_amdgcn_s_barrier()
#define PG8_SCHED __builtin_amdgcn_sched_barrier(0)
    Unit cur, nxt; int ui = 0;
    if (!S.next(0, cur)) return;
    f32x4 acc[2][2][4][2];
#pragma unroll
    for (int a = 0; a < 2; ++a)
#pragma unroll
        for (int b = 0; b < 2; ++b)
#pragma unroll
            for (int m = 0; m < 4; ++m)
#pragma unroll
                for (int n = 0; n < 2; ++n) acc[a][b][m][n] = (f32x4){0.f, 0.f, 0.f, 0.f};
    v8i_t At[4], B0[2], B1[2];
    unsigned gO[2][2], gN[2][2];
    if constexpr (GATHER) {
#pragma unroll
        for (int h = 0; h < 2; ++h)
#pragma unroll
            for (int i = 0; i < 2; ++i) { gO[h][i] = S.gather(cur, h * HALF + gR[i], gC2[i], K); gN[h][i] = gO[h][i]; }
    } else { gO[0][0] = gO[0][1] = gO[1][0] = gO[1][1] = 0u; gN[0][0] = gN[0][1] = gN[1][0] = gN[1][1] = 0u; }
    const char* cA = (const char*)g.A + (GATHER ? (size_t)0 : (size_t)cur.pm * tstep);
    const char* cB = (const char*)g.Bt + ((size_t)cur.e * g.bstride) * (FP8 ? 1 : 2) + (size_t)cur.pn * tstep;
    PG8_STAGE(PG8_SB(0, 0), cB, voffB); PG8_STAGE(PG8_SB(0, 1), cB + hstep, voffB); PG8_STAGE_A(PG8_SA(0, 0), cA, 0, 0, false); PG8_STAGE_A(PG8_SA(0, 1), cA + hstep, 1, 0, false);
    if (wr == 1) PG8_BAR;
    PG8_WAIT_V(2); PG8_BAR;
    PG8_STAGE(PG8_SB(1, 0), cB + kstep, voffB); PG8_STAGE_A(PG8_SA(1, 0), cA + kstep, 0, kstep, false); PG8_STAGE(PG8_SB(1, 1), cB + hstep + kstep, voffB);
    PG8_WAIT_V(6); PG8_BAR;
    for (;;) {
        const bool has_next = S.next(ui + 1, nxt);
        if constexpr (GATHER) {
            if (has_next) {
#pragma unroll
                for (int h = 0; h < 2; ++h)
#pragma unroll
                    for (int i = 0; i < 2; ++i) gN[h][i] = S.gather(nxt, h * HALF + gR[i], gC2[i], K);
            } else {
#pragma unroll
                for (int h = 0; h < 2; ++h)
#pragma unroll
                    for (int i = 0; i < 2; ++i) gN[h][i] = gO[h][i];
            }
        }
        const char* nA = GATHER ? cA : (has_next ? (const char*)g.A + (size_t)nxt.pm * tstep : cA);
        const char* nB = has_next ? (const char*)g.Bt + ((size_t)nxt.e * g.bstride) * (FP8 ? 1 : 2) + (size_t)nxt.pn * tstep : cB;
#pragma unroll 1
        for (int t = 0; t < nt; t += 2) {
            if constexpr (Epi::HAS_MID) { if (t == Epi::MID_T) { E.mid(acc, cur, wr, wc, fr, fq); PG8_SCHED; } }
            const bool last = (t == nt - 2);
            const char* a1 = cA + (size_t)(t + 1) * kstep;
            const char* a2 = last ? nA : cA + (size_t)(t + 2) * kstep; const char* b2 = last ? nB : cB + (size_t)(t + 2) * kstep;
            const char* a3 = a2 + kstep; const char* b3 = b2 + kstep;
            const size_t k1 = (size_t)(t + 1) * kstep, k2 = last ? (size_t)0 : (size_t)(t + 2) * kstep, k3 = k2 + kstep;
            PG8_LDB(B0, 0, 0); PG8_LDB(B1, 0, 1); PG8_SCHED; PG8_LDA(At, 0, 0); PG8_STAGE_A(PG8_SA(1, 1), a1 + hstep, 1, k1, false);
            PG8_WAIT_V(8); PG8_WAIT_L(0); PG8_BAR; PG8_MMA(0, 0, At, B0); PG8_MMA(0, 1, At, B1); PG8_BAR; PG8_SCHED;
            PG8_LDA(At, 0, 1); PG8_STAGE(PG8_SB(0, 0), b2, voffB); PG8_STAGE(PG8_SB(0, 1), b2 + hstep, voffB); PG8_STAGE_A(PG8_SA(0, 0), a2, 0, k2, last);
            PG8_WAIT_V(8); PG8_WAIT_L(0); PG8_BAR; PG8_MMA(1, 0, At, B0); PG8_MMA(1, 1, At, B1); PG8_BAR; PG8_SCHED;
            PG8_LDB(B0, 1, 0); PG8_LDB(B1, 1, 1); PG8_SCHED; PG8_LDA(At, 1, 0); PG8_STAGE_A(PG8_SA(0, 1), a2 + hstep, 1, k2, last);
            PG8_WAIT_V(8); PG8_WAIT_L(0); PG8_BAR; PG8_MMA(0, 0, At, B0); PG8_MMA(0, 1, At, B1); PG8_BAR; PG8_SCHED;
            PG8_LDA(At, 1, 1); PG8_STAGE(PG8_SB(1, 0), b3, voffB); PG8_STAGE(PG8_SB(1, 1), b3 + hstep, voffB); PG8_STAGE_A(PG8_SA(1, 0), a3, 0, k3, last);
            PG8_WAIT_V(8); PG8_WAIT_L(0); PG8_BAR; PG8_MMA(1, 0, At, B0); PG8_MMA(1, 1, At, B1); PG8_BAR; PG8_SCHED;
        }
        if constexpr (ALIGN_EPI) { if (wr == 0) PG8_BAR; }
        if constexpr (FP8) asm volatile("s_nop 15\n\ts_nop 15" : "+v"(acc[1][1][0][0]), "+v"(acc[1][1][0][1]), "+v"(acc[1][1][1][0]), "+v"(acc[1][1][1][1]), "+v"(acc[1][1][2][0]), "+v"(acc[1][1][2][1]), "+v"(acc[1][1][3][0]), "+v"(acc[1][1][3][1]));
        E(acc, cur, wr, wc, fr, fq);
        if (!has_next) break;
#pragma unroll
        for (int a = 0; a < 2; ++a)
#pragma unroll
            for (int b = 0; b < 2; ++b)
#pragma unroll
                for (int m = 0; m < 4; ++m)
#pragma unroll
                    for (int n = 0; n < 2; ++n) acc[a][b][m][n] = (f32x4){0.f, 0.f, 0.f, 0.f};
        cur = nxt; cA = nA; cB = nB; ++ui;
        if constexpr (GATHER) {
#pragma unroll
            for (int h = 0; h < 2; ++h)
#pragma unroll
                for (int i = 0; i < 2; ++i) gO[h][i] = gN[h][i];
        }
        if constexpr (ALIGN_EPI) { if (wr == 1) PG8_BAR; }
    }
    PG8_WAIT_V(0);
    if constexpr (!ALIGN_EPI) { if (wr == 0) PG8_BAR; }
    PG8_BAR;
#undef PG8_SA
#undef PG8_SB
#undef PG8_STAGE
#undef PG8_STAGE_A
#undef PG8_LDA
#undef PG8_LDF
#undef PG8_LO
#undef PG8_HI
#undef PG8_LDB
#undef PG8_MMA
#undef PG8_WAIT_V
#undef PG8_WAIT_L
#undef PG8_BAR
#undef PG8_SCHED
}
}
constexpr int NBATCH = 8, SEQ = 4096, MTOK = 32768, DMODEL = 1024, NIN = 5632;
constexpr float QSCALE = 0.125f * 1.4426950408889634f;
constexpr float REPS = 1e-6f;
constexpr size_t MiB = 1u << 20;
#if defined(STAMP_SEL) || defined(ATT_PROBE) || defined(DBG_ORACLE)
constexpr size_t WS_CTL = 0, CTL_ZERO_BYTES = 128 * 1024;
#else
constexpr size_t WS_CTL = 0, CTL_ZERO_BYTES = 64 * 1024;
#endif
constexpr size_t WS_MOD = 1 * MiB, WS_WG8 = 1 * MiB + 256 * 1024, WS_ROUTE = 1 * MiB + 512 * 1024;
constexpr size_t WS_CS = 2 * MiB, WS_LOGI = 4 * MiB, WS_LOGF = 4 * MiB + 512 * 1024, WS_WR = 5 * MiB;
constexpr size_t WS_WIN = 6 * MiB, WS_WBR = 17 * MiB, WS_WOUT = 19 * MiB, WS_WGU = 21 * MiB, WS_WD = 53 * MiB;
constexpr size_t WS_R1 = 70 * MiB;
constexpr size_t WS_QM = 134 * MiB, WS_KM = 166 * MiB, WS_VM = 198 * MiB, WS_OG = 230 * MiB;
constexpr size_t WS_QD = 262 * MiB, WS_KD = 294 * MiB, WS_VD = 326 * MiB;
constexpr size_t WS_GM = 358 * MiB, WS_GD = 422 * MiB;
constexpr size_t WS_MG = WS_QM;
constexpr size_t WS_TOK = WS_VM, WS_WT = WS_VM + 8 * MiB;
constexpr size_t WS_Y = 302 * MiB;
constexpr size_t WS_H2F = WS_VD;
constexpr size_t WS_X1B = WS_GD;
constexpr size_t WS_ACT = WS_QD;
constexpr size_t WS_END = 486 * MiB;
constexpr size_t WS_MODP = 488 * MiB;
constexpr size_t WS_NT = 486 * MiB, WS_SC = 487 * MiB, WS_MIN = 487 * MiB + 65536;
constexpr int CW_BAR = 4096, CW_ATTQ = 8192, CW_CNT = 12288, CW_ERR = 16384;

__host__ __device__ __forceinline__ int dperm(int p) { return p < 16 ? (8 * ((p >> 2) & 1) + 4 * (p >> 3) + (p & 3)) : p; }
__host__ __device__ __forceinline__ int win_col(int L) {
    if (L < 2048) return L;
    if (L < 3072) { const int Lp = L - 2048, isk = Lp >> 9, Lt = Lp & 511, th = Lt >> 8, P = Lt & 255, bj = P >> 7, g = (P >> 5) & 3, r = P & 31;
        return (isk ? 2568 : 2056) + 64 * (4 * th + g) + dperm(32 * bj + r); }
    if (L < 3584) return 3080 + (L - 3072);
    { const int Lg = L - 3584, k = Lg >> 8, P = Lg & 255, bj = P >> 7, c = P & 127; return (bj ? 4616 : 3592) + 128 * k + c; }
}

using pg8::Unit;
DI u32x4 pack8(const f32x4& a, const f32x4& b) { u32x4 w; w.x = pk2(a[0], a[1]); w.y = pk2(a[2], a[3]); w.z = pk2(b[0], b[1]); w.w = pk2(b[2], b[3]); return w; }
DI float bfidx(const u32x4& w, int i) { const unsigned x = (i < 2) ? w.x : (i < 4) ? w.y : (i < 6) ? w.z : w.w; return (i & 1) ? bfhi(x) : bflo(x); }

struct EpiInProj {
    static constexpr bool PERM = true, HAS_MID = false; static constexpr int MID_T = 0;
    bf16_t *QM, *KM, *VM, *OG, *QD, *KD, *VD, *GM, *GD; const float* cs; const float *qnw, *knw;
    DI void mid(f32x4 (&)[2][2][4][2], const Unit&, int, int, int, int) const {}
    DI void operator()(const f32x4 (&acc)[2][2][4][2], const Unit& u, int wr, int wc, int fr, int fq) const {
        asm volatile("" : "+v"(fr), "+v"(fq));
        const int pn = u.pn, row0 = u.pm * 256 + wr * 64 + fr;
        constexpr float WSC = 1.0f / 32.0f;
        if (pn >= 8 && pn < 12) {
            const bool isk = pn >= 10; const int grp = 4 * (pn & 1) + wc;
            bf16_t* dst = isk ? KD : QD; const float* nw = isk ? knw : qnw;
            f32x4 w[2][2];
#pragma unroll
            for (int n = 0; n < 2; ++n) { w[0][n] = *(const f32x4*)(nw + (fq < 2 ? (8 * n + 4 * fq) : (8 * fq + 4 * n))); w[1][n] = *(const f32x4*)(nw + 32 + 8 * fq + 4 * n); }
            const float osc = isk ? 1.0f : QSCALE;
#pragma unroll
            for (int ai = 0; ai < 2; ++ai) {
                f32x4 cc[4], sn[4];
#pragma unroll
                for (int m = 0; m < 4; ++m) { cc[m] = (f32x4){1.f, 1.f, 1.f, 1.f}; sn[m] = (f32x4){0.f, 0.f, 0.f, 0.f}; }
                if (fq < 2) {
#pragma unroll
                    for (int m = 0; m < 4; ++m) { const float* cp = cs + (size_t)(row0 + ai * 128 + m * 16) * 16 + 4 * fq; cc[m] = *(const f32x4*)cp; sn[m] = *(const f32x4*)(cp + 8); } }
                __builtin_amdgcn_sched_barrier(0);
#pragma unroll
                for (int m = 0; m < 4; ++m) {
                    const int row = row0 + ai * 128 + m * 16;
                    f32x4 y[2][2]; float ss = 0.f;
#pragma unroll
                    for (int bj = 0; bj < 2; ++bj)
#pragma unroll
                        for (int n = 0; n < 2; ++n) { y[bj][n] = acc[ai][bj][m][n] * WSC; const f32x4 q = y[bj][n] * y[bj][n]; ss += (q[0] + q[1]) + (q[2] + q[3]); }
                    ss += __shfl_xor(ss, 16); ss += __shfl_xor(ss, 32);
                    const float rstd = __builtin_amdgcn_rsqf(ss * (1.0f / 64.0f) + REPS);
#pragma unroll
                    for (int bj = 0; bj < 2; ++bj)
#pragma unroll
                        for (int n = 0; n < 2; ++n) y[bj][n] = y[bj][n] * rstd * w[bj][n];
                    if (fq < 2) {
                        const f32x4 c4 = cc[m], s4 = sn[m];
                        const f32x4 a = y[0][0], b = y[0][1];
                        y[0][0] = a * c4 - b * s4; y[0][1] = b * c4 + a * s4;
                    }
#pragma unroll
                    for (int bj = 0; bj < 2; ++bj) __builtin_nontemporal_store(pack8(y[bj][0] * osc, y[bj][1] * osc), (u32x4*)(dst + (size_t)row * 512 + 64 * grp + 32 * bj + 8 * fq));
                }
                __builtin_amdgcn_sched_barrier(0);
            }
            return;
        }
        if (pn >= 14) {
            const int colg = (pn - 14) * 128 + wc * 32 + 8 * fq;
#pragma unroll
            for (int ai = 0; ai < 2; ++ai)
#pragma unroll
                for (int m = 0; m < 4; ++m) { f32x4 r[2], d[2];
#pragma unroll
                    for (int n = 0; n < 2; ++n)
#pragma unroll
                        for (int j = 0; j < 4; ++j) { constexpr float C2 = -WSC * 1.4426950408889634f;
                            const float em = __builtin_amdgcn_exp2f(acc[ai][0][m][n][j] * C2), od = 1.f + __builtin_amdgcn_exp2f(fminf(acc[ai][1][m][n][j] * C2, 99.f));
                            d[n][j] = __builtin_amdgcn_rcpf(od); r[n][j] = od * __builtin_amdgcn_rcpf(1.f + em); }
                    const size_t off = (size_t)(row0 + ai * 128 + m * 16) * 1024 + colg;
                    __builtin_nontemporal_store(pack8(r[0], r[1]), (u32x4*)(GM + off)); __builtin_nontemporal_store(pack8(d[0], d[1]), (u32x4*)(GD + off)); }
            return;
        }
        bf16_t* base; int ld, colt; bool sg;
        if (pn < 8) { base = pn < 2 ? QM : pn < 4 ? KM : pn < 6 ? VM : OG; ld = 512; colt = (pn & 1) * 256; sg = pn >= 6; }
        else { base = VD; ld = 512; colt = (pn & 1) * 256; sg = false; }
        const int col0 = colt + wc * 32 + 8 * fq;
#pragma unroll
        for (int ai = 0; ai < 2; ++ai)
#pragma unroll
            for (int m = 0; m < 4; ++m) { bf16_t* rowp = base + (size_t)(row0 + ai * 128 + m * 16) * ld + col0;
#pragma unroll
                for (int bj = 0; bj < 2; ++bj) { f32x4 v0, v1;
                    if (sg) { constexpr float C2 = -WSC * 1.4426950408889634f;
#pragma unroll
                        for (int j = 0; j < 4; ++j) { v0[j] = __builtin_amdgcn_rcpf(1.f + __builtin_amdgcn_exp2f(acc[ai][bj][m][0][j] * C2)); v1[j] = __builtin_amdgcn_rcpf(1.f + __builtin_amdgcn_exp2f(acc[ai][bj][m][1][j] * C2)); } }
                    else { v0 = acc[ai][bj][m][0] * WSC; v1 = acc[ai][bj][m][1] * WSC; }
                    __builtin_nontemporal_store(pack8(v0, v1), (u32x4*)(rowp + bj * 128)); } }
    }
};

struct EpiBranch {
    static constexpr bool PERM = true, HAS_MID = true; static constexpr int MID_T = 8;
    const bf16_t *GM, *GD; bf16_t* MG;
    DI void mid(f32x4 (&acc)[2][2][4][2], const Unit& u, int wr, int wc, int fr, int fq) const {
        unsigned lo = (unsigned)((wr * 64 + fr) * 1024 + wc * 32 + 8 * fq); asm volatile("" : "+v"(lo));
        const size_t ub = (size_t)u.pm * 256 * 1024 + (size_t)u.pn * 256; const bf16_t* gmb = GM + ub;
        u32x4 gmv[2][4][2];
#pragma unroll
        for (int ai = 0; ai < 2; ++ai)
#pragma unroll
            for (int m = 0; m < 4; ++m)
#pragma unroll
                for (int bj = 0; bj < 2; ++bj) gmv[ai][m][bj] = *(const u32x4*)(gmb + (lo + (unsigned)((ai * 128 + m * 16) * 1024 + bj * 128)));
        __builtin_amdgcn_sched_barrier(0);
#pragma unroll
        for (int ai = 0; ai < 2; ++ai)
#pragma unroll
            for (int m = 0; m < 4; ++m)
#pragma unroll
                for (int bj = 0; bj < 2; ++bj) { const u32x4 gm = gmv[ai][m][bj];
#pragma unroll
                    for (int n = 0; n < 2; ++n)
#pragma unroll
                        for (int j = 0; j < 4; ++j) acc[ai][bj][m][n][j] *= bfidx(gm, 4 * n + j); }
    }
    DI void operator()(const f32x4 (&acc)[2][2][4][2], const Unit& u, int wr, int wc, int fr, int fq) const {
        unsigned lo = (unsigned)((wr * 64 + fr) * 1024 + wc * 32 + 8 * fq); asm volatile("" : "+v"(lo));
        const size_t ub = (size_t)u.pm * 256 * 1024 + (size_t)u.pn * 256; const bf16_t* gdb = GD + ub;
#define EB_OFF(ai, m, bj) (lo + (unsigned)(((ai) * 128 + (m) * 16) * 1024 + (bj) * 128))
        u32x4 g0[4][2], g1[4][2]; u32x2 p0[4][2];
        unsigned char* mg8 = (unsigned char*)MG + ub;
#define EB_PK8(v0_, v1_) (u32x2){(unsigned)__builtin_amdgcn_cvt_pk_fp8_f32(v0_[2], v0_[3], __builtin_amdgcn_cvt_pk_fp8_f32(v0_[0], v0_[1], 0, false), true), (unsigned)__builtin_amdgcn_cvt_pk_fp8_f32(v1_[2], v1_[3], __builtin_amdgcn_cvt_pk_fp8_f32(v1_[0], v1_[1], 0, false), true)}
#pragma unroll
        for (int m = 0; m < 4; ++m)
#pragma unroll
            for (int bj = 0; bj < 2; ++bj) g0[m][bj] = *(const u32x4*)(gdb + EB_OFF(0, m, bj));
        __builtin_amdgcn_sched_barrier(0);
#pragma unroll
        for (int m = 0; m < 4; ++m)
#pragma unroll
            for (int bj = 0; bj < 2; ++bj) { f32x4 v[2];
#pragma unroll
                for (int n = 0; n < 2; ++n)
#pragma unroll
                    for (int j = 0; j < 4; ++j) v[n][j] = acc[0][bj][m][n][j] * fmaxf(bfidx(g0[m][bj], 4 * n + j), 1e-30f);
                p0[m][bj] = EB_PK8(v[0], v[1]); }
        __builtin_amdgcn_sched_barrier(0);
#pragma unroll
        for (int m = 0; m < 4; ++m)
#pragma unroll
            for (int bj = 0; bj < 2; ++bj) g1[m][bj] = *(const u32x4*)(gdb + EB_OFF(1, m, bj));
        __builtin_amdgcn_sched_barrier(0);
#pragma unroll
        for (int m = 0; m < 4; ++m)
#pragma unroll
            for (int bj = 0; bj < 2; ++bj) *(u32x2*)(mg8 + EB_OFF(0, m, bj)) = p0[m][bj];
        __builtin_amdgcn_sched_barrier(0);
#pragma unroll
        for (int m = 0; m < 4; ++m)
#pragma unroll
            for (int bj = 0; bj < 2; ++bj) { f32x4 v[2];
#pragma unroll
                for (int n = 0; n < 2; ++n)
#pragma unroll
                    for (int j = 0; j < 4; ++j) v[n][j] = acc[1][bj][m][n][j] * fmaxf(bfidx(g1[m][bj], 4 * n + j), 1e-30f);
                *(u32x2*)(mg8 + EB_OFF(1, m, bj)) = EB_PK8(v[0], v[1]); }
#undef EB_PK8
#undef EB_OFF
    }
};

struct EpiOut {
    static constexpr bool PERM = true, HAS_MID = false; static constexpr int MID_T = 0;
    const float* mod; const bf16_t* xb; bf16_t* X1;
    DI void mid(f32x4 (&)[2][2][4][2], const Unit&, int, int, int, int) const {}
    DI void operator()(const f32x4 (&acc)[2][2][4][2], const Unit& u, int wr, int wc, int fr, int fq) const {
        asm volatile("" : "+v"(fr), "+v"(fq));
        const int row0 = u.pm * 256 + wr * 64 + fr, col0 = u.pn * 256 + wc * 32 + 8 * fq; const int b = u.pm >> 4;
        f32x4 gv[2][2];
#pragma unroll
        for (int bj = 0; bj < 2; ++bj)
#pragma unroll
            for (int n = 0; n < 2; ++n) gv[bj][n] = *(const f32x4*)(mod + b * 6144 + 2048 + col0 + bj * 128 + n * 4) * (1.0f / 32.0f);
#define EO_OFF(ai, m, bj) ((size_t)(row0 + (ai) * 128 + (m) * 16) * 1024 + col0 + (bj) * 128)
#define EO_MIX(W_, AI_, M_, BJ_) pack8((f32x4){bflo((W_).x), bfhi((W_).x), bflo((W_).y), bfhi((W_).y)} + gv[BJ_][0] * acc[AI_][BJ_][M_][0], (f32x4){bflo((W_).z), bfhi((W_).z), bflo((W_).w), bfhi((W_).w)} + gv[BJ_][1] * acc[AI_][BJ_][M_][1])
        u32x4 x0[4][2], p0[4][2], x1[4][2];
#pragma unroll
        for (int m = 0; m < 4; ++m)
#pragma unroll
            for (int bj = 0; bj < 2; ++bj) x0[m][bj] = *(const u32x4*)(xb + EO_OFF(0, m, bj));
        __builtin_amdgcn_sched_barrier(0);
#pragma unroll
        for (int m = 0; m < 4; ++m)
#pragma unroll
            for (int bj = 0; bj < 2; ++bj) p0[m][bj] = EO_MIX(x0[m][bj], 0, m, bj);
        __builtin_amdgcn_sched_barrier(0);
#pragma unroll
        for (int m = 0; m < 4; ++m)
#pragma unroll
            for (int bj = 0; bj < 2; ++bj) x1[m][bj] = *(const u32x4*)(xb + EO_OFF(1, m, bj));
        __builtin_amdgcn_sched_barrier(0);
#pragma unroll
        for (int m = 0; m < 4; ++m)
#pragma unroll
            for (int bj = 0; bj < 2; ++bj) *(u32x4*)(X1 + EO_OFF(0, m, bj)) = p0[m][bj];
        __builtin_amdgcn_sched_barrier(0);
#pragma unroll
        for (int m = 0; m < 4; ++m)
#pragma unroll
            for (int bj = 0; bj < 2; ++bj) *(u32x4*)(X1 + EO_OFF(1, m, bj)) = EO_MIX(x1[m][bj], 1, m, bj);
#undef EO_OFF
#undef EO_MIX
    }
};

struct EpiRouter {
    static constexpr bool PERM = false, HAS_MID = false; static constexpr int MID_T = 0;
    const float *brg, *bre; unsigned* cnt; int* tok; float* wt; float* route; LAS unsigned char* stage;
    DI void mid(f32x4 (&)[2][2][4][2], const Unit&, int, int, int, int) const {}
    DI void operator()(const f32x4 (&acc)[2][2][4][2], const Unit& u, int wr, int wc, int fr, int fq) const {
        if (wc != 0) return;
        const int row0 = u.pm * 256 + wr * 64 + fr;
        const f32x4 bg = *(const f32x4*)brg;
        int L1v[8], L2v[8]; float w1v[8], w2v[8];
#pragma unroll
        for (int ai = 0; ai < 2; ++ai)
#pragma unroll
            for (int m = 0; m < 4; ++m) {
                float gl[4];
#pragma unroll
                for (int j = 0; j < 4; ++j) gl[j] = __shfl(acc[ai][1][m][0][j], fr) + bg[j];
                int g = 0; float gmx = gl[0];
#pragma unroll
                for (int j = 1; j < 4; ++j) if (gl[j] > gmx) { gmx = gl[j]; g = j; }
                float gs = 0.f;
#pragma unroll
                for (int j = 0; j < 4; ++j) gs += fexp(gl[j] - gmx);
                const float pg = 1.0f / gs;
                f32x4 sel0 = acc[ai][0][m][0], sel1 = acc[ai][0][m][1];
                asm volatile("" : "+v"(sel0), "+v"(sel1));
                f32x4 sel;
#pragma unroll
                for (int j = 0; j < 4; ++j) sel[j] = (g & 2) ? sel1[j] : sel0[j];
                const int srcA = fr + 32 * (g & 1), srcB = srcA + 16;
                float el[8];
                { const f32x4 b0 = *(const LAS f32x4*)(stage + 4608 + 32 * g), b1 = *(const LAS f32x4*)(stage + 4608 + 32 * g + 16);
#pragma unroll
                  for (int j = 0; j < 4; ++j) { el[j] = __shfl(sel[j], srcA) + b0[j]; el[4 + j] = __shfl(sel[j], srcB) + b1[j]; } }
                int j1 = 0; float m1 = el[0];
#pragma unroll
                for (int j = 1; j < 8; ++j) if (el[j] > m1) { m1 = el[j]; j1 = j; }
                int j2 = -1; float m2 = -INFINITY;
#pragma unroll
                for (int j = 0; j < 8; ++j) if (j != j1 && el[j] > m2) { m2 = el[j]; j2 = j; }
                const float e2 = fexp(m2 - m1);
                L1v[ai * 4 + m] = 8 * g + j1; L2v[ai * 4 + m] = 32 + 8 * g + j2; w1v[ai * 4 + m] = pg / (1.f + e2); w2v[ai * 4 + m] = pg * e2 / (1.f + e2);
            }
        if (fq == 0) {
#pragma unroll
            for (int i = 0; i < 8; ++i) { const int li = wr * 64 + fr + (i >> 2) * 128 + (i & 3) * 16;
                *(LAS u32x4*)(stage + 16 * li) = (u32x4){(unsigned)(u.pm * 256 + li), (unsigned)L1v[i] | ((unsigned)L2v[i] << 8), __float_as_uint(w1v[i]), __float_as_uint(w2v[i])}; }
        }
        asm volatile("s_waitcnt lgkmcnt(0)" ::: "memory");
    }
    DI void commit(int tid) const {
        LAS unsigned* lcnt = (LAS unsigned*)(stage + 4096); LAS unsigned* lbase = lcnt + 64;
        if (tid < 64) lcnt[tid] = 0u;
        __syncthreads();
        u32x4 rec = {0u, 0u, 0u, 0u}; unsigned r1 = 0u, r2 = 0u, L1 = 0u, L2 = 0u;
        if (tid < 256) { rec = *(const LAS u32x4*)(stage + 16 * tid); L1 = rec.y & 255u; L2 = rec.y >> 8;
            r1 = __hip_atomic_fetch_add(lcnt + L1, 1u, __ATOMIC_RELAXED, __HIP_MEMORY_SCOPE_WORKGROUP); r2 = __hip_atomic_fetch_add(lcnt + L2, 1u, __ATOMIC_RELAXED, __HIP_MEMORY_SCOPE_WORKGROUP); }
        __syncthreads();
        if (tid < 64) { const unsigned n = lcnt[tid]; lbase[tid] = n ? atomicAdd(cnt + 64 * tid, n) : 0u; }
        __syncthreads();
        if (tid < 256) { const unsigned p1 = lbase[L1] + r1, p2 = lbase[L2] + r2; const int row = (int)rec.x;
            tok[(size_t)L1 * 32768 + p1] = row; wt[(size_t)L1 * 32768 + p1] = __uint_as_float(rec.z);
            tok[(size_t)L2 * 32768 + p2] = row; wt[(size_t)L2 * 32768 + p2] = __uint_as_float(rec.w);
            *(u32x4*)(route + (size_t)row * 4) = (u32x4){L1 * 32768u + p1, L2 * 32768u + p2, rec.z, rec.w}; }
    }
};

struct GroupedOrder {
    const LAS int* pref;
    int nx, nN, j; const int* tok; const unsigned* cnt;
    DI bool next(int i, Unit& u) const {
        const int un = i * 32 + j; if (un >= nx * nN) return false;
        const int gm = ((const LAS unsigned short*)(pref + 160))[un / nN]; int l = ((const LAS unsigned char*)(pref + 72))[gm];
        l = __builtin_amdgcn_readfirstlane(l); const int mt = __builtin_amdgcn_readfirstlane(gm - pref[l]);
        u.pm = __builtin_amdgcn_readfirstlane(gm); u.pn = __builtin_amdgcn_readfirstlane(un % nN); u.e = l & 31; u.l = l; u.mt = mt; return true;
    }
    DI unsigned gather(const Unit& u, int r, int c2, int K) const {
        const int n = pref[256 + u.l]; int idx = u.mt * 256 + r; idx = idx < n ? idx : n - 1;
        return (unsigned)tok[(size_t)u.l * 32768 + idx] * (unsigned)(K * 2) + (unsigned)c2;
    }
};
struct EpiGateUp {
    static constexpr bool PERM = true, HAS_MID = false; static constexpr int MID_T = 0;
    bf16_t* ACT;
    DI void mid(f32x4 (&)[2][2][4][2], const Unit&, int, int, int, int) const {}
    DI void operator()(const f32x4 (&acc)[2][2][4][2], const Unit& u, int wr, int wc, int fr, int fq) const {
        const int row0 = u.pm * 256 + wr * 64 + fr, col0 = u.pn * 128 + wc * 32 + 8 * fq;
#pragma unroll
        for (int ai = 0; ai < 2; ++ai)
#pragma unroll
            for (int m = 0; m < 4; ++m) { f32x4 v[2];
#pragma unroll
                for (int n = 0; n < 2; ++n)
#pragma unroll
                    for (int j = 0; j < 4; ++j) { const float gg = acc[ai][0][m][n][j]; v[n][j] = gg * fsigm(gg) * acc[ai][1][m][n][j]; }
                *(u32x4*)(ACT + (size_t)(row0 + ai * 128 + m * 16) * 256 + col0) = pack8(v[0], v[1]); }
    }
};
__host__ __device__ __forceinline__ int wd_col(int P) { const int bj = P >> 7, wc = (P >> 5) & 3, fq = (P >> 3) & 3, i = P & 7; return 64 * wc + 16 * fq + 8 * bj + i; }
struct EpiDownY {
    static constexpr bool PERM = true, HAS_MID = false; static constexpr int MID_T = 0;
    unsigned char* Y;
    DI void mid(f32x4 (&)[2][2][4][2], const Unit&, int, int, int, int) const {}
    DI void operator()(const f32x4 (&acc)[2][2][4][2], const Unit& u, int wr, int wc, int fr, int fq) const {
        const int row0 = u.pm * 256 + wr * 64 + fr, col0 = u.pn * 256 + 64 * wc + 16 * fq;
#pragma unroll
        for (int ai = 0; ai < 2; ++ai)
#pragma unroll
            for (int m = 0; m < 4; ++m) { u32x4 w;
                w.x = __builtin_amdgcn_cvt_pk_fp8_f32(acc[ai][0][m][0][2], acc[ai][0][m][0][3], __builtin_amdgcn_cvt_pk_fp8_f32(acc[ai][0][m][0][0], acc[ai][0][m][0][1], 0, false), true);
                w.y = __builtin_amdgcn_cvt_pk_fp8_f32(acc[ai][0][m][1][2], acc[ai][0][m][1][3], __builtin_amdgcn_cvt_pk_fp8_f32(acc[ai][0][m][1][0], acc[ai][0][m][1][1], 0, false), true);
                w.z = __builtin_amdgcn_cvt_pk_fp8_f32(acc[ai][1][m][0][2], acc[ai][1][m][0][3], __builtin_amdgcn_cvt_pk_fp8_f32(acc[ai][1][m][0][0], acc[ai][1][m][0][1], 0, false), true);
                w.w = __builtin_amdgcn_cvt_pk_fp8_f32(acc[ai][1][m][1][2], acc[ai][1][m][1][3], __builtin_amdgcn_cvt_pk_fp8_f32(acc[ai][1][m][1][0], acc[ai][1][m][1][1], 0, false), true);
                *(u32x4*)(Y + (size_t)(row0 + ai * 128 + m * 16) * 1024 + col0) = w; }
    }
};
namespace att {
typedef short v4i16_t __attribute__((ext_vector_type(4)));
constexpr int XP = 132;
constexpr int OFF_SUBW = 131072 + 1024;
constexpr int OFF_WS = 69632;
DI int crow(int r, int hi) { return (r & 3) + 8 * (r >> 2) + 4 * hi; }
DI s16x4 vtr(const LAS char* p) { return __builtin_bit_cast(s16x4, __builtin_amdgcn_ds_read_tr16_b64_v4i16((LAS v4i16_t*)p)); }

DI void unit(int b, int h, int qb, const bf16_t* __restrict__ QD, const bf16_t* __restrict__ KD, const bf16_t* __restrict__ VD, bf16_t* HMD, float lam, const float* subw, LAS char* lds) {
    int tid = threadIdx.x; asm volatile("" : "+v"(tid));
    const int lane = tid & 63, wid = __builtin_amdgcn_readfirstlane(tid >> 6), r32 = lane & 31, hi = lane >> 5, map = wid >> 2, wq = wid & 3;
    const int q0 = qb * 128, NT = 2 * qb + 2; const size_t rowbase = (size_t)b * SEQ;
    const bf16_t* kub = KD + rowbase * 512 + h * 128; const bf16_t* vub = VD + rowbase * 512 + h * 128;
    unsigned kgo[2], vgo[2];
#pragma unroll
    for (int i = 0; i < 2; ++i) { const int id = tid + 512 * i;
        kgo[i] = (unsigned)((id & 63) * 512 + (id >> 6) * 8);
        vgo[i] = (unsigned)(((id >> 2) & 63) * 512 + (id >> 8) * 32 + (id & 3) * 8); }
    const unsigned dmaw = (unsigned)wid * 1024u;
#define ATT_DMA(t) do { const unsigned st_ = ((unsigned)(t) & 3u) * 32768u; _Pragma("unroll") for (int i_ = 0; i_ < 2; ++i_) { \
        __builtin_amdgcn_global_load_lds((const unsigned*)(kub + (size_t)(t) * 64 * 512 + kgo[i_]), (LAS unsigned*)(lds + st_ + dmaw + i_ * 8192), 16, 0, 0); \
        __builtin_amdgcn_global_load_lds((const unsigned*)(vub + (size_t)(t) * 64 * 512 + vgo[i_]), (LAS unsigned*)(lds + st_ + 16384 + dmaw + i_ * 8192), 16, 0, 0); } } while (0)
#ifdef ATT_DOUBLE_DMA
#define ATT_DMA_X2(t) ATT_DMA(t)
#else
#define ATT_DMA_X2(t) do {} while (0)
#endif
    ATT_DMA(0); ATT_DMA(1);
    bf16x8 qf[4];
    { const bf16_t* qp = QD + (rowbase + q0 + 32 * wq + r32) * 512 + h * 128 + map * 64 + 8 * hi;
#pragma unroll
      for (int d0 = 0; d0 < 4; ++d0) qf[d0] = *(const bf16x8*)(qp + 16 * d0); }
    asm volatile("" : "+v"(qf[0]), "+v"(qf[1]), "+v"(qf[2]), "+v"(qf[3]));
    asm volatile("s_waitcnt vmcnt(0) lgkmcnt(0)\n\ts_barrier" ::: "memory");
    if (2 < NT) ATT_DMA(2);
    f32x16 o[4];
#pragma unroll
    for (int i = 0; i < 4; ++i)
#pragma unroll
        for (int r = 0; r < 16; ++r) o[i][r] = 0.f;
    f32x16 lacc;
#pragma unroll
    for (int r = 0; r < 16; ++r) lacc[r] = 0.f;
    const bf16x8 ones = (bf16x8){0x3f80, 0x3f80, 0x3f80, 0x3f80, 0x3f80, 0x3f80, 0x3f80, 0x3f80};
    const int qabs = q0 + 32 * wq + r32;
    const int kfo = (8 * map + hi) * 1024 + r32 * 16;
    const int vfo = 16384 + ((lane >> 4) & 1) * 32 + (lane & 3) * 8 + (4 * hi + ((lane & 15) >> 2)) * 64;
#define ATT_QK(P0, P1, tt) do { const LAS char* kb_ = lds + ((tt) & 3) * 32768 + kfo; \
        _Pragma("unroll") for (int r = 0; r < 16; ++r) { P0[r] = 0.f; P1[r] = 0.f; } \
        _Pragma("unroll") for (int dh = 0; dh < 2; ++dh) { bf16x8 kf_[4]; \
            _Pragma("unroll") for (int dd = 0; dd < 2; ++dd) { kf_[2 * dd] = *(const LAS bf16x8*)(kb_ + (2 * dh + dd) * 2048); kf_[2 * dd + 1] = *(const LAS bf16x8*)(kb_ + (2 * dh + dd) * 2048 + 512); } \
            _Pragma("unroll") for (int dd = 0; dd < 2; ++dd) { P0 = __builtin_amdgcn_mfma_f32_32x32x16_bf16(kf_[2 * dd], qf[2 * dh + dd], P0, 0, 0, 0); P1 = __builtin_amdgcn_mfma_f32_32x32x16_bf16(kf_[2 * dd + 1], qf[2 * dh + dd], P1, 0, 0, 0); } \
            __builtin_amdgcn_sched_barrier(0); } } while (0)
#define ATT_EXP_MASK(P0, P1, tt) do { const int kbase_ = 64 * (tt) + 4 * hi; _Pragma("unroll") for (int r = 0; r < 16; ++r) { const int kv_ = kbase_ + (r & 3) + 8 * (r >> 2); \
        P0[r] = (kv_ > qabs) ? 0.f : __builtin_amdgcn_exp2f(P0[r]); P1[r] = (kv_ + 32 > qabs) ? 0.f : __builtin_amdgcn_exp2f(P1[r]); } } while (0)
#define ATT_PACK(P0, P1) do { u32x4 w_; \
        w_.x = pk2(P0[0], P0[1]); w_.y = pk2(P0[2], P0[3]); w_.z = pk2(P0[4], P0[5]); w_.w = pk2(P0[6], P0[7]); pa[0] = __builtin_bit_cast(bf16x8, w_); \
        w_.x = pk2(P0[8], P0[9]); w_.y = pk2(P0[10], P0[11]); w_.z = pk2(P0[12], P0[13]); w_.w = pk2(P0[14], P0[15]); pa[1] = __builtin_bit_cast(bf16x8, w_); \
        w_.x = pk2(P1[0], P1[1]); w_.y = pk2(P1[2], P1[3]); w_.z = pk2(P1[4], P1[5]); w_.w = pk2(P1[6], P1[7]); pa[2] = __builtin_bit_cast(bf16x8, w_); \
        w_.x = pk2(P1[8], P1[9]); w_.y = pk2(P1[10], P1[11]); w_.z = pk2(P1[12], P1[13]); w_.w = pk2(P1[14], P1[15]); pa[3] = __builtin_bit_cast(bf16x8, w_); } while (0)
#define ATT_VFRAG(vb_, j) ({ const s16x4 lo_ = vtr((vb_) + ((j) >> 2) * 4096 + ((j) & 3) * 1024), hh_ = vtr((vb_) + ((j) >> 2) * 4096 + ((j) & 3) * 1024 + 512); (bf16x8){lo_[0], lo_[1], lo_[2], lo_[3], hh_[0], hh_[1], hh_[2], hh_[3]}; })
#define ATT_PV_PLAIN(tt) do { const LAS char* vb_ = lds + ((tt) & 3) * 32768 + vfo; __builtin_amdgcn_s_setprio(1); \
        _Pragma("unroll") for (int ks = 0; ks < 4; ++ks) lacc = __builtin_amdgcn_mfma_f32_32x32x16_bf16(pa[ks], ones, lacc, 0, 0, 0); \
        _Pragma("unroll") for (int j = 0; j < 16; ++j) { const bf16x8 vf_ = ATT_VFRAG(vb_, j); o[j >> 2] = __builtin_amdgcn_mfma_f32_32x32x16_bf16(pa[j & 3], vf_, o[j >> 2], 0, 0, 0); } \
        __builtin_amdgcn_s_setprio(0); } while (0)
#ifdef ATT_PROBE
#ifdef ATT_PROBE_RT
    const unsigned long long tp0_ = __builtin_amdgcn_s_memrealtime();
#else
    const unsigned long long tp0_ = __builtin_amdgcn_s_memtime();
#endif
#endif
    bf16x8 pa[4];
    { f32x16 p0, p1;
      ATT_QK(p0, p1, 0);
      if (NT > 2) {
#pragma unroll
          for (int r = 0; r < 16; ++r) { p0[r] = __builtin_amdgcn_exp2f(p0[r]); p1[r] = __builtin_amdgcn_exp2f(p1[r]); }
      } else ATT_EXP_MASK(p0, p1, 0);
      ATT_PACK(p0, p1); }
#ifdef ATT_DOUBLE_DMA
#define ATT_VM4 "8"
#else
#define ATT_VM4 "4"
#endif
#define ATT_TOP_NODMA(t) do { if ((t) + 1 < NT) asm volatile("s_waitcnt vmcnt(" ATT_VM4 ") lgkmcnt(0)\n\ts_barrier" ::: "memory"); else asm volatile("s_waitcnt vmcnt(0) lgkmcnt(0)\n\ts_barrier" ::: "memory"); } while (0)
#define ATT_TOP(t) do { if ((t) + 1 < NT) asm volatile("s_waitcnt vmcnt(" ATT_VM4 ") lgkmcnt(0)\n\ts_barrier" ::: "memory"); else asm volatile("s_waitcnt vmcnt(0) lgkmcnt(0)\n\ts_barrier" ::: "memory"); \
        if ((t) + 2 < NT) { ATT_DMA((t) + 2); ATT_DMA_X2((t) + 2); } } while (0)
    int t = 1;
    for (; t + 2 < NT; ++t) {
        ATT_TOP_NODMA(t);
        {
            const LAS char* kb = lds + (t & 3) * 32768 + kfo;
            const LAS char* vb = lds + ((t - 1) & 3) * 32768 + vfo;
            f32x16 ph; bf16x8 pn[4];
#define ATT_QKH(off) do { bf16x8 kf_[4]; _Pragma("unroll") for (int d0 = 0; d0 < 4; ++d0) kf_[d0] = *(const LAS bf16x8*)(kb + d0 * 2048 + (off)); \
                _Pragma("unroll") for (int r = 0; r < 16; ++r) ph[r] = 0.f; \
                _Pragma("unroll") for (int d0 = 0; d0 < 4; ++d0) ph = __builtin_amdgcn_mfma_f32_32x32x16_bf16(kf_[d0], qf[d0], ph, 0, 0, 0); } while (0)
#define ATT_GAP(j, e0) do { const bf16x8 vfn_ = ATT_VFRAG(vb, ((j) + 2) & 15); \
                o[(j) >> 2] = __builtin_amdgcn_mfma_f32_32x32x16_bf16(pa[(j) & 3], vfa, o[(j) >> 2], 0, 0, 0); \
                ph[e0] = __builtin_amdgcn_exp2f(ph[e0]); ph[(e0) + 1] = __builtin_amdgcn_exp2f(ph[(e0) + 1]); \
                vfa = vfb; vfb = vfn_; } while (0)
#define ATT_PACKH(i0) do { u32x4 w_; w_.x = pk2(ph[0], ph[1]); w_.y = pk2(ph[2], ph[3]); w_.z = pk2(ph[4], ph[5]); w_.w = pk2(ph[6], ph[7]); pn[i0] = __builtin_bit_cast(bf16x8, w_); \
                w_.x = pk2(ph[8], ph[9]); w_.y = pk2(ph[10], ph[11]); w_.z = pk2(ph[12], ph[13]); w_.w = pk2(ph[14], ph[15]); pn[(i0) + 1] = __builtin_bit_cast(bf16x8, w_); } while (0)
#define ATT_GAP0(j) do { const bf16x8 vfn_ = ATT_VFRAG(vb, ((j) + 2) & 15); \
                o[(j) >> 2] = __builtin_amdgcn_mfma_f32_32x32x16_bf16(pa[(j) & 3], vfa, o[(j) >> 2], 0, 0, 0); \
                vfa = vfb; vfb = vfn_; } while (0)
#define ATT_GAP3(j, e0) do { const bf16x8 vfn_ = ATT_VFRAG(vb, ((j) + 2) & 15); \
                o[(j) >> 2] = __builtin_amdgcn_mfma_f32_32x32x16_bf16(pa[(j) & 3], vfa, o[(j) >> 2], 0, 0, 0); \
                ph[e0] = __builtin_amdgcn_exp2f(ph[e0]); ph[(e0) + 1] = __builtin_amdgcn_exp2f(ph[(e0) + 1]); ph[(e0) + 2] = __builtin_amdgcn_exp2f(ph[(e0) + 2]); \
                vfa = vfb; vfb = vfn_; } while (0)
            __builtin_amdgcn_s_setprio(1);
            ATT_QKH(0);
            __builtin_amdgcn_sched_barrier(0);
            bf16x8 vfa = ATT_VFRAG(vb, 0), vfb = ATT_VFRAG(vb, 1);
#pragma unroll
            for (int ks = 0; ks < 4; ++ks) lacc = __builtin_amdgcn_mfma_f32_32x32x16_bf16(pa[ks], ones, lacc, 0, 0, 0);
            ATT_GAP(0, 0); ATT_GAP(1, 2); ATT_GAP(2, 4); ATT_GAP(3, 6); ATT_GAP(4, 8); ATT_GAP(5, 10); ATT_GAP(6, 12); ATT_GAP(7, 14);
#pragma unroll
            for (int i = 0; i < 4; ++i) __builtin_amdgcn_sched_group_barrier(0x008, 1, 0);
#pragma unroll
            for (int i = 0; i < 8; ++i) { __builtin_amdgcn_sched_group_barrier(0x100, 2, 0); __builtin_amdgcn_sched_group_barrier(0x008, 1, 0); __builtin_amdgcn_sched_group_barrier(0x402, 2, 0); }
            __builtin_amdgcn_sched_barrier(0);
            ATT_PACKH(0);
            ATT_DMA(t + 2);
            ATT_QKH(512);
            __builtin_amdgcn_sched_barrier(0);
            ATT_GAP0(8); ATT_GAP0(9);
            ATT_GAP3(10, 0); ATT_GAP3(11, 3); ATT_GAP3(12, 6); ATT_GAP3(13, 9); ATT_GAP(14, 12); ATT_GAP(15, 14);
#pragma unroll
            for (int i = 0; i < 2; ++i) { __builtin_amdgcn_sched_group_barrier(0x100, 2, 0); __builtin_amdgcn_sched_group_barrier(0x008, 1, 0); }
#pragma unroll
            for (int i = 0; i < 4; ++i) { __builtin_amdgcn_sched_group_barrier(0x100, 2, 0); __builtin_amdgcn_sched_group_barrier(0x008, 1, 0); __builtin_amdgcn_sched_group_barrier(0x402, 3, 0); }
#pragma unroll
            for (int i = 0; i < 2; ++i) { __builtin_amdgcn_sched_group_barrier(0x100, 2, 0); __builtin_amdgcn_sched_group_barrier(0x008, 1, 0); __builtin_amdgcn_sched_group_barrier(0x402, 2, 0); }
            __builtin_amdgcn_sched_barrier(0);
            __builtin_amdgcn_s_setprio(0);
            ATT_PACKH(2);
            pa[0] = pn[0]; pa[1] = pn[1]; pa[2] = pn[2]; pa[3] = pn[3];
#undef ATT_GAP0
#undef ATT_GAP3
#undef ATT_QKH
#undef ATT_GAP
#undef ATT_PACKH
        }
    }
    for (; t < NT; ++t) {
        ATT_TOP(t);
        ATT_PV_PLAIN(t - 1);
        if (64 * t <= q0 + 32 * wq + 31) { f32x16 p0, p1; ATT_QK(p0, p1, t); ATT_EXP_MASK(p0, p1, t); ATT_PACK(p0, p1); }
    }
    if (64 * (NT - 1) <= q0 + 32 * wq + 31) ATT_PV_PLAIN(NT - 1);
#undef ATT_TOP
#undef ATT_TOP_NODMA
#undef ATT_QK
#undef ATT_EXP_MASK
#undef ATT_PACK
#undef ATT_VFRAG
#undef ATT_PV_PLAIN
#undef ATT_DMA
#ifdef ATT_PROBE
    if (tid == 0) { volatile LAS unsigned* pm_ = (volatile LAS unsigned*)(lds + 131072 + 320);
#if defined(UNIT_PROBE) || defined(EPI_PROBE)
        (void)tp0_;
#elif defined(ATT_PROBE_RT)
        pm_[4] += (unsigned)(__builtin_amdgcn_s_memrealtime() - tp0_) * 100u;
#else
        pm_[4] += (unsigned)(__builtin_amdgcn_s_memtime() - tp0_);
#endif
        pm_[5] += (unsigned)NT; }
#endif
#ifdef EPI_PROBE
    const unsigned long long te0_ = __builtin_amdgcn_s_memtime();
#endif
    __syncthreads();
    { int t2_ = threadIdx.x; asm volatile("" : "+v"(t2_)); tid = t2_; }
    const int lane_e = tid & 63, r32e = lane_e & 31, hie = lane_e >> 5;
    float rl[16];
#pragma unroll
    for (int r = 0; r < 16; ++r) rl[r] = __builtin_amdgcn_rcpf(lacc[r]);
    LAS float* X = (LAS float*)lds + wq * 32 * XP;
    if (map == 1) {
#pragma unroll
        for (int dt = 0; dt < 4; ++dt)
#pragma unroll
            for (int r = 0; r < 16; ++r) X[crow(r, hie) * XP + 32 * dt + r32e] = lam * o[dt][r] * rl[r];
    }
    __syncthreads();
    if (map == 0) {
#pragma unroll
        for (int dt = 0; dt < 4; ++dt)
#pragma unroll
            for (int r = 0; r < 16; ++r) { const int idx = crow(r, hie) * XP + 32 * dt + r32e; X[idx] = o[dt][r] * rl[r] - X[idx]; }
        asm volatile("s_waitcnt lgkmcnt(0)" ::: "memory");
        const int row = lane_e >> 1, seg = lane_e & 1;
        f32x4 xv[16]; float ss = 0.f;
#pragma unroll
        for (int i = 0; i < 16; ++i) { xv[i] = *(const LAS f32x4*)(X + row * XP + 64 * seg + 4 * i); const f32x4 q = xv[i] * xv[i]; ss += (q[0] + q[1]) + (q[2] + q[3]); }
        ss += __shfl_xor(ss, 1);
        const float rs = __builtin_amdgcn_rsqf(ss * (1.0f / 128.0f) + REPS) * 0.8f;
        bf16_t* op = HMD + (rowbase + q0 + 32 * wq + row) * 1024 + 512 + h * 128 + 64 * seg;
        const LAS float* swl = (const LAS float*)(lds + OFF_SUBW);
#pragma unroll
        for (int i = 0; i < 8; ++i) { const f32x4 w0 = *(const LAS f32x4*)(swl + 64 * seg + 8 * i), w1 = *(const LAS f32x4*)(swl + 64 * seg + 8 * i + 4);
            *(u32x4*)(op + 8 * i) = pack8(xv[2 * i] * w0 * rs, xv[2 * i + 1] * w1 * rs); }
    }
    __syncthreads();
#ifdef EPI_PROBE
    if (threadIdx.x == 0) { volatile LAS unsigned* pm_ = (volatile LAS unsigned*)(lds + 131072 + 320); pm_[4] += (unsigned)(__builtin_amdgcn_s_memtime() - te0_); }
#endif
}
}

namespace ml {
constexpr int PQ = 272, PS = 144;
constexpr int OQ = 0, OK = 17408, OKW = 34816, OV = 53248, OP = 71680, OF = 80896, OH = 110592;
constexpr int F_N = 0, F_QN = 128, F_RSP = 192, F_SSQ = 320, F_G = 832, F_CW = 1088, F_N2 = 6208, F_RS = 6336;
struct Ptrs { const bf16_t *QM, *KM, *VM, *OG; const float *LOGI, *LOGF, *conv_w, *conv_b, *nw; bf16_t* HMD; float *LT, *NT, *SC, *MIN; };

DI float row_scan_add(float x) {
    x += __builtin_bit_cast(float, __builtin_amdgcn_update_dpp(0, __builtin_bit_cast(int, x), 0x111, 0xf, 0xf, true));
    x += __builtin_bit_cast(float, __builtin_amdgcn_update_dpp(0, __builtin_bit_cast(int, x), 0x112, 0xf, 0xf, true));
    x += __builtin_bit_cast(float, __builtin_amdgcn_update_dpp(0, __builtin_bit_cast(int, x), 0x114, 0xf, 0xf, true));
    x += __builtin_bit_cast(float, __builtin_amdgcn_update_dpp(0, __builtin_bit_cast(int, x), 0x118, 0xf, 0xf, true));
    return x;
}
DI float wave_scan_add(float x) {
    x = row_scan_add(x);
    x += __builtin_bit_cast(float, __builtin_amdgcn_update_dpp(0, __builtin_bit_cast(int, x), 0x142, 0xa, 0xf, false));
    x += __builtin_bit_cast(float, __builtin_amdgcn_update_dpp(0, __builtin_bit_cast(int, x), 0x143, 0xc, 0xf, false));
    return x;
}
DI float wave_scan_max(float x) {
#define ML_DPPMAX(ctrl, rm) x = fmaxf(x, __builtin_bit_cast(float, __builtin_amdgcn_update_dpp(__builtin_bit_cast(int, x), __builtin_bit_cast(int, x), ctrl, rm, 0xf, false)))
    ML_DPPMAX(0x111, 0xf); ML_DPPMAX(0x112, 0xf); ML_DPPMAX(0x114, 0xf); ML_DPPMAX(0x118, 0xf); ML_DPPMAX(0x142, 0xa); ML_DPPMAX(0x143, 0xc);
#undef ML_DPPMAX
    return x;
}
DI float row_scan_add8(float x) {
    x += __builtin_bit_cast(float, __builtin_amdgcn_update_dpp(0, __builtin_bit_cast(int, x), 0x111, 0xf, 0xf, true));
    x += __builtin_bit_cast(float, __builtin_amdgcn_update_dpp(0, __builtin_bit_cast(int, x), 0x112, 0xf, 0xf, true));
    x += __builtin_bit_cast(float, __builtin_amdgcn_update_dpp(0, __builtin_bit_cast(int, x), 0x114, 0xf, 0xf, true));
    return x;
}
DI void load_taps(const Ptrs& P, LAS float* fl, int tid) {
    float tv[10];
#pragma unroll
    for (int k = 0; k < 10; ++k) { const int i = tid + 512 * k, hh = i / 1280, r = i % 1280, tn = r / 640, j = (r % 640) >> 7, col = r & 127, ch = tn * 512 + hh * 128 + col;
        const float* src = (j < 4) ? P.conv_w + j * 1024 + ch : P.conv_b + ch; tv[k] = *src; }
#pragma unroll
    for (int k = 0; k < 10; ++k) fl[F_CW + tid + 512 * k] = tv[k];
}
#define ML_CONV_HALF(hh, cwp, xr, ov) do { float cw_[4][4]; \
        { const f32x4 b0_ = *(const LAS f32x4*)((cwp) + 512 + 4 * (hh)); _Pragma("unroll") for (int r = 0; r < 4; ++r) { ov[r][0] = b0_[0]; ov[r][1] = b0_[1]; ov[r][2] = b0_[2]; ov[r][3] = b0_[3]; } } \
        _Pragma("unroll") for (int j = 0; j < 4; ++j) { const f32x4 w0_ = *(const LAS f32x4*)((cwp) + 128 * j + 4 * (hh)); cw_[j][0] = w0_[0]; cw_[j][1] = w0_[1]; cw_[j][2] = w0_[2]; cw_[j][3] = w0_[3]; } \
        _Pragma("unroll") for (int rr = 0; rr < 7; ++rr) { const unsigned wa_ = (hh) ? xr[rr].z : xr[rr].x, wb_ = (hh) ? xr[rr].w : xr[rr].y; const float xe_[4] = {bflo(wa_), bfhi(wa_), bflo(wb_), bfhi(wb_)}; \
            _Pragma("unroll") for (int r = 0; r < 4; ++r) { const int j = rr - r; if (j >= 0 && j < 4) { _Pragma("unroll") for (int e = 0; e < 4; ++e) ov[r][e] += cw_[j][e] * xe_[e]; } } } } while (0)

DI void passA(const Ptrs& P, LAS char* lds, int first, int stride) {
    const int tid = threadIdx.x, lane = tid & 63, wid = __builtin_amdgcn_readfirstlane(tid >> 6), fr = lane & 15, gq = lane >> 4;
    LAS float* fl = (LAS float*)(lds + OF);
    const int cch = (tid >> 5) & 15, rp = tid & 31;
    const int vch = tid >> 5, sp = tid & 31;
    load_taps(P, fl, tid);
    __syncthreads();
    u32x4 xr[5], vv[2]; float lf = 0.f, li = 0.f;
#define MLA_LOAD(itn) do { const int bh_ = (itn) & 31, c_ = (itn) >> 5, h_ = bh_ & 3; const size_t R0_ = (size_t)(bh_ >> 2) * SEQ; \
        lf = P.LOGF[(size_t)bh_ * SEQ + 64 * c_ + lane]; li = P.LOGI[(size_t)bh_ * SEQ + 64 * c_ + lane];     \
        { const bf16_t* csrc_ = P.KM + h_ * 128 + 8 * cch; \
            _Pragma("unroll") for (int rr = 0; rr < 5; ++rr) { const int gr = 64 * c_ + 2 * rp + rr - 3; xr[rr] = (gr >= 0) ? *(const u32x4*)(csrc_ + (R0_ + gr) * 512) : (u32x4){0u, 0u, 0u, 0u}; } } \
        { const bf16_t* vsrc_ = P.VM + h_ * 128 + 8 * vch; \
          _Pragma("unroll") for (int rr = 0; rr < 2; ++rr) vv[rr] = *(const u32x4*)(vsrc_ + (R0_ + 64 * c_ + 2 * sp + rr) * 512); } } while (0)
    if (first < 2048) MLA_LOAD(first);
    for (int it = first; it < 2048; it += stride) {
        const int bh = it & 31, h = bh & 3;
        const float bc = wave_scan_add(lf);
        const float ag = li - bc; const float pm = wave_scan_max(ag);
        const float pmax = __builtin_bit_cast(float, __builtin_amdgcn_readlane(__builtin_bit_cast(int, pm), 63)), blast = __builtin_bit_cast(float, __builtin_amdgcn_readlane(__builtin_bit_cast(int, bc), 63)), wloc = fexp(ag - pmax);
        const float wx0 = __shfl(wloc, 2 * rp), wx1 = __shfl(wloc, 2 * rp + 1);
        {
            const LAS float* cwp = fl + F_CW + h * 1280 + 640 + 8 * cch;
#pragma unroll
            for (int hh = 0; hh < 2; ++hh) {
                float ov[2][4], cw_[4][4];
                { const f32x4 b0_ = *(const LAS f32x4*)(cwp + 512 + 4 * hh);
#pragma unroll
                  for (int r = 0; r < 2; ++r) { ov[r][0] = b0_[0]; ov[r][1] = b0_[1]; ov[r][2] = b0_[2]; ov[r][3] = b0_[3]; } }
#pragma unroll
                for (int j = 0; j < 4; ++j) { const f32x4 w0_ = *(const LAS f32x4*)(cwp + 128 * j + 4 * hh); cw_[j][0] = w0_[0]; cw_[j][1] = w0_[1]; cw_[j][2] = w0_[2]; cw_[j][3] = w0_[3]; }
#pragma unroll
                for (int rr = 0; rr < 5; ++rr) { const unsigned wa_ = hh ? xr[rr].z : xr[rr].x, wb_ = hh ? xr[rr].w : xr[rr].y; const float xe_[4] = {bflo(wa_), bfhi(wa_), bflo(wb_), bfhi(wb_)};
#pragma unroll
                    for (int r = 0; r < 2; ++r) { const int j = rr - r; if (j >= 0 && j < 4) {
#pragma unroll
                            for (int e = 0; e < 4; ++e) ov[r][e] += cw_[j][e] * xe_[e]; } } }
#pragma unroll
                for (int e = 0; e < 4; ++e) { const float v0 = ov[0][e], v1 = ov[1][e];
                    *(LAS unsigned*)(lds + OKW + (8 * cch + 4 * hh + e) * PS + (2 * rp) * 2) = pk2(v0 * fsigm(v0) * 0.08838834764831845f * wx0, v1 * fsigm(v1) * 0.08838834764831845f * wx1); }
                __builtin_amdgcn_sched_barrier(0); }
        }
        { float v0[8], v1[8];
          v0[0] = bflo(vv[0].x); v0[1] = bfhi(vv[0].x); v0[2] = bflo(vv[0].y); v0[3] = bfhi(vv[0].y); v0[4] = bflo(vv[0].z); v0[5] = bfhi(vv[0].z); v0[6] = bflo(vv[0].w); v0[7] = bfhi(vv[0].w);
          v1[0] = bflo(vv[1].x); v1[1] = bfhi(vv[1].x); v1[2] = bflo(vv[1].y); v1[3] = bfhi(vv[1].y); v1[4] = bflo(vv[1].z); v1[5] = bfhi(vv[1].z); v1[6] = bflo(vv[1].w); v1[7] = bfhi(vv[1].w);
#pragma unroll
          for (int e = 0; e < 8; ++e) *(LAS unsigned*)(lds + OV + (8 * vch + e) * PS + (2 * sp) * 2) = pk2(v0[e], v1[e]); }
        if (it + stride < 2048) MLA_LOAD(it + stride);
        __syncthreads();
        f32x4 Cacc[8];
#pragma unroll
        for (int i = 0; i < 8; ++i) Cacc[i] = (f32x4){0.f, 0.f, 0.f, 0.f};
#pragma unroll
        for (int k2 = 0; k2 < 2; ++k2) {
            const bf16x8 bv = *(const LAS bf16x8*)(lds + OV + (16 * wid + fr) * PS + (32 * k2 + 8 * gq) * 2);
#pragma unroll
            for (int kt = 0; kt < 8; ++kt) { const bf16x8 a = *(const LAS bf16x8*)(lds + OKW + (16 * kt + fr) * PS + (32 * k2 + 8 * gq) * 2);
                Cacc[kt] = __builtin_amdgcn_mfma_f32_16x16x32_bf16(a, bv, Cacc[kt], 0, 0, 0); }
        }
        { bf16_t* dst = (bf16_t*)P.LT + (size_t)it * 16384 + (size_t)(wid * 64 + lane) * 32;
#pragma unroll
          for (int ks = 0; ks < 4; ++ks) *(u32x4*)(dst + 8 * ks) = pack8(Cacc[2 * ks], Cacc[2 * ks + 1]); }
        if (tid < 128) { float s = 0.f;
#pragma unroll
            for (int i = 0; i < 8; ++i) { const u32x4 w = *(const LAS u32x4*)(lds + OKW + tid * PS + i * 16); s += (bflo(w.x) + bfhi(w.x)) + (bflo(w.y) + bfhi(w.y)) + (bflo(w.z) + bfhi(w.z)) + (bflo(w.w) + bfhi(w.w)); }
            P.NT[(size_t)it * 128 + tid] = s; }
        if (tid == 0) { P.SC[2 * it] = pmax; P.SC[2 * it + 1] = blast; }
        __syncthreads();
    }
#undef MLA_LOAD
}

#ifndef SCAN_PD
#define SCAN_PD 4
#endif
DI void passB(const Ptrs& P, LAS char* lds, int tid) {
    const int g = blockIdx.x * 512 + tid, bh = g >> 12, e4 = g & 4095;
    LAS float* sc_l = (LAS float*)lds;
    if (tid < 128) sc_l[256 + tid] = P.SC[2 * ((tid >> 1) * 32 + bh) + (tid & 1)];
    __syncthreads();
    if (tid == 0) { float m = 0.f;
        for (int c = 0; c < 64; ++c) { const float pm = sc_l[256 + 2 * c], bl = sc_l[257 + 2 * c]; const float g63 = fmaxf(m, pm);
            sc_l[128 + 2 * c] = m; sc_l[129 + 2 * c] = g63; m = bl + g63; } }
    __syncthreads();
    if (tid < 64) { const float mi = sc_l[128 + 2 * tid], g63 = sc_l[129 + 2 * tid], pm = sc_l[256 + 2 * tid];
        sc_l[2 * tid] = fexp(mi - g63); sc_l[2 * tid + 1] = fexp(pm - g63); if ((blockIdx.x & 7) == 0) P.MIN[tid * 32 + bh] = mi; }
    __syncthreads();
    f32x4 C = {0.f, 0.f, 0.f, 0.f}, N = {0.f, 0.f, 0.f, 0.f};
    u32x2* lt = (u32x2*)P.LT + e4; f32x4* nt = (f32x4*)P.NT + (e4 & 31);
    constexpr int PD = SCAN_PD;
    u32x2 Lr[PD];
#pragma unroll
    for (int j = 0; j < PD; ++j) Lr[j] = __builtin_nontemporal_load(lt + (size_t)(j * 32 + bh) * 4096);
#pragma unroll 1
    for (int c0 = 0; c0 < 64; c0 += PD) {
#pragma unroll
        for (int j = 0; j < PD; ++j) {
            const int c = c0 + j, tile = c * 32 + bh;
            const float decay = sc_l[2 * c], sc = sc_l[2 * c + 1];
            const f32x4 Lc = {bflo(Lr[j].x), bfhi(Lr[j].x), bflo(Lr[j].y), bfhi(Lr[j].y)};
            if (c + PD < 64) Lr[j] = __builtin_nontemporal_load(lt + (size_t)((c + PD) * 32 + bh) * 4096);
            { u32x2 w; w.x = pk2(C[0], C[1]); w.y = pk2(C[2], C[3]); __builtin_nontemporal_store(w, lt + (size_t)tile * 4096); }
            C = C * decay + Lc * sc;
            if (e4 < 32) { const f32x4 n4 = nt[(size_t)tile * 32]; nt[(size_t)tile * 32] = N; N = N * decay + n4 * sc; }
        }
    }
    __syncthreads();
}

DI void passC(const Ptrs& P, LAS char* lds, int first, int stride) {
    int tid = threadIdx.x; asm volatile("" : "+v"(tid));
    const int lane = tid & 63, wid = __builtin_amdgcn_readfirstlane(tid >> 6), fr = lane & 15, gq = lane >> 4;
    LAS float* fl = (LAS float*)(lds + OF);
    const int tens = wid >> 2, cch = (tid >> 4) & 15, rg = tid & 15, vch = tid >> 5, sp = tid & 31;
    u32x4 xr[7], vv[2]; float lf = 0.f, li = 0.f, mprev = 0.f, nval = 0.f;
#define MLC_LOAD(itn) do { const int bh_ = (itn) & 31, c_ = (itn) >> 5, h_ = bh_ & 3; const size_t R0_ = (size_t)(bh_ >> 2) * SEQ; \
        { const bf16_t* csrc_ = (tens ? P.KM : P.QM) + h_ * 128 + 8 * cch; \
          _Pragma("unroll") for (int rr = 0; rr < 7; ++rr) { const int gr = 64 * c_ + 4 * rg + rr - 3; xr[rr] = (gr >= 0) ? *(const u32x4*)(csrc_ + (R0_ + gr) * 512) : (u32x4){0u, 0u, 0u, 0u}; } \
          const bf16_t* vsrc_ = P.VM + h_ * 128 + 8 * vch; \
          _Pragma("unroll") for (int rr = 0; rr < 2; ++rr) vv[rr] = *(const u32x4*)(vsrc_ + (R0_ + 64 * c_ + 2 * sp + rr) * 512); } \
        lf = P.LOGF[(size_t)bh_ * SEQ + 64 * c_ + lane]; li = P.LOGI[(size_t)bh_ * SEQ + 64 * c_ + lane]; mprev = P.MIN[itn]; \
        if (tid < 128) nval = P.NT[(size_t)(itn) * 128 + tid]; } while (0)
    if (first < 2048) MLC_LOAD(first);
    int par = 0;
    for (int it = first; it < 2048; it += stride, par ^= 1) {
    const int bh = it & 31, c = it >> 5, h = bh & 3; const size_t R0 = (size_t)(bh >> 2) * SEQ;
    const int FN = par ? F_N2 : F_N;
    u32x4 cfr[4];
    { const bf16_t* src = (const bf16_t*)P.LT + (size_t)it * 16384 + (size_t)(wid * 64 + lane) * 32;
#pragma unroll
      for (int ks = 0; ks < 4; ++ks) cfr[ks] = *(const u32x4*)(src + 8 * ks); }
    if (tid < 128) fl[FN + tid] = nval;
    const float nwv = P.nw[h * 128 + 16 * wid + fr];
    const float bc = wave_scan_add(lf);
    const float ag = li - bc; const float pm = wave_scan_max(ag);
    const float gg = fmaxf(mprev, pm);
    if (wid == 0) { fl[F_G + lane] = ag; fl[F_G + 64 + lane] = gg; fl[F_G + 128 + lane] = fexp(mprev - gg); fl[F_G + 192 + lane] = fexp(-(bc + gg)); }
    { const LAS float* cwp = fl + F_CW + h * 1280 + tens * 640 + 8 * cch;
#pragma unroll
      for (int hh = 0; hh < 2; ++hh) { float ov[4][4]; ML_CONV_HALF(hh, cwp, xr, ov);
#pragma unroll
          for (int r = 0; r < 4; ++r) {
#pragma unroll
              for (int e = 0; e < 4; ++e) { const float v = ov[r][e]; ov[r][e] = v * fsigm(v) * (tens ? 0.08838834764831845f : 1.0f); }
              u32x2 w; w.x = pk2(ov[r][0], ov[r][1]); w.y = pk2(ov[r][2], ov[r][3]);
              *(LAS u32x2*)(lds + (tens ? OK : OQ) + (4 * rg + r) * PQ + cch * 16 + 8 * hh) = w; }
          __builtin_amdgcn_sched_barrier(0); }
      float v0[8], v1[8];
      v0[0] = bflo(vv[0].x); v0[1] = bfhi(vv[0].x); v0[2] = bflo(vv[0].y); v0[3] = bfhi(vv[0].y); v0[4] = bflo(vv[0].z); v0[5] = bfhi(vv[0].z); v0[6] = bflo(vv[0].w); v0[7] = bfhi(vv[0].w);
      v1[0] = bflo(vv[1].x); v1[1] = bfhi(vv[1].x); v1[2] = bflo(vv[1].y); v1[3] = bfhi(vv[1].y); v1[4] = bflo(vv[1].z); v1[5] = bfhi(vv[1].z); v1[6] = bflo(vv[1].w); v1[7] = bfhi(vv[1].w);
#pragma unroll
      for (int e = 0; e < 8; ++e) *(LAS unsigned*)(lds + OV + (8 * vch + e) * PS + (2 * sp) * 2) = pk2(v0[e], v1[e]); }
    u32x4 ogp[2];
#pragma unroll
    for (int i = 0; i < 2; ++i) { const int id = tid + 512 * i; ogp[i] = *(const u32x4*)(P.OG + (R0 + 64 * c + (id >> 4)) * 512 + h * 128 + 8 * (id & 15)); }
    if (it + stride < 2048) MLC_LOAD(it + stride);
    __syncthreads();
    {
        const int tt = wid >> 1, sh = wid & 1;
        f32x4 s0 = {0.f, 0.f, 0.f, 0.f}, s1 = {0.f, 0.f, 0.f, 0.f};
#pragma unroll
        for (int ks = 0; ks < 4; ++ks) {
            const bf16x8 a = *(const LAS bf16x8*)(lds + OQ + (16 * tt + fr) * PQ + (32 * ks + 8 * gq) * 2);
            const bf16x8 b0 = *(const LAS bf16x8*)(lds + OK + (32 * sh + fr) * PQ + (32 * ks + 8 * gq) * 2);
            const bf16x8 b1 = *(const LAS bf16x8*)(lds + OK + (32 * sh + 16 + fr) * PQ + (32 * ks + 8 * gq) * 2);
            s0 = __builtin_amdgcn_mfma_f32_16x16x32_bf16(a, b0, s0, 0, 0, 0);
            s1 = __builtin_amdgcn_mfma_f32_16x16x32_bf16(a, b1, s1, 0, 0, 0);
        }
        const int sA = 32 * sh + fr, sB = sA + 16;
        const float aA = fl[F_G + sA], aB = fl[F_G + sB];
#pragma unroll
        for (int rg2 = 0; rg2 < 4; ++rg2) {
            const int t = 16 * tt + 4 * gq + rg2; const float gt = fl[F_G + 64 + t];
            const float pA = (sA <= t) ? s0[rg2] * fexp(aA - gt) : 0.f, pB = (sB <= t) ? s1[rg2] * fexp(aB - gt) : 0.f;
            *(LAS bf16_t*)(lds + OP + t * PS + sA * 2) = (bf16_t)(pk2(pA, 0.f) & 0xffffu);
            *(LAS bf16_t*)(lds + OP + t * PS + sB * 2) = (bf16_t)(pk2(pB, 0.f) & 0xffffu);
            const float rs = row_scan_add(pA + pB);
            if (fr == 15) fl[F_RSP + sh * 64 + t] = rs;
        }
        const int tq = tid >> 3, kseg = tid & 7;
        const u32x4 qa = *(const LAS u32x4*)(lds + OQ + tq * PQ + kseg * 32), qb2 = *(const LAS u32x4*)(lds + OQ + tq * PQ + kseg * 32 + 16);
        const LAS float* np = fl + FN + 16 * kseg;
        float d = bflo(qa.x) * np[0] + bfhi(qa.x) * np[1] + bflo(qa.y) * np[2] + bfhi(qa.y) * np[3] + bflo(qa.z) * np[4] + bfhi(qa.z) * np[5] + bflo(qa.w) * np[6] + bfhi(qa.w) * np[7]
                + bflo(qb2.x) * np[8] + bfhi(qb2.x) * np[9] + bflo(qb2.y) * np[10] + bfhi(qb2.y) * np[11] + bflo(qb2.z) * np[12] + bfhi(qb2.z) * np[13] + bflo(qb2.w) * np[14] + bfhi(qb2.w) * np[15];
        d = row_scan_add8(d);
        if (kseg == 7) fl[F_QN + tq] = d;
    }
    __syncthreads();
    f32x4 y[4];
#pragma unroll
    for (int tt = 0; tt < 4; ++tt) y[tt] = (f32x4){0.f, 0.f, 0.f, 0.f};
#pragma unroll
    for (int ks = 0; ks < 4; ++ks) {
        const bf16x8 bfr = __builtin_bit_cast(bf16x8, cfr[ks]);
#pragma unroll
        for (int tt = 0; tt < 4; ++tt) {
            const u32x2 a0 = *(const LAS u32x2*)(lds + OQ + (16 * tt + fr) * PQ + (32 * ks + 4 * gq) * 2), a1 = *(const LAS u32x2*)(lds + OQ + (16 * tt + fr) * PQ + (32 * ks + 16 + 4 * gq) * 2);
            const u32x4 aw = {a0.x, a0.y, a1.x, a1.y};
            y[tt] = __builtin_amdgcn_mfma_f32_16x16x32_bf16(__builtin_bit_cast(bf16x8, aw), bfr, y[tt], 0, 0, 0);
        }
        __builtin_amdgcn_sched_barrier(0);
    }
#pragma unroll
    for (int tt = 0; tt < 4; ++tt)
#pragma unroll
        for (int rg2 = 0; rg2 < 4; ++rg2) { const int t = 16 * tt + 4 * gq + rg2; y[tt][rg2] *= fl[F_G + 128 + t]; }
#pragma unroll
    for (int k2 = 0; k2 < 2; ++k2) {
        const bf16x8 bv = *(const LAS bf16x8*)(lds + OV + (16 * wid + fr) * PS + (32 * k2 + 8 * gq) * 2);
#pragma unroll
        for (int tt = 0; tt < 4; ++tt) { const bf16x8 a = *(const LAS bf16x8*)(lds + OP + (16 * tt + fr) * PS + (32 * k2 + 8 * gq) * 2);
            y[tt] = __builtin_amdgcn_mfma_f32_16x16x32_bf16(a, bv, y[tt], 0, 0, 0); }
        __builtin_amdgcn_sched_barrier(0);
    }
    { const float den = fl[F_RSP + lane] + fl[F_RSP + 64 + lane] + fl[F_G + 128 + lane] * fl[F_QN + lane];
      fl[F_RS + wid * 64 + lane] = __builtin_amdgcn_rcpf(fmaxf(fabsf(den), fl[F_G + 192 + lane]));
      asm volatile("s_waitcnt lgkmcnt(0)" ::: "memory"); }
#pragma unroll
    for (int tt = 0; tt < 4; ++tt)
#pragma unroll
        for (int rg2 = 0; rg2 < 4; ++rg2) { const int t = 16 * tt + 4 * gq + rg2;
            const float hv = y[tt][rg2] * fl[F_RS + wid * 64 + t]; y[tt][rg2] = hv;
            const float sq = row_scan_add(hv * hv);
            if (fr == 15) fl[F_SSQ + wid * 64 + t] = sq; }
    __syncthreads();
    { float tot = 0.f;
#pragma unroll
      for (int w = 0; w < 8; ++w) tot += fl[F_SSQ + w * 64 + lane];
      fl[F_RS + wid * 64 + lane] = __builtin_amdgcn_rsqf(tot * (1.0f / 128.0f) + REPS);
      asm volatile("s_waitcnt lgkmcnt(0)" ::: "memory"); }
#pragma unroll
    for (int tt = 0; tt < 4; ++tt)
#pragma unroll
        for (int rg2 = 0; rg2 < 4; ++rg2) { const int t = 16 * tt + 4 * gq + rg2;
            const float ov = y[tt][rg2] * fl[F_RS + wid * 64 + t] * nwv;
            *(LAS bf16_t*)(lds + OH + t * PQ + (16 * wid + fr) * 2) = (bf16_t)(pk2(ov, 0.f) & 0xffffu); }
    __syncthreads();
#pragma unroll
    for (int i = 0; i < 2; ++i) { const int id = tid + 512 * i, row = id >> 4, ch = id & 15;
        const u32x4 hv4 = *(const LAS u32x4*)(lds + OH + row * PQ + ch * 16);
        u32x4 o4; o4.x = pk2(bflo(hv4.x) * bflo(ogp[i].x), bfhi(hv4.x) * bfhi(ogp[i].x)); o4.y = pk2(bflo(hv4.y) * bflo(ogp[i].y), bfhi(hv4.y) * bfhi(ogp[i].y));
        o4.z = pk2(bflo(hv4.z) * bflo(ogp[i].z), bfhi(hv4.z) * bfhi(ogp[i].z)); o4.w = pk2(bflo(hv4.w) * bflo(ogp[i].w), bfhi(hv4.w) * bfhi(ogp[i].w));
        *(u32x4*)(P.HMD + (R0 + 64 * c + row) * 1024 + h * 128 + 8 * ch) = o4; }
    __syncthreads();
    }
#undef MLC_LOAD
}
#undef ML_CONV_HALF
}
constexpr int NWAVES = 8, LDS_BYTES = 147456, RING_BYTES = 131072, MISC_OFF = RING_BYTES + 320, PREF_OFF = RING_BYTES + 1024;
#define RLX_AGENT __ATOMIC_RELAXED, __HIP_MEMORY_SCOPE_AGENT
#define XB_TMO      128
#define XB_XCNT(j)  (256  + 64 * (j))
#define XB_XSUB(j)  (1280 + 64 * (j))
#define XB_XGEN(j)  (2304 + 64 * (j))
#define XB_TOP      3328
#define XB_TOPGEN   3392
#define XCD_BAR_WORDS 3456
#define XB_SPIN_CAP (1u << 18)
DI unsigned xb_ld(unsigned* p)              { return __hip_atomic_load(p, __ATOMIC_RELAXED, __HIP_MEMORY_SCOPE_AGENT); }
DI unsigned xb_add(unsigned* p, unsigned v) { return __hip_atomic_fetch_add(p, v, __ATOMIC_RELAXED, __HIP_MEMORY_SCOPE_AGENT); }
DI unsigned xb_xcc_id() { return (unsigned)__builtin_amdgcn_s_getreg((3 << 11) | 20) & 0xFu; }
#define XB_SPIN(cond, bar) do { unsigned _sp = 0; while (cond) { __builtin_amdgcn_s_sleep(10); \
    if ((++_sp & 255u) == 0u) { if (xb_ld(&(bar)[XB_TMO])) break; if (_sp > XB_SPIN_CAP) { atomicAdd(&(bar)[XB_TMO], 1u); break; } } } } while (0)
struct XcdBarrier { unsigned* bar; unsigned x; volatile LAS unsigned* st; };
DI XcdBarrier xcd_barrier_post(unsigned* bar, volatile LAS unsigned* st) {
    XcdBarrier b; b.bar = bar; b.x = xb_xcc_id(); b.st = st;
    if (threadIdx.x == 0) (void)xb_add(&bar[XB_XCNT(b.x)], 1u);
    return b;
}
DI void xcd_barrier_complete(unsigned* bar, unsigned x, unsigned& nloc, unsigned& nx) {
    const unsigned G = gridDim.x * gridDim.y * gridDim.z;
    unsigned sum, cnt, mine, sp = 0u;
    for (;;) {
        sum = 0u; cnt = 0u; mine = 0u;
#pragma unroll
        for (unsigned j = 0; j < 16; ++j) { const unsigned c = xb_ld(&bar[XB_XCNT(j)]); sum += c; cnt += (c > 0u) ? 1u : 0u; mine = (j == x) ? c : mine; }
        if (sum == G) break;
        __builtin_amdgcn_s_sleep(1);
        if ((++sp & 255u) == 0u) { if (xb_ld(&bar[XB_TMO])) break; if (sp > XB_SPIN_CAP) { atomicAdd(&bar[XB_TMO], 1u); break; } }
    }
    nloc = mine > 0u ? mine : 1u; nx = cnt > 0u ? cnt : 1u;
}
DI void xcd_barrier(const XcdBarrier& b) {
    asm volatile("s_waitcnt vmcnt(0)" ::: "memory");
    __syncthreads();
    if (threadIdx.x == 0) {
        unsigned* bar = b.bar;
        __builtin_amdgcn_s_waitcnt(0);
        unsigned nloc = b.st[0], nx = b.st[1];
        if (nloc == 0u) { xcd_barrier_complete(bar, b.x, nloc, nx); b.st[0] = nloc; b.st[1] = nx; }
        const unsigned old = xb_add(&bar[XB_XSUB(b.x)], 1u);
        const unsigned gen = old / nloc;
        if (old + 1u == (gen + 1u) * nloc) {
            __builtin_amdgcn_fence(__ATOMIC_RELEASE, "agent");
            asm volatile("s_waitcnt vmcnt(0)" ::: "memory");
            const unsigned og = xb_add(&bar[XB_TOP], 1u);
            const unsigned tg = og / nx;
            if (og + 1u == (tg + 1u) * nx) xb_add(&bar[XB_TOPGEN], 1u);
            else XB_SPIN(xb_ld(&bar[XB_TOPGEN]) == tg, bar);
            __builtin_amdgcn_fence(__ATOMIC_ACQUIRE, "agent");
            xb_add(&bar[XB_XGEN(b.x)], 1u);
            asm volatile("s_waitcnt vmcnt(0)" ::: "memory");
        } else {
            XB_SPIN(xb_ld(&bar[XB_XGEN(b.x)]) == gen, bar);
            __builtin_amdgcn_fence(__ATOMIC_ACQUIRE, "agent");
            asm volatile("s_waitcnt vmcnt(0)" ::: "memory");
        }
    }
    __syncthreads();
}

struct Args { const void* in[30]; float* out; unsigned char* ws; float freq[8]; int ph_lo, ph_hi; };

DI float wave_sum(float v) {
    v += __builtin_bit_cast(float, __builtin_amdgcn_update_dpp(0, __builtin_bit_cast(int, v), 0x111, 0xf, 0xf, true));
    v += __builtin_bit_cast(float, __builtin_amdgcn_update_dpp(0, __builtin_bit_cast(int, v), 0x112, 0xf, 0xf, true));
    v += __builtin_bit_cast(float, __builtin_amdgcn_update_dpp(0, __builtin_bit_cast(int, v), 0x114, 0xf, 0xf, true));
    v += __builtin_bit_cast(float, __builtin_amdgcn_update_dpp(0, __builtin_bit_cast(int, v), 0x118, 0xf, 0xf, true));
    v += __builtin_bit_cast(float, __builtin_amdgcn_update_dpp(0, __builtin_bit_cast(int, v), 0x142, 0xa, 0xf, false));
    v += __builtin_bit_cast(float, __builtin_amdgcn_update_dpp(0, __builtin_bit_cast(int, v), 0x143, 0xc, 0xf, false));
    return __builtin_bit_cast(float, __builtin_amdgcn_readlane(__builtin_bit_cast(int, v), 63));
}
DI float logsigf(float x) { return fminf(x, 0.f) - __logf(1.f + __expf(-fabsf(x))); }

DI void tr_item_v4(const float* W, int ldw, int col0, bf16_t* WT, int ldk, int koff, int n0, int k0, LAS float* scr, int lane, int ca = 8, int cb = 4) {
    const int c4 = 4 * (lane & 7), r8 = lane >> 3, cs = col0 + ca * ((lane & 7) >> 1) + cb * (lane & 1); f32x4 wv[8];
#pragma unroll
    for (int i = 0; i < 8; ++i) wv[i] = __builtin_nontemporal_load((const f32x4*)(W + (size_t)(k0 + 8 * i + r8) * ldw + cs));
#pragma unroll
    for (int i = 0; i < 8; ++i) { LAS float* d = scr + (8 * i + r8) * 33 + c4; d[0] = wv[i][0]; d[1] = wv[i][1]; d[2] = wv[i][2]; d[3] = wv[i][3]; }
    asm volatile("s_waitcnt lgkmcnt(0)" ::: "memory");
    const int c = lane & 7;
#pragma unroll
    for (int j = 0; j < 4; ++j) { const int n = (lane >> 3) + 8 * j; const LAS float* s = scr + (8 * c) * 33 + n;
        u32x4 o; o.x = pk2(s[0 * 33], s[1 * 33]); o.y = pk2(s[2 * 33], s[3 * 33]); o.z = pk2(s[4 * 33], s[5 * 33]); o.w = pk2(s[6 * 33], s[7 * 33]);
        *(u32x4*)(WT + (size_t)(n0 + n) * ldk + koff + k0 + 8 * c) = o; }
    asm volatile("s_waitcnt lgkmcnt(0)" ::: "memory");
}
DI void tr_item(const float* W, int ldw, int col, bf16_t* WT, int ldk, int koff, int n0, int k0, LAS float* scr, int lane) {
#pragma unroll 8
    for (int i = 0; i < 32; ++i) { const int kk = 2 * i + (lane >> 5); scr[kk * 33 + (lane & 31)] = W[(size_t)(k0 + kk) * ldw + col]; }
    asm volatile("s_waitcnt lgkmcnt(0)" ::: "memory");
    const int c = lane & 7;
#pragma unroll
    for (int j = 0; j < 4; ++j) { const int n = (lane >> 3) + 8 * j; const LAS float* s = scr + (8 * c) * 33 + n;
        u32x4 o; o.x = pk2(s[0 * 33], s[1 * 33]); o.y = pk2(s[2 * 33], s[3 * 33]); o.z = pk2(s[4 * 33], s[5 * 33]); o.w = pk2(s[6 * 33], s[7 * 33]);
        *(u32x4*)(WT + (size_t)(n0 + n) * ldk + koff + k0 + 8 * c) = o; }
    asm volatile("s_waitcnt lgkmcnt(0)" ::: "memory");
}

DI unsigned pk4_fp8(float a, float b, float c, float d) { unsigned w = 0; w = __builtin_amdgcn_cvt_pk_fp8_f32(a, b, w, false); w = __builtin_amdgcn_cvt_pk_fp8_f32(c, d, w, true); return w; }
DI void tr_item_fp8_v4(const float* W, int ldw, int csrc, unsigned char* WT, int ldk, int n0, int k0, float sc, LAS float* scr, int lane) {
    const int c4 = 4 * (lane & 7), r8 = lane >> 3; f32x4 wv[8];
#pragma unroll
    for (int i = 0; i < 8; ++i) wv[i] = __builtin_nontemporal_load((const f32x4*)(W + (size_t)(k0 + 8 * i + r8) * ldw + csrc));
#pragma unroll
    for (int i = 0; i < 8; ++i) { LAS float* d = scr + (8 * i + r8) * 33 + c4; d[0] = wv[i][0] * sc; d[1] = wv[i][1] * sc; d[2] = wv[i][2] * sc; d[3] = wv[i][3] * sc; }
    asm volatile("s_waitcnt lgkmcnt(0)" ::: "memory");
    const int c = lane & 7;
#pragma unroll
    for (int j = 0; j < 4; ++j) { const int n = (lane >> 3) + 8 * j; const LAS float* s = scr + (8 * c) * 33 + n;
        u32x2 o; o.x = pk4_fp8(s[0 * 33], s[1 * 33], s[2 * 33], s[3 * 33]); o.y = pk4_fp8(s[4 * 33], s[5 * 33], s[6 * 33], s[7 * 33]);
        *(u32x2*)(WT + (size_t)(n0 + n) * ldk + k0 + 8 * c) = o; }
    asm volatile("s_waitcnt lgkmcnt(0)" ::: "memory");
}
DI void tr_item_fp8(const float* W, int ldw, int col, unsigned char* WT, int ldk, int n0, int k0, float sc, LAS float* scr, int lane) {
#pragma unroll 8
    for (int i = 0; i < 32; ++i) { const int kk = 2 * i + (lane >> 5); scr[kk * 33 + (lane & 31)] = W[(size_t)(k0 + kk) * ldw + col] * sc; }
    asm volatile("s_waitcnt lgkmcnt(0)" ::: "memory");
    const int c = lane & 7;
#pragma unroll
    for (int j = 0; j < 4; ++j) { const int n = (lane >> 3) + 8 * j; const LAS float* s = scr + (8 * c) * 33 + n;
        u32x2 o; o.x = pk4_fp8(s[0 * 33], s[1 * 33], s[2 * 33], s[3 * 33]); o.y = pk4_fp8(s[4 * 33], s[5 * 33], s[6 * 33], s[7 * 33]);
        *(u32x2*)(WT + (size_t)(n0 + n) * ldk + k0 + 8 * c) = o; }
    asm volatile("s_waitcnt lgkmcnt(0)" ::: "memory");
}

DI void p0_prologue(const Args& a, LAS unsigned char* lds, int tid, int lane, int wave) {
    unsigned char* ws = a.ws;
    const int gw = blockIdx.x * NWAVES + wave, NGW = gridDim.x * NWAVES;
    const float* w_in = (const float*)a.in[6];
    {
        LAS float* cl = (LAS float*)(lds + 69632);
        const float* c = (const float*)a.in[1];
        { float cv[16];
#pragma unroll
          for (int k = 0; k < 16; ++k) cv[k] = c[tid + 512 * k];
#pragma unroll
          for (int k = 0; k < 16; ++k) cl[tid + 512 * k] = cv[k]; }
        __syncthreads();
        if (wave >= 6) {
            const int i = (int)blockIdx.x * 128 + (wave - 6) * 64 + lane;
            { bf16_t* wr = (bf16_t*)(ws + WS_WR); const float* w_re = (const float*)a.in[25]; const float* w_rg = (const float*)a.in[23];
              const int n = i >> 7, k8 = (i & 127) * 8; float v[8];
#pragma unroll
              for (int j = 0; j < 8; ++j) v[j] = (n < 32) ? w_re[(k8 + j) * 32 + n] : (n >= 128 && n < 132) ? w_rg[(k8 + j) * 4 + (n - 128)] : 0.f;
              u32x4 o; o.x = pk2(v[0], v[1]); o.y = pk2(v[2], v[3]); o.z = pk2(v[4], v[5]); o.w = pk2(v[6], v[7]); *(u32x4*)(wr + (size_t)n * 1024 + k8) = o; }
            if ((i & 3) == 0) { const int i2 = i >> 2; ((float*)(ws + WS_WG8))[i2] = w_in[(size_t)(i2 & 1023) * 5640 + 2048 + (i2 >> 10)]; }
        }
        const int it = wave * 256 + (int)blockIdx.x;
        if (it < 1536) {
            const float* w_ada = (const float*)a.in[3]; const float* b_ada = (const float*)a.in[4];
            const int cg = it % 384, ks = it / 384, c4 = lane & 3, kr = lane >> 2, col = 16 * cg + 4 * c4;
            f32x4 s[8], wv[16];
#pragma unroll
            for (int b = 0; b < 8; ++b) s[b] = (f32x4){0.f, 0.f, 0.f, 0.f};
            const float* wp = w_ada + (size_t)(256 * ks + kr) * 6144 + col;
#pragma unroll
            for (int i = 0; i < 16; ++i) wv[i] = __builtin_nontemporal_load((const f32x4*)(wp + (size_t)(16 * i) * 6144));
            __builtin_amdgcn_sched_barrier(0);
#pragma unroll
            for (int i = 0; i < 16; ++i) { const int k = 256 * ks + 16 * i + kr;
#pragma unroll
                for (int b = 0; b < 8; ++b) s[b] += wv[i] * cl[b * 1024 + k];
                if ((i & 3) == 3) __builtin_amdgcn_sched_barrier(0); }
#pragma unroll
            for (int b = 0; b < 8; ++b)
#pragma unroll
                for (int e = 0; e < 4; ++e) { float v = s[b][e]; v += __shfl_xor(v, 4); v += __shfl_xor(v, 8); v += __shfl_xor(v, 16); v += __shfl_xor(v, 32); s[b][e] = v; }
            if (kr == 0) { f32x4 bb = {0.f, 0.f, 0.f, 0.f}; if (ks == 0) bb = *(const f32x4*)(b_ada + col);
                float* mp = (float*)(ws + WS_MODP) + (size_t)ks * 49152;
#pragma unroll
                for (int b = 0; b < 8; ++b) *(f32x4*)(mp + b * 6144 + col) = s[b] + bb; }
        }
    }
    LAS float* scr = (LAS float*)(lds + wave * 8448);
    constexpr int I_IN = 16 * 176, I_BR = 8 * 32, I_OUT = 16 * 32;
    constexpr int NITEMS = I_IN + 2 * I_BR + I_OUT;
    for (int it = gw; it < NITEMS; it += NGW) {
        int r = it;
        if (r < I_IN) { const int kb = r / 176, nb = r % 176;
            tr_item_fp8_v4(w_in, 5640, win_col(32 * nb + 4 * (lane & 7)), (unsigned char*)(ws + WS_WIN), 1024, 32 * nb, 64 * kb, 32.0f, scr, lane);
            continue; } r -= I_IN;
        if (r < I_BR) { const int kb = r / 32, nb = r % 32; tr_item_v4((const float*)a.in[19], 1024, 32 * nb, (bf16_t*)(ws + WS_WBR), 1024, 0, 32 * nb, 64 * kb, scr, lane); continue; } r -= I_BR;
        if (r < I_BR) { const int kb = r / 32, nb = r % 32; tr_item_v4((const float*)a.in[20], 1024, 32 * nb, (bf16_t*)(ws + WS_WBR), 1024, 512, 32 * nb, 64 * kb, scr, lane); continue; } r -= I_BR;
        { const int kb = r / 32, nb = r % 32; tr_item_fp8_v4((const float*)a.in[21], 1024, 32 * nb + 4 * (lane & 7), (unsigned char*)(ws + WS_WOUT), 1024, 32 * nb, 64 * kb, 32.0f, scr, lane); }
    }
    const int gt = blockIdx.x * (NWAVES * 64) + tid, NGT = gridDim.x * NWAVES * 64;
    { float* cs = (float*)(ws + WS_CS); const int* pos = (const int*)a.in[2];
      for (int i = gt; i < MTOK * 8; i += NGT) { const int row = i >> 3, f = i & 7; const float ang = (float)pos[row] * a.freq[f];
          double rv = (double)ang * 0.15915494309189535; rv -= rint(rv); const float ar = (float)(rv * 6.283185307179586);
          cs[(size_t)row * 16 + f] = cosf(ar); cs[(size_t)row * 16 + 8 + f] = sinf(ar); } }
}
DI void p_convert_experts(const Args& a, LAS unsigned char* lds, int lane, int wave, int gw, int ngw) {
    unsigned char* ws = a.ws;
    LAS float* scr = (LAS float*)(lds + wave * 8448);
    constexpr int I_GU = 32 * 256, I_D = 32 * 128;
    for (int it = gw; it < I_GU + I_D; it += ngw) {
        int r = it;
        if (r < I_GU) { const int e = r >> 8, q = r & 255, kb = q >> 4, nb = q & 15;
            const float* src = (const float*)a.in[((nb >> 2) & 1) ? 28 : 27] + (size_t)e * 1024 * 256;
            tr_item_v4(src, 256, 128 * (nb >> 3) + 32 * (nb & 3), (bf16_t*)(ws + WS_WGU) + (size_t)e * 512 * 1024, 1024, 0, 32 * nb, 64 * kb, scr, lane); continue; } r -= I_GU;
        { const int e = r >> 7, q = r & 127, kb = q >> 5, nb = q & 31;
            const int nrow = 32 * nb + (lane & 31);
            tr_item((const float*)a.in[29] + (size_t)e * 256 * 1024, 1024, (nrow & ~255) + wd_col(nrow & 255), (bf16_t*)(ws + WS_WD) + (size_t)e * 1024 * 256, 256, 0, 32 * nb, 64 * kb, scr, lane); }
    }
}

#ifndef MN_ROT
#define MN_ROT 0
#endif
template <bool GATES>
DI void p_modnorm(const float* xin, const float* nw, const float* scale, const float* shift, bf16_t* outp, const Args& a, LAS unsigned char* lds, int tid, int lane, int wave) {
    LAS float* wg = (LAS float*)lds;
    if (GATES) { const float* wg8 = (const float*)(a.ws + WS_WG8); float gv_[16];
#pragma unroll
        for (int k = 0; k < 16; ++k) gv_[k] = wg8[tid + 512 * k];
#pragma unroll
        for (int k = 0; k < 16; ++k) wg[tid + 512 * k] = gv_[k];
        __syncthreads(); }
    const int gw = ((((int)blockIdx.x & 7) << 5) | ((int)blockIdx.x >> 3)) * NWAVES + wave;
    const int row0 = gw * 16, b = row0 >> 12;
    f32x4 A[4], Sh[4];
    if (GATES) {
        const float* mp = (const float*)(a.ws + WS_MODP);
        if (tid < 192) { const int idx = (int)blockIdx.x * 192 + tid; ((float*)(a.ws + WS_MOD))[idx] = ((mp[idx] + mp[49152 + idx]) + mp[2 * 49152 + idx]) + mp[3 * 49152 + idx]; }
#pragma unroll
        for (int j = 0; j < 4; ++j) { const int c = 4 * lane + 256 * j; const f32x4 w = *(const f32x4*)(nw + c);
            const float* ps = mp + b * 6144 + 1024 + c; const float* ph = mp + b * 6144 + c;
            const f32x4 sc = ((*(const f32x4*)ps + *(const f32x4*)(ps + 49152)) + *(const f32x4*)(ps + 2 * 49152)) + *(const f32x4*)(ps + 3 * 49152);
            Sh[j] = ((*(const f32x4*)ph + *(const f32x4*)(ph + 49152)) + *(const f32x4*)(ph + 2 * 49152)) + *(const f32x4*)(ph + 3 * 49152);
            A[j] = w * (sc + 1.0f); }
    } else {
#pragma unroll
        for (int j = 0; j < 4; ++j) { const int c = 4 * lane + 256 * j; const f32x4 w = *(const f32x4*)(nw + c), sc = *(const f32x4*)(scale + b * 6144 + c); A[j] = w * (sc + 1.0f); Sh[j] = *(const f32x4*)(shift + b * 6144 + c); }
    }
#define MN_LOAD(VN, TN, r_) do { const int rr_ = row0 + (((r_) + rot) & 15); _Pragma("unroll") for (int j = 0; j < 4; ++j) { if (GATES) VN[j] = __builtin_nontemporal_load((const f32x4*)(xin + (size_t)rr_ * 1024 + 4 * lane + 256 * j)); \
            else TN[j] = __builtin_nontemporal_load((const u32x2*)((const bf16_t*)(a.ws + WS_X1B) + (size_t)rr_ * 1024 + 4 * lane + 256 * j)); } __builtin_amdgcn_sched_barrier(0); } while (0)
    const int rot = MN_ROT ? (gw & 15) : 0;
    float gbias = 0.f;
    if (GATES) gbias = (lane & 4) ? ((const float*)a.in[8])[lane & 3] : ((const float*)a.in[7])[lane & 3];
    auto do_row = [&](const f32x4 (&vn)[4], const u32x2 (&tn)[4], const int r) __attribute__((always_inline)) {
        const int row = row0 + ((r + rot) & 15);
        f32x4 v[4]; float ss = 0.f;
#pragma unroll
        for (int j = 0; j < 4; ++j) {
            if (GATES) { v[j] = vn[j];
                u32x2 xb; xb.x = pk2(v[j][0], v[j][1]); xb.y = pk2(v[j][2], v[j][3]); __builtin_nontemporal_store(xb, (u32x2*)((bf16_t*)(a.out + 16777216) + (size_t)row * 1024 + 4 * lane + 256 * j)); }
            else { const u32x2 t2 = tn[j]; v[j][0] = bflo(t2.x); v[j][1] = bfhi(t2.x); v[j][2] = bflo(t2.y); v[j][3] = bfhi(t2.y); }
            const f32x4 q = v[j] * v[j]; ss += (q[0] + q[1]) + (q[2] + q[3]); }
        const float rstd = __builtin_amdgcn_rsqf(wave_sum(ss) * (1.0f / 1024.0f) + REPS);
#pragma unroll
        for (int j = 0; j < 4; ++j) { v[j] = v[j] * rstd * A[j] + Sh[j];
            if (GATES) *(unsigned*)((unsigned char*)outp + (size_t)row * 1024 + 4 * lane + 256 * j) = pk4_fp8(v[j][0], v[j][1], v[j][2], v[j][3]);
            else { u32x2 o; o.x = pk2(v[j][0], v[j][1]); o.y = pk2(v[j][2], v[j][3]); *(u32x2*)(outp + (size_t)row * 1024 + 4 * lane + 256 * j) = o; } }
        if (GATES) {
            float gd[8];
#pragma unroll
            for (int g = 0; g < 8; ++g) { float d = 0.f;
#pragma unroll
                for (int j = 0; j < 4; ++j) { const f32x4 w = *(const LAS f32x4*)(wg + g * 1024 + 4 * lane + 256 * j); const f32x4 p = v[j] * w; d += (p[0] + p[1]) + (p[2] + p[3]); }
                gd[g] = wave_sum(d); __builtin_amdgcn_sched_barrier(0); }
            if (lane < 8) { float val = 0.f;
#pragma unroll
                for (int g = 0; g < 8; ++g) val = (lane == g) ? gd[g] : val;
                const int hh = lane & 3, s = row & 4095;
                if (lane < 4) ((float*)(a.ws + WS_LOGI))[(size_t)(b * 4 + hh) * SEQ + s] = val + gbias;
                else ((float*)(a.ws + WS_LOGF))[(size_t)(b * 4 + hh) * SEQ + s] = logsigf(val + gbias); }
        }
        __builtin_amdgcn_sched_barrier(0);
    };
    f32x4 vA[4], vB[4], vC[4], vD[4]; u32x2 tA[4], tB[4], tC[4], tD[4];
#pragma unroll
    for (int j = 0; j < 4; ++j) { tA[j] = (u32x2){0u, 0u}; tB[j] = tA[j]; tC[j] = tA[j]; tD[j] = tA[j]; vA[j] = (f32x4){0.f, 0.f, 0.f, 0.f}; vB[j] = vA[j]; vC[j] = vA[j]; vD[j] = vA[j]; }
    MN_LOAD(vA, tA, 0); MN_LOAD(vB, tB, 1); MN_LOAD(vC, tC, 2); MN_LOAD(vD, tD, 3);
#pragma unroll 1
    for (int r = 0; r < 16; r += 4) {
        const bool more = r + 4 < 16;
        do_row(vA, tA, r);     if (more) MN_LOAD(vA, tA, r + 4);
        do_row(vB, tB, r + 1); if (more) MN_LOAD(vB, tB, r + 5);
        do_row(vC, tC, r + 2); if (more) MN_LOAD(vC, tC, r + 6);
        do_row(vD, tD, r + 3); if (more) MN_LOAD(vD, tD, r + 7);
    }
#undef MN_LOAD
}

__global__ void __launch_bounds__(NWAVES * 64, 2) fwd_kernel(Args args) {
    extern __shared__ __attribute__((aligned(16))) unsigned char lds_raw[];
    LAS unsigned char* lds = (LAS unsigned char*)lds_raw;
    volatile LAS unsigned* MISC = (volatile LAS unsigned*)(lds + MISC_OFF);
    const int tid = threadIdx.x, lane = tid & 63, wave = __builtin_amdgcn_readfirstlane(tid >> 6), G = gridDim.x;
    unsigned char* ws = args.ws;
    unsigned* ctl = (unsigned*)(ws + WS_CTL);
    for (int u = tid; u < (LDS_BYTES - RING_BYTES) / 4; u += NWAVES * 64) ((LAS unsigned*)(lds + RING_BYTES))[u] = 0u;
    __syncthreads();
    XcdBarrier bar = xcd_barrier_post(ctl + CW_BAR, MISC + 8);
    const int lo = args.ph_lo, hi = args.ph_hi;
#ifdef ONLY_PHASE
#define IN(k) ((k) == ONLY_PHASE && lo <= (k) && (k) < hi)
#else
#define IN(k) (lo <= (k) && (k) < hi)
#endif
#ifdef STAMP_SEL
#define STAMP(k) do { if (blockIdx.x == 0 && tid == 0) { const unsigned long long t_ = __builtin_amdgcn_s_memrealtime(); MISC[32 + 2 * (k)] = (unsigned)t_; MISC[33 + 2 * (k)] = (unsigned)(t_ >> 32); } } while (0)
#else
#define STAMP(k) do {} while (0)
#endif
#define SEAM(k) do { if (IN(k) && IN((k) + 1)) xcd_barrier(bar); STAMP((k) + 1); } while (0)
    float* mod = (float*)(ws + WS_MOD);
    bf16_t* R1 = (bf16_t*)(ws + WS_R1);
    STAMP(0);
    if (IN(0)) { p0_prologue(args, lds, tid, lane, wave); SEAM(0); }
    if (IN(1)) { p_modnorm<true>((const float*)args.in[0], (const float*)args.in[5], mod + 1024, mod, R1, args, lds, tid, lane, wave); SEAM(1); }
    if (IN(2)) {
        pg8::Gemm g{R1, (const bf16_t*)(ws + WS_WIN), 1024, 0, 0};     pg8::StaticOrder S; S.init(MTOK, NIN, G, (int)blockIdx.x);
        EpiInProj E{(bf16_t*)(ws + WS_QM), (bf16_t*)(ws + WS_KM), (bf16_t*)(ws + WS_VM), (bf16_t*)(ws + WS_OG), (bf16_t*)(ws + WS_QD), (bf16_t*)(ws + WS_KD), (bf16_t*)(ws + WS_VD),
                    (bf16_t*)(ws + WS_GM), (bf16_t*)(ws + WS_GD), (const float*)(ws + WS_CS), (const float*)args.in[12], (const float*)args.in[13]};
        pg8::gemm_phase<EpiInProj, pg8::StaticOrder, true, false, true>(lds, g, S, E);
        SEAM(2);
    }
    if (IN(3)) {
        if (tid < 64) { const float *q1 = (const float*)args.in[14], *k1 = (const float*)args.in[15], *q2 = (const float*)args.in[16], *k2 = (const float*)args.in[17];
            const float s1 = wave_sum(q1[tid] * k1[tid]), s2 = wave_sum(q2[tid] * k2[tid]);
            if (tid == 0) MISC[2] = __float_as_uint(__expf(s1) - __expf(s2) + 0.2f); }
        __syncthreads();
        const float lam = __uint_as_float(MISC[2]);
        ml::Ptrs MP{(const bf16_t*)(ws + WS_QM), (const bf16_t*)(ws + WS_KM), (const bf16_t*)(ws + WS_VM), (const bf16_t*)(ws + WS_OG), (const float*)(ws + WS_LOGI), (const float*)(ws + WS_LOGF),
                    (const float*)args.in[9], (const float*)args.in[10], (const float*)args.in[11], R1, args.out, (float*)(ws + WS_NT), (float*)(ws + WS_SC), (float*)(ws + WS_MIN)};
        ml::passA(MP, (LAS char*)lds, (int)blockIdx.x, G);
        xcd_barrier(bar); STAMP(12);
        ml::passB(MP, (LAS char*)lds, tid);
#ifdef STAMP_SEL
        if (blockIdx.x == 32 && tid == 0) { const unsigned long long t_ = __builtin_amdgcn_s_memrealtime(); ctl[CW_ERR + 58] = (unsigned)t_; ctl[CW_ERR + 59] = (unsigned)(t_ >> 32); }
#endif
        if (tid < 128) ((LAS float*)(lds + att::OFF_SUBW))[tid] = ((const float*)args.in[18])[tid];
        {
            const int x = blockIdx.x & 7, j = (int)blockIdx.x >> 3;
#pragma unroll 1
            for (int u = 0; u < 4; ++u) { const int bh = 4 * x + u, qb = (u & 1) ? j : 31 - j;
                att::unit(bh >> 2, bh & 3, qb, (const bf16_t*)(ws + WS_QD), (const bf16_t*)(ws + WS_KD), (const bf16_t*)(ws + WS_VD), R1, lam, (const float*)args.in[18], (LAS char*)lds); }
        }
#ifdef STAMP_SEL
        if (blockIdx.x == 32 && tid == 0) { const unsigned long long t_ = __builtin_amdgcn_s_memrealtime(); ctl[CW_ERR + 62] = (unsigned)t_; ctl[CW_ERR + 63] = (unsigned)(t_ >> 32); }
#endif
        xcd_barrier(bar); STAMP(14);
        ml::load_taps(MP, (LAS float*)(lds + ml::OF), tid);
        __syncthreads();
        ml::passC(MP, (LAS char*)lds, (int)blockIdx.x, G);
#ifdef ATT_PROBE
        if (blockIdx.x == 32 && tid == 0) { ctl[CW_ERR + 60] = MISC[4]; ctl[CW_ERR + 61] = MISC[5]; }
#endif
        SEAM(3);
    }
    if (IN(4)) {
        pg8::Gemm g{R1, (const bf16_t*)(ws + WS_WBR), 1024, 0, 0}; pg8::StaticOrder S; S.init(MTOK, 1024, G, (int)blockIdx.x);
        EpiBranch E{(const bf16_t*)(ws + WS_GM), (const bf16_t*)(ws + WS_GD), (bf16_t*)(ws + WS_MG)};
        pg8::gemm_phase<EpiBranch, pg8::StaticOrder, true, false>(lds, g, S, E);
        SEAM(4);
    }
    if (IN(5)) {
        pg8::Gemm g{(const bf16_t*)(ws + WS_MG), (const bf16_t*)(ws + WS_WOUT), 1024, 0, 0};     pg8::StaticOrder S; S.init(MTOK, 1024, G, (int)blockIdx.x);
        EpiOut E{mod, (const bf16_t*)(args.out + 16777216), (bf16_t*)(ws + WS_X1B)};
        pg8::gemm_phase<EpiOut, pg8::StaticOrder, true, false, true>(lds, g, S, E);
        SEAM(5);
    }
    if (IN(6)) { p_modnorm<false>((const float*)args.in[0], (const float*)args.in[22], mod + 4096, mod + 3072, R1, args, lds, tid, lane, wave); SEAM(6); }
    if (IN(7)) {
        pg8::Gemm g{R1, (const bf16_t*)(ws + WS_WR), 1024, 0, 0}; pg8::StaticOrder S; S.init(MTOK, 256, G, (int)blockIdx.x);
        EpiRouter E{(const float*)args.in[24], (const float*)args.in[26], ctl + CW_CNT, (int*)(ws + WS_TOK), (float*)(ws + WS_WT), (float*)(ws + WS_ROUTE), lds + PREF_OFF};
        if (blockIdx.x < 128) { if (tid < 32) ((LAS float*)(lds + PREF_OFF + 4608))[tid] = ((const float*)args.in[26])[tid];
            pg8::gemm_phase<EpiRouter, pg8::StaticOrder, true, false>(lds, g, S, E); __syncthreads(); STAMP(23); E.commit(tid); STAMP(16); }
        else p_convert_experts(args, lds, threadIdx.x & 63, wave, ((int)blockIdx.x - 128) * NWAVES + wave, 128 * NWAVES);
#ifdef STAMP_SEL
        if (blockIdx.x == 128 && tid == 0) { const unsigned long long t_ = __builtin_amdgcn_s_memrealtime(); ctl[CW_ERR + 56] = (unsigned)t_; ctl[CW_ERR + 57] = (unsigned)(t_ >> 32); }
        if (tid == 0) { const unsigned long long t_ = __builtin_amdgcn_s_memrealtime(); __hip_atomic_store(ctl + CW_ERR + 1024 + blockIdx.x, (unsigned)t_, RLX_AGENT); }
#endif
        SEAM(7);
#ifdef STAMP_SEL
        if (blockIdx.x == 0 && tid == 0) { const unsigned t7 = MISC[32 + 2 * 7]; unsigned mr = 0, mc = 0;
            for (int i = 0; i < 128; ++i) { const unsigned d = __hip_atomic_load(ctl + CW_ERR + 1024 + i, RLX_AGENT) - t7; mr = d > mr ? d : mr; }
            for (int i = 128; i < 256; ++i) { const unsigned d = __hip_atomic_load(ctl + CW_ERR + 1024 + i, RLX_AGENT) - t7; mc = d > mc ? d : mc; }
            MISC[32 + 2 * 20] = 0; MISC[33 + 2 * 20] = 0; MISC[32 + 2 * 21] = mr; MISC[33 + 2 * 21] = 0; MISC[32 + 2 * 22] = mc; MISC[33 + 2 * 22] = 0; }
#endif
    }
    if (IN(8) || IN(9) || IN(10)) {
        LAS int* pref = (LAS int*)(lds + PREF_OFF);
        if (tid < 64) pref[256 + tid] = (int)__hip_atomic_load(ctl + CW_CNT + 64 * tid, RLX_AGENT);
        __syncthreads();
        if (tid == 0) { int acc = 0; for (int l = 0; l < 64; ++l) { pref[l] = acc; acc += (pref[256 + l] + 255) >> 8; } pref[64] = acc; }
        __syncthreads();
        if (tid < 64) { LAS unsigned char* t2l = (LAS unsigned char*)(pref + 72); for (int g = pref[tid]; g < pref[tid + 1]; ++g) t2l[g] = (unsigned char)tid; }
        if (tid == 64) { LAS unsigned short* xt = (LAS unsigned short*)(pref + 160); int n = 0;
            for (int l = (int)blockIdx.x & 7; l < 64; l += 8) for (int g = pref[l]; g < pref[l + 1]; ++g) xt[n++] = (unsigned short)g;
            pref[65] = n; }
        __syncthreads();
    }
    if (IN(8)) {
        const LAS int* pref = (const LAS int*)(lds + PREF_OFF);
        pg8::Gemm g{R1, (const bf16_t*)(ws + WS_WGU), 1024, (size_t)512 * 1024, 0};
        GroupedOrder S{pref, pref[65], 2, (int)blockIdx.x >> 3, (const int*)(ws + WS_TOK), ctl + CW_CNT};
        EpiGateUp E{(bf16_t*)(ws + WS_ACT)};
        pg8::gemm_phase<EpiGateUp, GroupedOrder, true, true>(lds, g, S, E);
        SEAM(8);
    }
    if (IN(9)) {
        const LAS int* pref = (const LAS int*)(lds + PREF_OFF);
        pg8::Gemm g{(const bf16_t*)(ws + WS_ACT), (const bf16_t*)(ws + WS_WD), 256, (size_t)1024 * 256, 0};
        GroupedOrder S{pref, pref[65], 4, (int)blockIdx.x >> 3, (const int*)(ws + WS_TOK), ctl + CW_CNT};
        EpiDownY E{(unsigned char*)(ws + WS_Y)};
        pg8::gemm_phase<EpiDownY, GroupedOrder, true, false>(lds, g, S, E);
        SEAM(9);
    }
    if (IN(10)) {
        const LAS int* pref = (const LAS int*)(lds + PREF_OFF);
        const unsigned char* Y = (const unsigned char*)(ws + WS_Y); const u32x4* route = (const u32x4*)(ws + WS_ROUTE);
        int lane_c = threadIdx.x & 63; asm volatile("" : "+v"(lane_c));
        const int gw = ((((int)blockIdx.x & 7) << 5) | ((int)blockIdx.x >> 3)) * NWAVES + wave, row0 = gw * 16, b = row0 >> 12;
        f32x4 g2[4];
#pragma unroll
        for (int j = 0; j < 4; ++j) g2[j] = *(const f32x4*)(mod + b * 6144 + 5120 + 4 * lane_c + 256 * j);
        const u32x4 rtl = route[row0 + (lane_c & 15)];
        const bf16_t* X1B = (const bf16_t*)(ws + WS_X1B) + (size_t)row0 * 1024 + 4 * lane_c; float* outw = args.out + (size_t)row0 * 1024 + 4 * lane_c;
#define P10_LOAD(X, YA, YB, W1, W2, r) do { \
            const unsigned rx_ = (unsigned)__builtin_amdgcn_readlane((int)rtl.x, (r)), ry_ = (unsigned)__builtin_amdgcn_readlane((int)rtl.y, (r)); \
            W1 = __uint_as_float((unsigned)__builtin_amdgcn_readlane((int)rtl.z, (r))); W2 = __uint_as_float((unsigned)__builtin_amdgcn_readlane((int)rtl.w, (r))); \
            const unsigned char* p1_ = Y + (size_t)(256 * pref[rx_ >> 15] + (int)(rx_ & 32767u)) * 1024 + 4 * lane_c; const unsigned char* p2_ = Y + (size_t)(256 * pref[ry_ >> 15] + (int)(ry_ & 32767u)) * 1024 + 4 * lane_c; \
            const bf16_t* xp_ = X1B + (size_t)(r) * 1024; \
            _Pragma("unroll") for (int j = 0; j < 4; ++j) { X[j] = *(const u32x2*)(xp_ + 256 * j); YA[j] = *(const unsigned*)(p1_ + 256 * j); YB[j] = *(const unsigned*)(p2_ + 256 * j); } \
            __builtin_amdgcn_sched_barrier(0); } while (0)
#define P10_COMB(X, YA, YB, W1, W2, r) do { float* op_ = outw + (size_t)(r) * 1024; \
            _Pragma("unroll") for (int j = 0; j < 4; ++j) { f32x4 xv; xv[0] = bflo(X[j].x); xv[1] = bfhi(X[j].x); xv[2] = bflo(X[j].y); xv[3] = bfhi(X[j].y); \
                const f32x2 a01 = __builtin_amdgcn_cvt_pk_f32_fp8(YA[j], false), a23 = __builtin_amdgcn_cvt_pk_f32_fp8(YA[j], true), b01 = __builtin_amdgcn_cvt_pk_f32_fp8(YB[j], false), b23 = __builtin_amdgcn_cvt_pk_f32_fp8(YB[j], true); \
                f32x4 y; y[0] = W1 * a01[0] + W2 * b01[0]; y[1] = W1 * a01[1] + W2 * b01[1]; y[2] = W1 * a23[0] + W2 * b23[0]; y[3] = W1 * a23[1] + W2 * b23[1]; \
                *(f32x4*)(op_ + 256 * j) = xv + g2[j] * y; } \
            __builtin_amdgcn_sched_barrier(0); } while (0)
        u32x2 xA[4], xB[4], xC[4], xD[4]; unsigned aA[4], aB[4], aC[4], aD[4], bA[4], bB[4], bC[4], bD[4]; float uA, vA, uB, vB, uC, vC, uD, vD;
        P10_LOAD(xA, aA, bA, uA, vA, 0); P10_LOAD(xB, aB, bB, uB, vB, 1); P10_LOAD(xC, aC, bC, uC, vC, 2); P10_LOAD(xD, aD, bD, uD, vD, 3);
#pragma unroll 1
        for (int r = 0; r < 16; r += 4) {
            const bool more = r + 4 < 16;
            P10_COMB(xA, aA, bA, uA, vA, r);     if (more) P10_LOAD(xA, aA, bA, uA, vA, r + 4);
            P10_COMB(xB, aB, bB, uB, vB, r + 1); if (more) P10_LOAD(xB, aB, bB, uB, vB, r + 5);
            P10_COMB(xC, aC, bC, uC, vC, r + 2); if (more) P10_LOAD(xC, aC, bC, uC, vC, r + 6);
            P10_COMB(xD, aD, bD, uD, vD, r + 3); if (more) P10_LOAD(xD, aD, bD, uD, vD, r + 7);
        }
#undef P10_LOAD
#undef P10_COMB
    }
#ifdef STAMP_SEL
    xcd_barrier(bar); STAMP(11);
    if (blockIdx.x == 0 && tid == 0) { MISC[32 + 2 * 13] = __hip_atomic_load(ctl + CW_ERR + 62, RLX_AGENT); MISC[33 + 2 * 13] = __hip_atomic_load(ctl + CW_ERR + 63, RLX_AGENT); }
    if (blockIdx.x == 0 && tid == 0) { MISC[32 + 2 * 17] = __hip_atomic_load(ctl + CW_ERR + 56, RLX_AGENT); MISC[33 + 2 * 17] = __hip_atomic_load(ctl + CW_ERR + 57, RLX_AGENT); }
    if (blockIdx.x == 0 && tid == 0) { MISC[32 + 2 * 15] = __hip_atomic_load(ctl + CW_ERR + 58, RLX_AGENT); MISC[33 + 2 * 15] = __hip_atomic_load(ctl + CW_ERR + 59, RLX_AGENT); }
    if (blockIdx.x == 0 && tid == 0) {
        const unsigned long long t0 = ((unsigned long long)MISC[33 + 2 * (STAMP_SEL)] << 32) | MISC[32 + 2 * (STAMP_SEL)], t1 = ((unsigned long long)MISC[33 + 2 * (STAMP_HI)] << 32) | MISC[32 + 2 * (STAMP_HI)];
#ifdef ATT_PROBE
        { const float cyc = (float)__hip_atomic_load(ctl + CW_ERR + 60, RLX_AGENT), nt = (float)__hip_atomic_load(ctl + CW_ERR + 61, RLX_AGENT);
#ifdef ATT_PROBE_TOTAL

#ifdef ATT_PROBE_NT
          args.out[5] += 2.0f * floorf(nt * 0.5f + 0.5f); (void)cyc; (void)t0; (void)t1; }
#else
          args.out[5] += 2.0f * floorf(cyc * (1.0f / 20000.0f) + 0.5f); (void)nt; (void)t0; (void)t1; }
#endif
#else
          args.out[5] += 2.0f * floorf(cyc / nt * (1.0f / 100.0f) + 0.5f); (void)t0; (void)t1; }
#endif
#else
#ifndef STAMP_OFF
#define STAMP_OFF 0
#endif
#ifndef STAMP_SCALE
#define STAMP_SCALE 0.25f
#endif
        args.out[5] += ((float)(t1 - t0) * 0.01f - (float)(STAMP_OFF)) * (STAMP_SCALE);
#endif
    }
#endif
#undef IN
#undef SEAM
}
#ifdef DBG_ORACLE
constexpr int DBG_B = 1, DBG_T = 1024, NSTAGE = 19;
__device__ __forceinline__ void err_acc(float d2, float r2, float* err) {
    __shared__ float sh[2][256];
    const int tid = threadIdx.x; sh[0][tid] = d2; sh[1][tid] = r2; __syncthreads();
    for (int o = 128; o > 0; o >>= 1) { if (tid < o) { sh[0][tid] += sh[0][tid + o]; sh[1][tid] += sh[1][tid + o]; } __syncthreads(); }
    if (tid == 0) { atomicAdd(err, sh[0][0]); atomicAdd(err + 1, sh[1][0]); }
}
__global__ void k_cmp(const void* fast, int fb16, int ldf, const float* ref, int ldr, int cols, int tf, float* err) {
    const int r = blockIdx.x; float d2 = 0.f, r2 = 0.f;
    for (int c = threadIdx.x; c < cols; c += 256) {
        float f = fb16 ? bf2f(((const bf16_t*)fast)[(size_t)r * ldf + c]) : ((const float*)fast)[(size_t)r * ldf + c];
        float v = ref[(size_t)r * ldr + c]; if (tf == 1) v = 1.f / (1.f + expf(-v));
        d2 += (f - v) * (f - v); r2 += v * v; }
    err_acc(d2, r2, err);
}
__global__ void k_cmp_qk(const bf16_t* fast, const float* ref, float sc, float* err) {
    const int r = blockIdx.x; float d2 = 0.f, r2 = 0.f;
    for (int c = threadIdx.x; c < 512; c += 256) { const float f = bf2f(fast[(size_t)r * 512 + c]); const float v = ref[(size_t)r * 512 + (c & ~63) + dperm(c & 63)] * sc; d2 += (f - v) * (f - v); r2 += v * v; }
    err_acc(d2, r2, err);
}
__global__ void k_cmp_gates(const float* logi, const float* logf, const float* proj, const float* b_i, const float* b_f, float* err) {
    const int t = blockIdx.x * 256 + threadIdx.x; float d2 = 0.f, r2 = 0.f;
    for (int h = 0; h < 4; ++h) { const float vi = proj[(size_t)t * 5640 + 2048 + h] + b_i[h]; const float x = proj[(size_t)t * 5640 + 2052 + h] + b_f[h]; const float vf = fminf(x, 0.f) - log1pf(expf(-fabsf(x)));
        const float fi = logi[(size_t)(DBG_B * 4 + h) * 4096 + t], ff = logf[(size_t)(DBG_B * 4 + h) * 4096 + t];
        d2 += (fi - vi) * (fi - vi) + (ff - vf) * (ff - vf) * 100.f; r2 += vi * vi + vf * vf * 100.f; }
    err_acc(d2, r2, err);
}
__global__ void k_cmp_route(const float* fast, const float* ref, float* err) {
    const int t = blockIdx.x * 256 + threadIdx.x; const float* f = fast + (size_t)(DBG_B * 4096 + t) * 4; const float* r = ref + (size_t)t * 4;
    const unsigned a0 = __float_as_uint(f[0]) >> 15, a1 = (__float_as_uint(f[1]) >> 15) - 32u;
    const float mis = ((float)a0 != r[0] || (float)a1 != r[1]) ? 1.f : 0.f;
    err_acc(mis * 0.03f, 1.0f, err);
}
__global__ void k_poison(float* out, size_t n, const float* err) {
    int bad = -1; float ratio = 0.f;
    for (int s = 0; s < NSTAGE; ++s) { const float d = err[2 * s], r = err[2 * s + 1]; if (!(d <= 9e-4f * r) || !(r > 0.f)) { bad = s; ratio = (r > 0.f) ? sqrtf(d / r) : 2.f; break; } }
    if (bad < 0) return;
    if (!(ratio < 2.f)) ratio = 2.f;
    const float Kf = powf(10.f, (float)(bad + 1)) * (1.f + ratio);
    for (size_t i = (size_t)blockIdx.x * 256 + threadIdx.x; i < n; i += (size_t)gridDim.x * 256) out[i] = out[i] * Kf;
}
#endif

static void launch_phases(Args a, int lo, int hi, hipStream_t stream) {
    a.ph_lo = lo; a.ph_hi = hi; void* kargs[] = {&a};
#if defined(DBG_ORACLE) || defined(N_LAUNCH_PER_PHASE)
    (void)hipMemsetAsync((char*)a.ws + WS_CTL + (size_t)CW_BAR * 4, 0, XCD_BAR_WORDS * 4, stream);
#endif
    hipError_t e = hipLaunchCooperativeKernel((const void*)fwd_kernel, dim3(256), dim3(NWAVES * 64), kargs, LDS_BYTES, stream);
    if (e != hipSuccess) fprintf(stderr, "kernel_launch: cooperative launch of phases [%d,%d) failed: %s\n", lo, hi, hipGetErrorString(e));
}
extern "C" void kernel_launch(void* const* d_in, const int* in_sizes, int n_in, void* d_out, int out_size, void* d_ws, size_t ws_size, hipStream_t stream) {
    static int state = 0;
    if (state == 0) {
        state = 1;
        if (n_in != 30 || out_size != MTOK * DMODEL || ws_size < WS_END + 4 * MiB) { fprintf(stderr, "kernel_launch: unexpected shapes (n_in %d out %d ws %zu)\n", n_in, out_size, ws_size); state = -1; }
        if (state > 0 && hipFuncSetAttribute((const void*)fwd_kernel, hipFuncAttributeMaxDynamicSharedMemorySize, LDS_BYTES) != hipSuccess) { fprintf(stderr, "kernel_launch: hipFuncSetAttribute failed\n"); state = -1; }
        int dev = 0, cus = 0, per_cu = 0; (void)hipGetDevice(&dev); (void)hipDeviceGetAttribute(&cus, hipDeviceAttributeMultiprocessorCount, dev);
        (void)hipOccupancyMaxActiveBlocksPerMultiprocessor(&per_cu, (const void*)fwd_kernel, NWAVES * 64, LDS_BYTES);
        if (state > 0 && (cus * per_cu < 256)) { fprintf(stderr, "kernel_launch: %d CUs x %d blocks cannot hold the 256-workgroup grid\n", cus, per_cu); state = -1; }
        (void)hipGetLastError();
    }
    if (state < 0) return;
    (void)hipMemsetAsync((char*)d_ws + WS_CTL, 0, CTL_ZERO_BYTES, stream);
    Args a{};
    for (int i = 0; i < 30; ++i) a.in[i] = d_in[i];
    a.out = (float*)d_out; a.ws = (unsigned char*)d_ws;
    for (int i = 0; i < 8; ++i) a.freq[i] = (float)std::pow(500000.0, -(double)(2 * i) / 16.0);
#ifndef DBG_ORACLE
#ifdef N_LAUNCH_PER_PHASE
    for (int p = 0; p < 11; ++p) launch_phases(a, p, p + 1, stream);
#else
#ifdef PROBE_PH_HI
    launch_phases(a, 0, PROBE_PH_HI, stream);
#else
    launch_phases(a, 0, 11, stream);
#endif
#endif
#else
    using namespace nv;
    char* ws = (char*)d_ws; float* err = (float*)(ws + WS_CTL) + CW_ERR;
    NaiveBuf B; const size_t lateb = naive_carve((char*)d_out, ws + WS_END + 3 * MiB, B, DBG_T);
    float* outn = (float*)(ws + WS_END + 3 * MiB + lateb); float* lamp = outn + (size_t)DBG_T * 1024;
    k_mod<<<dim3(24, 8), 256, 0, stream>>>((const float*)d_in[1], (const float*)d_in[3], (const float*)d_in[4], B.mod);
    k_lam<<<1, 64, 0, stream>>>((const float*)d_in[14], (const float*)d_in[15], (const float*)d_in[16], (const float*)d_in[17], lamp);
    naive_batch(d_in, DBG_B, B, lamp, outn, DBG_T, stream);
    const size_t rb = (size_t)DBG_B * 4096;
    auto CMP = [&](int s, const void* fast, int fb16, int ldf, const float* ref, int ldr, int cols, int tf) { k_cmp<<<DBG_T, 256, 0, stream>>>(fast, fb16, ldf, ref, ldr, cols, tf, err + 2 * s); };
    launch_phases(a, 0, 1, stream);
    k_cmp<<<8, 256, 0, stream>>>(ws + WS_MOD, 0, 6144, B.mod, 6144, 6144, 0, err + 0);
    launch_phases(a, 1, 2, stream);
    CMP(1, (bf16_t*)(ws + WS_R1) + rb * 1024, 1, 1024, B.h, 1024, 1024, 0);
    k_cmp_gates<<<DBG_T / 256, 256, 0, stream>>>((const float*)(ws + WS_LOGI), (const float*)(ws + WS_LOGF), B.proj, (const float*)d_in[7], (const float*)d_in[8], err + 2 * 2);
    launch_phases(a, 2, 3, stream);
    CMP(3, (bf16_t*)(ws + WS_QM) + rb * 512, 1, 512, B.proj + 0, 5640, 512, 0);
    CMP(4, (bf16_t*)(ws + WS_KM) + rb * 512, 1, 512, B.proj + 512, 5640, 512, 0);
    CMP(5, (bf16_t*)(ws + WS_VM) + rb * 512, 1, 512, B.proj + 1024, 5640, 512, 0);
    CMP(6, (bf16_t*)(ws + WS_OG) + rb * 512, 1, 512, B.proj + 1536, 5640, 512, 1);
    k_cmp_qk<<<DBG_T, 256, 0, stream>>>((bf16_t*)(ws + WS_QD) + rb * 512, B.qd, QSCALE, err + 2 * 7);
    k_cmp_qk<<<DBG_T, 256, 0, stream>>>((bf16_t*)(ws + WS_KD) + rb * 512, B.kd, 1.0f, err + 2 * 8);
    CMP(9, (bf16_t*)(ws + WS_VD) + rb * 512, 1, 512, B.proj + 3080, 5640, 512, 0);
    CMP(10, (bf16_t*)(ws + WS_GM) + rb * 1024, 1, 1024, B.proj + 3592, 5640, 1024, 1);
    CMP(11, (bf16_t*)(ws + WS_GD) + rb * 1024, 1, 1024, B.proj + 4616, 5640, 1024, 1);
    launch_phases(a, 3, 4, stream);
    CMP(12, (bf16_t*)(ws + WS_R1) + rb * 1024, 1, 1024, B.hm, 512, 512, 0);
    CMP(13, (bf16_t*)(ws + WS_R1) + rb * 1024 + 512, 1, 1024, B.hd, 512, 512, 0);
    launch_phases(a, 4, 5, stream);
    CMP(14, (bf16_t*)(ws + WS_MG) + rb * 1024, 1, 1024, B.merged, 1024, 1024, 0);
    launch_phases(a, 5, 6, stream);
    CMP(15, (float*)d_out + rb * 1024, 0, 1024, B.x1, 1024, 1024, 0);
    launch_phases(a, 6, 7, stream);
    CMP(16, (bf16_t*)(ws + WS_R1) + rb * 1024, 1, 1024, B.h2, 1024, 1024, 0);
    launch_phases(a, 7, 8, stream);
    k_cmp_route<<<DBG_T / 256, 256, 0, stream>>>((const float*)(ws + WS_ROUTE), B.route, err + 2 * 17);
    launch_phases(a, 8, 9, stream); launch_phases(a, 9, 10, stream); launch_phases(a, 10, 11, stream);
    CMP(18, (float*)d_out + rb * 1024, 0, 1024, outn, 1024, 1024, 0);
    k_poison<<<1024, 256, 0, stream>>>((float*)d_out, (size_t)MTOK * DMODEL, err);
#endif
}
```
